# Optimizing an MI355X kernel written in HIP

```python
import jax, jax.numpy as jnp
from jax import lax
import numpy as np

D_MODEL = 2048
BATCH = 2
SEQ = 4096
DEPTH = 1
DEC_BATCH = 8
DEC_SEQ = 16
PAST_LEN = 1024

CHUNK = 64
LEFT_CHUNKS = 8
BAND_LEFT = LEFT_CHUNKS * CHUNK
N_HEADS = 16
HEAD_DIM = 128
D_ATTN = N_HEADS * HEAD_DIM
MAX_REL = 256
N_REL = CHUNK + MAX_REL
D_RNN = 2048
RG_BLOCKS = 16
RG_BLOCK_DIM = D_RNN // RG_BLOCKS
CONV_WIDTH = 4
RG_C = 8.0
D_FF = -(-8 * D_MODEL // (3 * 256)) * 256
D_IN_TOTAL = 3 * D_ATTN + 2 * D_RNN + 2 * D_MODEL
NORM_EPS = 1e-6
NEG_INF = -1e30

kernel_name = "hybrid_chunk_attn_rglru_adaln_stream_step"


def rms_norm(x):
    xf = x.astype(jnp.float32)
    y = xf * lax.rsqrt(jnp.mean(xf * xf, axis=-1, keepdims=True) + NORM_EPS)
    return y.astype(x.dtype)


def adaln(c, w_mod, b_mod):
    m = jax.nn.silu(c) @ w_mod + b_mod
    return jnp.split(m[:, None, :], 6, axis=-1)


def band_attention(q, k, v, q_pos, k_pos, rel_bias):
    diff_c = q_pos[:, :, None] // CHUNK - k_pos[:, None, :] // CHUNK
    valid = (k_pos[:, None, :] >= 0) & (diff_c >= 0) & (diff_c <= LEFT_CHUNKS)
    rel = jnp.clip(q_pos[:, :, None] - k_pos[:, None, :], -(CHUNK - 1), MAX_REL) + (CHUNK - 1)
    bias = jnp.moveaxis(jnp.take(rel_bias, rel, axis=1), 0, 1).astype(jnp.float32)
    s = jnp.einsum('bnqhd,bnkhd->bnhqk', q, k).astype(jnp.float32) * (HEAD_DIM ** -0.5)
    s = jnp.where(valid[None, :, None], s + bias[None], NEG_INF)
    p = jax.nn.softmax(s, axis=-1).astype(v.dtype)
    return jnp.einsum('bnhqk,bnkhd->bnqhd', p, v)


def attn_prompt(q, k, v, rel_bias):
    B, T = q.shape[0], q.shape[1]
    NC = T // CHUNK
    pad = ((0, 0), (BAND_LEFT, 0), (0, 0), (0, 0))
    k_pad = jnp.pad(k, pad)
    v_pad = jnp.pad(v, pad)
    idx = (jnp.arange(NC) * CHUNK)[:, None] + jnp.arange(BAND_LEFT + CHUNK)[None, :]
    k_band = k_pad[:, idx]
    v_band = v_pad[:, idx]
    q_pos = jnp.arange(T).reshape(NC, CHUNK)
    o = band_attention(q.reshape(B, NC, CHUNK, N_HEADS, HEAD_DIM), k_band, v_band,
                       q_pos, idx - BAND_LEFT, rel_bias)
    keep = min(BAND_LEFT, T)
    return o.reshape(B, T, D_ATTN), k[:, T - keep:], v[:, T - keep:]


def attn_sample(q, k, v, cache_k, cache_v, rel_bias):
    B, T = q.shape[0], q.shape[1]
    R = cache_k.shape[1]
    k_all = jnp.concatenate([cache_k, k], axis=1)[:, None]
    v_all = jnp.concatenate([cache_v, v], axis=1)[:, None]
    q_pos = (PAST_LEN + jnp.arange(T))[None, :]
    k_pos = (PAST_LEN - R + jnp.arange(R + T))[None, :]
    o = band_attention(q[:, None], k_all, v_all, q_pos, k_pos, rel_bias)
    return o.reshape(B, T, D_ATTN), k, v


def _scan_combine(left, right):
    a_l, b_l = left
    a_r, b_r = right
    return a_l * a_r, a_r * b_l + b_r


def rglru_branch(u, g, conv_buf, h0, p):
    B, T, _ = u.shape
    u_ext = jnp.concatenate([conv_buf.astype(u.dtype), u], axis=1)
    xc = p['conv_b'] + sum(u_ext[:, j:j + T] * p['conv_w'][j] for j in range(CONV_WIDTH))
    new_buf = u_ext[:, T:]
    xb = xc.reshape(B, T, RG_BLOCKS, RG_BLOCK_DIM)
    r = jax.nn.sigmoid(jnp.einsum('btnd,nde->btne', xb, p['w_rg_a']).reshape(B, T, D_RNN) + p['b_rg_a'])
    i = jax.nn.sigmoid(jnp.einsum('btnd,nde->btne', xb, p['w_rg_x']).reshape(B, T, D_RNN) + p['b_rg_x'])
    log_a = (-RG_C * r.astype(jnp.float32)) * jax.nn.softplus(-p['rg_lambda'].astype(jnp.float32))
    a = jnp.exp(log_a)
    b = jnp.sqrt(-jnp.expm1(2.0 * log_a)) * (i * xc).astype(jnp.float32)
    A, Bc = lax.associative_scan(_scan_combine, (a, b), axis=1)
    h = A * h0.astype(jnp.float32)[:, None] + Bc
    y = h.astype(u.dtype) * jax.nn.gelu(g)
    return y, new_buf, h[:, -1].astype(u.dtype)


def encoder_layer(x, c, p, attn_fn, conv_buf, h0):
    B, T, _ = x.shape
    sh1, sc1, g1, sh2, sc2, g2 = adaln(c, p['w_mod'], p['b_mod'])
    h = rms_norm(x) * (1.0 + sc1) + sh1
    z = h @ p['w_in']
    splits = [D_ATTN, 2 * D_ATTN, 3 * D_ATTN, 3 * D_ATTN + D_RNN,
              3 * D_ATTN + 2 * D_RNN, 3 * D_ATTN + 2 * D_RNN + D_MODEL]
    q, k, v, u, g_rnn, gate_a, gate_r = jnp.split(z, splits, axis=-1)
    hs = (B, T, N_HEADS, HEAD_DIM)
    o_attn, new_k, new_v = attn_fn(q.reshape(hs), k.reshape(hs), v.reshape(hs))
    y_rnn, new_buf, h_last = rglru_branch(u, g_rnn, conv_buf, h0, p)
    merged = (jax.nn.sigmoid(gate_a) * (o_attn @ p['w_proj_attn'])
              + jax.nn.sigmoid(gate_r) * (y_rnn @ p['w_proj_rnn']))
    x = x + g1 * (merged @ p['w_out'])
    h = rms_norm(x) * (1.0 + sc2) + sh2
    ff = (jax.nn.silu(h @ p['w_ffn_gate']) * (h @ p['w_ffn_up'])) @ p['w_ffn_down']
    x = x + g2 * ff
    return x, new_k, new_v, h_last, new_buf


def setup_inputs(seed: int = 0) -> dict:
    key = jax.random.key(seed)
    ks = jax.random.split(key, 32)
    f32 = jnp.float32
    cache_rows = min(BAND_LEFT, PAST_LEN)

    def nrm(k, shape, scale):
        return jax.random.normal(k, shape, f32) * scale

    u_lam = jax.random.uniform(ks[14], (DEPTH, D_RNN), f32, 0.9, 0.999)
    a_base = u_lam ** (1.0 / RG_C)
    rg_lambda = jnp.log(a_base) - jnp.log1p(-a_base)
    return {
        'x_prompt': nrm(ks[0], (BATCH, SEQ, D_MODEL), 1.0),
        'x_sample': nrm(ks[1], (DEC_BATCH, DEC_SEQ, D_MODEL), 1.0),
        'c_prompt': nrm(ks[2], (BATCH, D_MODEL), 1.0),
        'c_sample': nrm(ks[3], (DEC_BATCH, D_MODEL), 1.0),
        'cache_attn_k': nrm(ks[4], (DEPTH, DEC_BATCH, cache_rows, N_HEADS, HEAD_DIM), 1.0),
        'cache_attn_v': nrm(ks[5], (DEPTH, DEC_BATCH, cache_rows, N_HEADS, HEAD_DIM), 1.0),
        'state_rglru_h': nrm(ks[6], (DEPTH, DEC_BATCH, D_RNN), 0.5),
        'state_rglru_conv': nrm(ks[7], (DEPTH, DEC_BATCH, CONV_WIDTH - 1, D_RNN), 1.0),
        'w_mod': nrm(ks[8], (DEPTH, D_MODEL, 6 * D_MODEL), 0.5 * D_MODEL ** -0.5),
        'b_mod': nrm(ks[9], (DEPTH, 6 * D_MODEL), 0.02),
        'w_in': nrm(ks[10], (DEPTH, D_MODEL, D_IN_TOTAL), D_MODEL ** -0.5),
        'rel_bias': nrm(ks[11], (DEPTH, N_HEADS, N_REL), 0.1),
        'conv_w': nrm(ks[12], (DEPTH, CONV_WIDTH, D_RNN), CONV_WIDTH ** -0.5),
        'conv_b': nrm(ks[13], (DEPTH, D_RNN), 0.01),
        'w_rg_a': nrm(ks[15], (DEPTH, RG_BLOCKS, RG_BLOCK_DIM, RG_BLOCK_DIM), RG_BLOCK_DIM ** -0.5),
        'b_rg_a': nrm(ks[16], (DEPTH, D_RNN), 0.01),
        'w_rg_x': nrm(ks[17], (DEPTH, RG_BLOCKS, RG_BLOCK_DIM, RG_BLOCK_DIM), RG_BLOCK_DIM ** -0.5),
        'b_rg_x': nrm(ks[18], (DEPTH, D_RNN), 0.01),
        'rg_lambda': rg_lambda,
        'w_proj_attn': nrm(ks[19], (DEPTH, D_ATTN, D_MODEL), D_ATTN ** -0.5),
        'w_proj_rnn': nrm(ks[20], (DEPTH, D_RNN, D_MODEL), D_RNN ** -0.5),
        'w_out': nrm(ks[21], (DEPTH, D_MODEL, D_MODEL), D_MODEL ** -0.5),
        'w_ffn_gate': nrm(ks[22], (DEPTH, D_MODEL, D_FF), D_MODEL ** -0.5),
        'w_ffn_up': nrm(ks[23], (DEPTH, D_MODEL, D_FF), D_MODEL ** -0.5),
        'w_ffn_down': nrm(ks[24], (DEPTH, D_FF, D_MODEL), D_FF ** -0.5),
        'final_norm_g': 1.0 + nrm(ks[25], (D_MODEL,), 0.05),
    }


def reference(x_prompt, x_sample, c_prompt, c_sample, cache_attn_k, cache_attn_v,
              state_rglru_h, state_rglru_conv, w_mod, b_mod, w_in, rel_bias, conv_w, conv_b,
              w_rg_a, b_rg_a, w_rg_x, b_rg_x, rg_lambda, w_proj_attn, w_proj_rnn, w_out,
              w_ffn_gate, w_ffn_up, w_ffn_down, final_norm_g):
    xp, xs = x_prompt, x_sample
    pk, pv, ph, pc, sk, sv, sh, sc = [], [], [], [], [], [], [], []
    for l in range(DEPTH):
        p = {'w_mod': w_mod[l], 'b_mod': b_mod[l], 'w_in': w_in[l], 'conv_w': conv_w[l],
             'conv_b': conv_b[l], 'w_rg_a': w_rg_a[l], 'b_rg_a': b_rg_a[l], 'w_rg_x': w_rg_x[l],
             'b_rg_x': b_rg_x[l], 'rg_lambda': rg_lambda[l], 'w_proj_attn': w_proj_attn[l],
             'w_proj_rnn': w_proj_rnn[l], 'w_out': w_out[l], 'w_ffn_gate': w_ffn_gate[l],
             'w_ffn_up': w_ffn_up[l], 'w_ffn_down': w_ffn_down[l]}
        rb = rel_bias[l]
        ck, cv = cache_attn_k[l], cache_attn_v[l]
        zero_buf = jnp.zeros((xp.shape[0], CONV_WIDTH - 1, D_RNN), xp.dtype)
        zero_h = jnp.zeros((xp.shape[0], D_RNN), xp.dtype)
        xp, k1, v1, h1, b1 = encoder_layer(
            xp, c_prompt, p, lambda q, k, v: attn_prompt(q, k, v, rb), zero_buf, zero_h)
        xs, k2, v2, h2, b2 = encoder_layer(
            xs, c_sample, p, lambda q, k, v: attn_sample(q, k, v, ck, cv, rb),
            state_rglru_conv[l], state_rglru_h[l])
        pk.append(k1); pv.append(v1); ph.append(h1); pc.append(b1)
        sk.append(k2); sv.append(v2); sh.append(h2); sc.append(b2)
    y_prompt = rms_norm(xp) * final_norm_g
    y_sample = rms_norm(xs) * final_norm_g
    return (y_prompt, y_sample,
            jnp.stack(pk), jnp.stack(pv), jnp.stack(ph), jnp.stack(pc),
            jnp.stack(sk), jnp.stack(sv), jnp.stack(sh), jnp.stack(sc))
```

```cpp
#include <hip/hip_runtime.h>
#include <hip/hip_bf16.h>
#include <cstdio>
#include <cstdint>

#ifndef MK_MULTI
#define MK_MULTI 0
#endif

constexpr int DM = 2048, TP = 4096, NBP = 2, TS = 16, NBS = 8;
constexpr int MP = NBP * TP;
constexpr int MS = NBS * TS;
constexpr int MV = MP + MS;
constexpr int MPAD = 8448;
constexpr int NIN = 14336, DFF = 5632, NGU = 2 * DFF, NMOD = 6 * DM;
constexpr float EPS = 1e-6f;
constexpr float ATT_SCALE = 0.08838834764831845f;
constexpr size_t O_YP = 0, O_YS = 16777216, O_PK = 17039360, O_PV = 19136512, O_PH = 21233664, O_PC = 21237760,
                 O_SK = 21250048, O_SV = 21512192, O_SH = 21774336, O_SC = 21790720, O_END = 21839872;

constexpr size_t MiB = 1u << 20;
constexpr size_t WS_CTL = 0, CTL_ZERO_BYTES = 1 * MiB;
constexpr size_t WS_MOD = 64 * 1024;
constexpr size_t WS_GRAN = 1 * MiB;
constexpr size_t WS_SLAB4 = 218 * MiB, WS_SLAB6 = 251 * MiB, WS_SLAB9 = 350 * MiB;
constexpr int NSL4 = 32, NSL6 = 16, NSL9 = 22;
constexpr size_t WS_WIN = 4 * MiB, WS_WPROJ = 60 * MiB, WS_WOUT = 76 * MiB, WS_WGU = 84 * MiB, WS_WDN = 128 * MiB, WS_WRG = 150 * MiB;
constexpr size_t WS_H1 = 152 * MiB;
constexpr size_t WS_Q = 185 * MiB, WS_K = 218 * MiB, WS_V = 251 * MiB, WS_U = 284 * MiB, WS_G = 317 * MiB, WS_SA = 350 * MiB, WS_SR = 383 * MiB;
constexpr size_t WS_MERGED = WS_Q;
constexpr size_t WS_ACT = WS_K;
constexpr size_t WS_OY = 416 * MiB;
constexpr size_t WS_END = 482 * MiB;
static_assert(WS_ACT + (size_t)MPAD * DFF * 2 <= WS_G, "ACT overlay");
constexpr int CW_TMO = 0, CW_READY = 2048, CW_BAR = 4096;
constexpr size_t WS_XW = 640 * 1024;

constexpr int RING_BYTES = 131072, LDSCTL_OFF = RING_BYTES, MISC_OFF = LDSCTL_OFF + 320, LDS_BYTES = 147456;
constexpr int NWAVES = 8;

#define GAS __attribute__((address_space(1)))
#define LAS __attribute__((address_space(3)))
typedef unsigned short bf16_t;
typedef unsigned v4u __attribute__((ext_vector_type(4)));
typedef unsigned v2u __attribute__((ext_vector_type(2)));
typedef float f32x4 __attribute__((ext_vector_type(4)));
typedef float f32x2 __attribute__((ext_vector_type(2)));
typedef float f32x16 __attribute__((ext_vector_type(16)));
typedef short bf16x8 __attribute__((ext_vector_type(8)));
typedef short s16x4 __attribute__((ext_vector_type(4)));
typedef GAS unsigned gu32;
typedef GAS unsigned long long gu64;
#define RLX_AGENT __ATOMIC_RELAXED, __HIP_MEMORY_SCOPE_AGENT
#define LDS_WAIT() asm volatile("s_waitcnt lgkmcnt(0)" ::: "memory")
#define VM_WAIT() asm volatile("s_waitcnt vmcnt(0)" ::: "memory")

__device__ __forceinline__ unsigned f2bf(float f) { unsigned u = __builtin_bit_cast(unsigned, f); return (u + 0x7fffu + ((u >> 16) & 1u)) >> 16; }
__device__ __forceinline__ unsigned pk2(float lo, float hi) { return f2bf(lo) | (f2bf(hi) << 16); }
__device__ __forceinline__ float bf2f(unsigned short h) { return __builtin_bit_cast(float, (unsigned)h << 16); }
__device__ __forceinline__ float bflo(unsigned w) { return __builtin_bit_cast(float, w << 16); }
__device__ __forceinline__ float bfhi(unsigned w) { return __builtin_bit_cast(float, w & 0xffff0000u); }
typedef __bf16 bf16x2_t __attribute__((ext_vector_type(2)));
__device__ __forceinline__ unsigned cvt_pk_bf16(float lo, float hi) { f32x2 v = {lo, hi}; bf16x2_t b = __builtin_convertvector(v, bf16x2_t); return __builtin_bit_cast(unsigned, b); }
__device__ __forceinline__ float sigm(float x) { return __builtin_amdgcn_rcpf(1.f + __expf(-x)); }
__device__ __forceinline__ float gelu_tanh(float x) { return x * sigm(1.5957691216057308f * (x + 0.044715f * x * x * x)); }
__device__ __forceinline__ float wave_sum(float v) {
#pragma unroll
    for (int o = 1; o < 64; o <<= 1) v += __shfl_xor(v, o);
    return v;
}
__device__ __forceinline__ float wave_max(float v) {
#pragma unroll
    for (int o = 1; o < 64; o <<= 1) v = fmaxf(v, __shfl_xor(v, o));
    return v;
}

namespace pg8 {
#define PG8_LAS __attribute__((address_space(3)))
constexpr int BM = 256, BK = 64, HALF = 128, HTB = HALF * BK * 2, STAGE_BYTES = 8 * HTB, NXCD = 8, WGM = 8;
__host__ __device__ __forceinline__ int lds_byte(int r, int c) { const int st = (r >> 4) * 2 + (c >> 5), rr = r & 15, cc = c & 31, ob = rr * 64 + cc * 2; return st * 1024 + (ob ^ (((ob >> 9) & 1) << 5)); }
__host__ __device__ __forceinline__ void stage_rc(int b, int& R, int& C) { const int st = b / 1024, sb = b % 1024, swz = sb ^ (((sb >> 9) & 1) << 5); R = (st >> 1) * 16 + swz / 64; C = (st & 1) * 32 + (swz % 64) / 2; }
__host__ __device__ __forceinline__ int perm32(int rho) { const int n = rho >> 4, i = rho & 15; return 8 * (i >> 2) + 4 * n + (i & 3); }
struct Unit { int pm, pn, k0, nt; };
struct Gemm { const bf16_t* A; const bf16_t* Bt; int M, N, K; };
struct StaticOrder {
    int nM, nN, nwg, G, c, ntf;
    __host__ __device__ void init(int M, int N, int K, int G_, int c_) { nM = M / BM; nN = N / BM; nwg = nM * nN; G = G_; c = c_; ntf = K / BK; }
    __host__ __device__ __forceinline__ bool next(int i, Unit& u) const { return at((long)i * G + c, u); }
    __host__ __device__ __forceinline__ bool at(long L, Unit& u) const {
        u.pm = 0; u.pn = 0; u.k0 = 0; u.nt = ntf;
        if (L >= nwg) return false;
        int wgid = (int)L; { const int q = nwg / NXCD, r = nwg % NXCD, xcd = wgid % NXCD, off = wgid / NXCD; wgid = (xcd < r ? xcd * (q + 1) : r * (q + 1) + (xcd - r) * q) + off; }
        const int nig = WGM * nN, gid = wgid / nig, fm = gid * WGM, gsz = (nM - fm) < WGM ? (nM - fm) : WGM;
        u.pm = fm + ((wgid % nig) % gsz); u.pn = (wgid % nig) / gsz; return true;
    }
    __device__ __forceinline__ void a_ready(const Unit&) const {}
    __device__ __forceinline__ void done(const Unit&) const {}
};
struct SampleGatedOrder : StaticOrder {
    const unsigned* ready; unsigned need;
    __device__ __forceinline__ void a_ready(const Unit& u) const {
        if (u.pm != 32) return;
        if (threadIdx.x < 64) { unsigned polls = 0;
            while ((unsigned)__builtin_amdgcn_readfirstlane(__hip_atomic_load(ready, __ATOMIC_RELAXED, __HIP_MEMORY_SCOPE_AGENT)) < need) { __builtin_amdgcn_s_sleep(2); if (++polls > (1u << 20)) break; }
            __builtin_amdgcn_fence(__ATOMIC_ACQUIRE, "agent");
            asm volatile("s_waitcnt vmcnt(0)" ::: "memory"); }
        asm volatile("" ::: "memory"); __builtin_amdgcn_s_barrier(); asm volatile("" ::: "memory");
    }
};
struct HybridOrder {
    StaticOrder base; int snt, npn, nsl; const unsigned* ready = nullptr; unsigned need = 0;
    __host__ __device__ void init(int N, int K, int G_, int c_, int snt_) { base.init(8192, N, K, G_, c_); snt = snt_; npn = N / BM; nsl = (K / BK) / snt_; }
    __host__ __device__ __forceinline__ bool next(int i, Unit& u) const {
        const long L = (long)i * base.G + base.c;
        if (L < base.nwg) return base.at(L, u);
        const int sidx = (int)(L - base.nwg);
        u.pm = 32; u.pn = sidx % npn; u.k0 = (sidx / npn) * snt; u.nt = snt; return sidx < npn * nsl;
    }
    __device__ __forceinline__ void a_ready(const Unit& u) const {
        if (u.pm != 32 || ready == nullptr) return;
        if (threadIdx.x < 64) { unsigned polls = 0;
            while ((unsigned)__builtin_amdgcn_readfirstlane(__hip_atomic_load(ready, __ATOMIC_RELAXED, __HIP_MEMORY_SCOPE_AGENT)) < need) { __builtin_amdgcn_s_sleep(2); if (++polls > (1u << 20)) break; }
            __builtin_amdgcn_fence(__ATOMIC_ACQUIRE, "agent");
            asm volatile("s_waitcnt vmcnt(0)" ::: "memory"); }
        asm volatile("" ::: "memory"); __builtin_amdgcn_s_barrier(); asm volatile("" ::: "memory");
    }
    __device__ __forceinline__ void done(const Unit&) const {}
};
template <class Epi, class Sched, bool ALIGN_EPI = false, bool SP2 = false>
__device__ __forceinline__ void gemm_phase(PG8_LAS unsigned char* lds, const Gemm g, const Sched& S, const Epi& E) {
    const int tid = threadIdx.x, wid = __builtin_amdgcn_readfirstlane(tid >> 6), lane = tid & 63, wr = wid >> 2, wc = wid & 3, fr = lane & 15, fq = lane >> 4;
    const int K = g.K, nt = K / BK;
    unsigned voffA[2], voffB[2];
#pragma unroll
    for (int i = 0; i < 2; ++i) { int R, C; stage_rc(tid * 16 + i * 8192, R, C); const int Rb = Epi::PERM ? ((R & ~31) + perm32(R & 31)) : R;
        voffA[i] = (unsigned)(R * K + C) * 2u; voffB[i] = (unsigned)(Rb * K + C) * 2u; }
    const size_t kstep = (size_t)(BK * 2);
    const size_t hstep = (size_t)HALF * K * 2;
    const size_t tstep = 2 * hstep;
    const unsigned ldsw = (unsigned)wid * 1024u;
    const int aoff = lds_byte(wr * 64 + fr, fq * 8), boff = lds_byte(wc * 32 + fr, fq * 8);
#define PG8_SA(b, h) (((b) * 2 + (h)) * HTB)
#define PG8_SB(b, h) ((4 + (b) * 2 + (h)) * HTB)
#define PG8_STAGE(bufoff, gbase, voff) do { _Pragma("unroll") for (int _i = 0; _i < 2; ++_i) \
        __builtin_amdgcn_global_load_lds((const unsigned*)((const char*)(gbase) + (voff)[_i]), (PG8_LAS unsigned*)(lds + (bufoff) + ldsw + _i * 8192), 16, 0, 0); } while (0)
#define PG8_LDA(dst, b, h) do { _Pragma("unroll") for (int m = 0; m < 4; ++m) _Pragma("unroll") for (int k = 0; k < 2; ++k) dst[m][k] = *(const PG8_LAS bf16x8*)(lds + PG8_SA(b, h) + aoff + m * 2048 + k * 1024); } while (0)
#define PG8_LDB(dst, b, h) do { _Pragma("unroll") for (int n = 0; n < 2; ++n) _Pragma("unroll") for (int k = 0; k < 2; ++k) dst[n][k] = *(const PG8_LAS bf16x8*)(lds + PG8_SB(b, h) + boff + n * 2048 + k * 1024); } while (0)
#define PG8_MMA(ai, bj, At, Bt) do { __builtin_amdgcn_s_setprio(1); _Pragma("unroll") for (int m = 0; m < 4; ++m) _Pragma("unroll") for (int n = 0; n < 2; ++n) _Pragma("unroll") for (int k = 0; k < 2; ++k) \
        acc[ai][bj][m][n] = __builtin_amdgcn_mfma_f32_16x16x32_bf16(Bt[n][k], At[m][k], acc[ai][bj][m][n], 0, 0, 0); __builtin_amdgcn_s_setprio(0); } while (0)
#define PG8_WAIT_V(n) asm volatile("s_waitcnt vmcnt(" #n ")" ::: "memory")
#define PG8_WAIT_L(n) asm volatile("s_waitcnt lgkmcnt(" #n ")" ::: "memory")
#define PG8_BAR __builtin_amdgcn_s_barrier()
#define PG8_SCHED __builtin_amdgcn_sched_barrier(0)
    Unit cur, nxt; int ui = 0;
    if (!S.next(0, cur)) return;
    f32x4 acc[2][2][4][2];
#pragma unroll
    for (int a = 0; a < 2; ++a)
#pragma unroll
        for (int b = 0; b < 2; ++b)
#pragma unroll
            for (int m = 0; m < 4; ++m)
#pragma unroll
                for (int n = 0; n < 2; ++n) acc[a][b][m][n] = (f32x4){0.f, 0.f, 0.f, 0.f};
    bf16x8 At[4][2], B0[2][2], B1[2][2];
    const char* cA = (const char*)g.A + (size_t)cur.pm * tstep + (size_t)cur.k0 * kstep; const char* cB = (const char*)g.Bt + (size_t)cur.pn * tstep + (size_t)cur.k0 * kstep;
    S.a_ready(cur);
    if constexpr (SP2) {
        PG8_STAGE(PG8_SB(0, 0), cB, voffB); PG8_STAGE(PG8_SB(0, 1), cB + hstep, voffB); PG8_STAGE(PG8_SA(0, 0), cA, voffA); PG8_STAGE(PG8_SA(0, 1), cA + hstep, voffA);
        if (wr == 1) PG8_BAR;
        PG8_WAIT_V(2); PG8_BAR;
        PG8_STAGE(PG8_SB(1, 0), cB + kstep, voffB); PG8_STAGE(PG8_SA(1, 0), cA + kstep, voffA); PG8_STAGE(PG8_SB(1, 1), cB + hstep + kstep, voffB);
        PG8_WAIT_V(6); PG8_BAR;
    } else {
        PG8_STAGE(PG8_SB(0, 0), cB, voffB); PG8_STAGE(PG8_SA(0, 0), cA, voffA); PG8_STAGE(PG8_SB(0, 1), cB + hstep, voffB); PG8_STAGE(PG8_SA(0, 1), cA + hstep, voffA);
        if (wr == 1) PG8_BAR;
        PG8_WAIT_V(4); PG8_BAR;
        PG8_STAGE(PG8_SB(1, 0), cB + kstep, voffB); PG8_STAGE(PG8_SA(1, 0), cA + kstep, voffA); PG8_STAGE(PG8_SB(1, 1), cB + hstep + kstep, voffB);
        PG8_WAIT_V(6); PG8_BAR;
    }
    for (;;) {
        const bool has_next = S.next(ui + 1, nxt);
        const char* nA = has_next ? (const char*)g.A + (size_t)nxt.pm * tstep + (size_t)nxt.k0 * kstep : cA; const char* nB = has_next ? (const char*)g.Bt + (size_t)nxt.pn * tstep + (size_t)nxt.k0 * kstep : cB;
        const int cnt = cur.nt;
        for (int t = 0; t < cnt; t += 2) {
            if constexpr (Epi::MIDK) { if (cnt == nt && t == (nt >> 1)) E.mid(acc, cur, wr, wc, fr, fq); }
            const bool last = (t == cnt - 2);
            const char* a1 = cA + (size_t)(t + 1) * kstep;
            const char* a2 = last ? nA : cA + (size_t)(t + 2) * kstep; const char* b2 = last ? nB : cB + (size_t)(t + 2) * kstep;
            const char* a3 = a2 + kstep; const char* b3 = b2 + kstep;
            if (last && has_next) S.a_ready(nxt);
            if constexpr (SP2) {
            PG8_LDB(B0, 0, 0); PG8_LDB(B1, 0, 1); PG8_SCHED; PG8_LDA(At, 0, 0); PG8_STAGE(PG8_SA(1, 1), a1 + hstep, voffA);
            PG8_WAIT_V(8); PG8_WAIT_L(0); PG8_BAR; PG8_MMA(0, 0, At, B0); PG8_MMA(0, 1, At, B1); PG8_BAR; PG8_SCHED;
            PG8_LDA(At, 0, 1); PG8_STAGE(PG8_SB(0, 0), b2, voffB); PG8_STAGE(PG8_SB(0, 1), b2 + hstep, voffB); PG8_STAGE(PG8_SA(0, 0), a2, voffA);
            PG8_WAIT_V(8); PG8_WAIT_L(0); PG8_BAR; PG8_MMA(1, 0, At, B0); PG8_MMA(1, 1, At, B1); PG8_BAR; PG8_SCHED;
            PG8_LDB(B0, 1, 0); PG8_LDB(B1, 1, 1); PG8_SCHED; PG8_LDA(At, 1, 0); PG8_STAGE(PG8_SA(0, 1), a2 + hstep, voffA);
            PG8_WAIT_V(8); PG8_WAIT_L(0); PG8_BAR; PG8_MMA(0, 0, At, B0); PG8_MMA(0, 1, At, B1); PG8_BAR; PG8_SCHED;
            PG8_LDA(At, 1, 1); PG8_STAGE(PG8_SB(1, 0), b3, voffB); PG8_STAGE(PG8_SB(1, 1), b3 + hstep, voffB); PG8_STAGE(PG8_SA(1, 0), a3, voffA);
            PG8_WAIT_V(8); PG8_WAIT_L(0); PG8_BAR; PG8_MMA(1, 0, At, B0); PG8_MMA(1, 1, At, B1); PG8_BAR; PG8_SCHED;
            } else {
            PG8_LDB(B0, 0, 0); PG8_SCHED; PG8_LDA(At, 0, 0); PG8_STAGE(PG8_SA(1, 1), a1 + hstep, voffA);
            PG8_WAIT_L(8); PG8_BAR; PG8_WAIT_L(0); PG8_MMA(0, 0, At, B0); PG8_BAR; PG8_SCHED;
            PG8_LDB(B1, 0, 1); PG8_STAGE(PG8_SB(0, 0), b2, voffB);
            PG8_BAR; PG8_WAIT_L(0); PG8_MMA(0, 1, At, B1); PG8_BAR;
            PG8_LDA(At, 0, 1); PG8_STAGE(PG8_SA(0, 0), a2, voffA);
            PG8_BAR; PG8_WAIT_L(0); PG8_MMA(1, 0, At, B0); PG8_BAR; PG8_SCHED;
            PG8_STAGE(PG8_SB(0, 1), b2 + hstep, voffB);
            PG8_WAIT_V(6); PG8_BAR; PG8_MMA(1, 1, At, B1); PG8_BAR;
            PG8_LDB(B0, 1, 0); PG8_SCHED; PG8_LDA(At, 1, 0); PG8_STAGE(PG8_SA(0, 1), a2 + hstep, voffA);
            PG8_WAIT_L(8); PG8_BAR; PG8_WAIT_L(0); PG8_MMA(0, 0, At, B0); PG8_BAR; PG8_SCHED;
            PG8_LDB(B1, 1, 1); PG8_STAGE(PG8_SB(1, 0), b3, voffB);
            PG8_BAR; PG8_WAIT_L(0); PG8_MMA(0, 1, At, B1); PG8_BAR;
            PG8_LDA(At, 1, 1); PG8_STAGE(PG8_SA(1, 0), a3, voffA);
            PG8_BAR; PG8_WAIT_L(0); PG8_MMA(1, 0, At, B0); PG8_BAR; PG8_SCHED;
            PG8_STAGE(PG8_SB(1, 1), b3 + hstep, voffB);
            PG8_WAIT_V(6); PG8_BAR; PG8_MMA(1, 1, At, B1); PG8_BAR;
            }
        }
        if constexpr (ALIGN_EPI) { if (wr == 0) PG8_BAR; }
        E(acc, cur, wr, wc, fr, fq); S.done(cur);
        if (!has_next) break;
#pragma unroll
        for (int a = 0; a < 2; ++a)
#pragma unroll
            for (int b = 0; b < 2; ++b)
#pragma unroll
                for (int m = 0; m < 4; ++m)
#pragma unroll
                    for (int n = 0; n < 2; ++n) acc[a][b][m][n] = (f32x4){0.f, 0.f, 0.f, 0.f};
        cur = nxt; cA = nA; cB = nB; ++ui;
        if constexpr (ALIGN_EPI) { if (wr == 1) PG8_BAR; }
    }
    PG8_WAIT_V(0);
    if constexpr (!ALIGN_EPI) { if (wr == 0) PG8_BAR; }
    PG8_BAR;
#undef PG8_SA
#undef PG8_SB
#undef PG8_STAGE
#undef PG8_LDA
#undef PG8_LDB
#undef PG8_MMA
#undef PG8_WAIT_V
#undef PG8_WAIT_L
#undef PG8_BAR
#undef PG8_SCHED
}
}

__device__ __forceinline__ v4u pack8bf(f32x4 a, f32x4 b) { v4u w; w.x = cvt_pk_bf16(a[0], a[1]); w.y = cvt_pk_bf16(a[2], a[3]); w.z = cvt_pk_bf16(b[0], b[1]); w.w = cvt_pk_bf16(b[2], b[3]); return w; }
__device__ __forceinline__ void unpack8bf(v4u w, f32x4& a, f32x4& b) { a = (f32x4){bflo(w.x), bfhi(w.x), bflo(w.y), bfhi(w.y)}; b = (f32x4){bflo(w.z), bfhi(w.z), bflo(w.w), bfhi(w.w)}; }

struct EpiIn {
    static constexpr bool PERM = true, MIDK = false;
    bf16_t* base;
    float* out;
    __device__ __forceinline__ void mid(f32x4 (&)[2][2][4][2], const pg8::Unit&, int, int, int, int) const {}
    template <int MODE>
    __device__ __forceinline__ void store_bf(const f32x4 (&acc)[2][2][4][2], const pg8::Unit& u, int wr, int wc, int fr, int fq, bf16_t* dst) const {
        const int colr = (u.pn & 7) * 256 + wc * 32 + 8 * fq;
#pragma unroll
        for (int ai = 0; ai < 2; ++ai)
#pragma unroll
            for (int m = 0; m < 4; ++m) {
                const size_t row = (size_t)u.pm * 256 + ai * 128 + wr * 64 + m * 16 + fr;
#pragma unroll
                for (int bj = 0; bj < 2; ++bj) {
                    f32x4 v0 = acc[ai][bj][m][0], v1 = acc[ai][bj][m][1];
                    if (MODE == 1) {
#pragma unroll
                        for (int e = 0; e < 4; ++e) { v0[e] = gelu_tanh(v0[e]); v1[e] = gelu_tanh(v1[e]); }
                    } else if (MODE == 2) {
#pragma unroll
                        for (int e = 0; e < 4; ++e) { v0[e] = sigm(v0[e]); v1[e] = sigm(v1[e]); }
                    }
                    *(v4u*)(dst + row * DM + colr + bj * 128) = pack8bf(v0, v1);
                }
                asm volatile("" ::: "memory");
            }
    }
    __device__ __forceinline__ void store_f32(const f32x4 (&acc)[2][2][4][2], const pg8::Unit& u, int wr, int wc, int fr, int fq, float* orow0, int rl0, int rl1) const {
        const int colr = (u.pn & 7) * 256 + wc * 32 + 8 * fq;
#pragma unroll
        for (int ai = 0; ai < 2; ++ai)
#pragma unroll
            for (int m = 0; m < 4; ++m) {
                const int rl = ai * 128 + wr * 64 + m * 16 + fr;
                if (rl >= rl0 && rl < rl1) {
                    float* o = orow0 + (size_t)(rl - rl0) * DM + colr;
#pragma unroll
                    for (int bj = 0; bj < 2; ++bj) { *(f32x4*)(o + bj * 128) = acc[ai][bj][m][0]; *(f32x4*)(o + bj * 128 + 4) = acc[ai][bj][m][1]; }
                }
                asm volatile("" ::: "memory");
            }
    }
    __device__ __forceinline__ void store_f32_sconv(const f32x4 (&acc)[2][2][4][2], const pg8::Unit& u, int wr, int wc, int fr, int fq) const {
        const int colr = (u.pn & 7) * 256 + wc * 32 + 8 * fq;
        if (fr >= 13) {
#pragma unroll
            for (int m = 0; m < 4; ++m) {
                const int rl = wr * 64 + m * 16 + fr;
                float* o = out + O_SC + ((size_t)((rl >> 4) * 3 + fr - 13)) * DM + colr;
#pragma unroll
                for (int bj = 0; bj < 2; ++bj) { *(f32x4*)(o + bj * 128) = acc[0][bj][m][0]; *(f32x4*)(o + bj * 128 + 4) = acc[0][bj][m][1]; }
                asm volatile("" ::: "memory");
            }
        }
    }
    __device__ __forceinline__ void operator()(const f32x4 (&acc)[2][2][4][2], const pg8::Unit& u, int wr, int wc, int fr, int fq) const {
        const int region = u.pn >> 3, pm = u.pm;
        bf16_t* dst = base + (size_t)region * (33 * MiB / 2);
        const bool sample = (pm == 32);
        if (region == 4) store_bf<1>(acc, u, wr, wc, fr, fq, dst);
        else if (region >= 5) store_bf<2>(acc, u, wr, wc, fr, fq, dst);
        else store_bf<0>(acc, u, wr, wc, fr, fq, dst);
        if (region == 1 || region == 2) {
            if (sample) store_f32(acc, u, wr, wc, fr, fq, out + (region == 1 ? O_SK : O_SV), 0, 128);
            else if ((pm & 15) >= 14) store_f32(acc, u, wr, wc, fr, fq, out + (region == 1 ? O_PK : O_PV) + ((size_t)((pm >> 4) * 512 + ((pm & 15) - 14) * 256)) * DM, 0, 256);
        } else if (region == 3) {
            if (sample) store_f32_sconv(acc, u, wr, wc, fr, fq);
            else if ((pm & 15) == 15) store_f32(acc, u, wr, wc, fr, fq, out + O_PC + (size_t)((pm >> 4) * 3) * DM, 253, 256);
        }
    }
};
template <bool GATED>
__device__ __forceinline__ void slice_store(const f32x4 (&acc)[2][2][4][2], const pg8::Unit& u, int wr, int wc, int fr, int fq, float* slabs, const bf16_t* gate) {
    int opq = 0; asm volatile("" : "+v"(opq));
    const int col0 = u.pn * 256 + wc * 32 + 8 * fq;
    float* slab = slabs + (size_t)(u.k0 / u.nt) * (128 * DM);
#pragma unroll
    for (int m = 0; m < 4; ++m) {
        const int rl = wr * 64 + m * 16 + fr + opq;
#pragma unroll
        for (int bj = 0; bj < 2; ++bj) {
            const int c = col0 + bj * 128;
            f32x4 v0 = acc[0][bj][m][0], v1 = acc[0][bj][m][1];
            if (GATED) { f32x4 g0, g1; unpack8bf(*(const v4u*)(gate + (size_t)(MP + rl) * DM + c), g0, g1); v0 = v0 * g0; v1 = v1 * g1; }
            float* p = slab + (size_t)rl * DM + c;
            *(f32x4*)p = v0; *(f32x4*)(p + 4) = v1;
        }
        asm volatile("" ::: "memory");
    }
}
struct EpiProj {
    static constexpr bool PERM = true, MIDK = true;
    const bf16_t* SA; const bf16_t* SR; bf16_t* O; float* sacc;
    __device__ __forceinline__ void mid(f32x4 (&acc)[2][2][4][2], const pg8::Unit& u, int wr, int wc, int fr, int fq) const {
        int opq = 0; asm volatile("" : "+v"(opq));
        const int col0 = u.pn * 256 + wc * 32 + 8 * fq;
        const int rowb = u.pm * 256 + wr * 64 + fr + opq;
#pragma unroll
        for (int ai = 0; ai < 2; ++ai)
#pragma unroll
            for (int m = 0; m < 4; ++m) {
                const size_t row = (size_t)(rowb + ai * 128 + m * 16);
#pragma unroll
                for (int bj = 0; bj < 2; ++bj) {
                    const size_t off = row * DM + col0 + bj * 128;
                    f32x4 a0, a1, r0, r1; unpack8bf(*(const v4u*)(SA + off), a0, a1); unpack8bf(*(const v4u*)(SR + off), r0, r1);
#pragma unroll
                    for (int e = 0; e < 4; ++e) { acc[ai][bj][m][0][e] *= a0[e] * __builtin_amdgcn_rcpf(r0[e]); acc[ai][bj][m][1][e] *= a1[e] * __builtin_amdgcn_rcpf(r1[e]); }
                }
                asm volatile("" : "+v"(acc[ai][0][m][0]), "+v"(acc[ai][0][m][1]), "+v"(acc[ai][1][m][0]), "+v"(acc[ai][1][m][1]) :: "memory");
            }
    }
    __device__ __forceinline__ void operator()(const f32x4 (&acc)[2][2][4][2], const pg8::Unit& u, int wr, int wc, int fr, int fq) const {
        if (u.pm == 32) { slice_store<true>(acc, u, wr, wc, fr, fq, sacc, u.k0 < 32 ? SA : SR); return; }
        const int col0 = u.pn * 256 + wc * 32 + 8 * fq;
#pragma unroll
        for (int ai = 0; ai < 2; ++ai)
#pragma unroll
            for (int m = 0; m < 4; ++m) {
                const size_t row = (size_t)u.pm * 256 + ai * 128 + wr * 64 + m * 16 + fr;
#pragma unroll
                for (int bj = 0; bj < 2; ++bj) {
                    const size_t off = row * DM + col0 + bj * 128;
                    f32x4 r0, r1; unpack8bf(*(const v4u*)(SR + off), r0, r1);
                    *(v4u*)(O + off) = pack8bf(acc[ai][bj][m][0] * r0, acc[ai][bj][m][1] * r1);
                }
                asm volatile("" ::: "memory");
            }
    }
};
constexpr int XL_OFF = LDSCTL_OFF + 1024;
__device__ __forceinline__ void panel_rinv(const f32x4 (&v)[2][2][4][2], const pg8::Unit& u, int wr, int wc, int fr, int fq, LAS unsigned char* xl, unsigned long long* xw) {
    const int lane = threadIdx.x & 63, wid = wr * 4 + wc;
    LAS float* P = (LAS float*)xl;
    LAS float* S = P + 1024;
#pragma unroll
    for (int ai = 0; ai < 2; ++ai)
#pragma unroll
        for (int m = 0; m < 4; ++m) { float q = 0.f;
#pragma unroll
            for (int bj = 0; bj < 2; ++bj)
#pragma unroll
                for (int n = 0; n < 2; ++n) { const f32x4 x = v[ai][bj][m][n]; q += (x[0] * x[0] + x[1] * x[1]) + (x[2] * x[2] + x[3] * x[3]); }
            q += __shfl_xor(q, 16); q += __shfl_xor(q, 32);
            if (fq == 0) P[(ai * 128 + wr * 64 + m * 16 + fr) * 4 + wc] = q; }
    asm volatile("s_waitcnt lgkmcnt(0)" ::: "memory"); __builtin_amdgcn_s_barrier(); asm volatile("" ::: "memory");
    int opq = 0; asm volatile("" : "+v"(opq));
    if (lane < 32) { const int row = wid * 32 + lane + opq; const f32x4 a = *(const LAS f32x4*)(P + row * 4);
        const float q = (a[0] + a[1]) + (a[2] + a[3]);
        unsigned long long* w = xw + (size_t)u.pm * 256 + row;
        const unsigned long long inc = (1ull << 56) + (unsigned long long)(q * 1048576.f);
        unsigned long long cur = __hip_atomic_fetch_add(w, inc, __ATOMIC_RELAXED, __HIP_MEMORY_SCOPE_AGENT) + inc;
        unsigned spins = 0;
        while ((cur >> 56) < 8ull) { __builtin_amdgcn_s_sleep(1); cur = __hip_atomic_load(w, __ATOMIC_RELAXED, __HIP_MEMORY_SCOPE_AGENT); if (++spins > (1u << 18)) break; }
        S[row] = rsqrtf((float)(cur & ((1ull << 56) - 1)) * (1.f / (1048576.f * DM)) + EPS); }
    asm volatile("s_waitcnt vmcnt(0) lgkmcnt(0)" ::: "memory"); __builtin_amdgcn_s_barrier(); asm volatile("" ::: "memory");
}
struct EpiResNorm {
    static constexpr bool PERM = true, MIDK = false;
    const float* xin; float* x1o; bf16_t* h2o; const float* mod; float* slabs; LAS unsigned char* xl; unsigned long long* xw;
    __device__ __forceinline__ void mid(f32x4 (&)[2][2][4][2], const pg8::Unit&, int, int, int, int) const {}
    __device__ __forceinline__ void operator()(f32x4 (&acc)[2][2][4][2], const pg8::Unit& u, int wr, int wc, int fr, int fq) const {
        if (u.pm == 32) { slice_store<false>(acc, u, wr, wc, fr, fq, slabs, nullptr); return; }
        const int col0 = u.pn * 256 + wc * 32 + 8 * fq;
        const float* md = mod + (size_t)(u.pm >> 4) * NMOD;
#pragma unroll
        for (int ai = 0; ai < 2; ++ai)
#pragma unroll
            for (int m = 0; m < 4; ++m) {
                const size_t ro = (size_t)(u.pm * 256 + ai * 128 + wr * 64 + m * 16 + fr) * DM;
#pragma unroll
                for (int bj = 0; bj < 2; ++bj) {
                    const int c = col0 + bj * 128;
                    const f32x4 g0 = *(const f32x4*)(md + 2 * DM + c), g1 = *(const f32x4*)(md + 2 * DM + c + 4);
                    const f32x4 x0 = *(const f32x4*)(xin + ro + c), x1 = *(const f32x4*)(xin + ro + c + 4);
                    acc[ai][bj][m][0] = x0 + g0 * acc[ai][bj][m][0]; acc[ai][bj][m][1] = x1 + g1 * acc[ai][bj][m][1];
                }
                asm volatile("" : "+v"(acc[ai][0][m][0]), "+v"(acc[ai][0][m][1]), "+v"(acc[ai][1][m][0]), "+v"(acc[ai][1][m][1]) :: "memory");
            }
        panel_rinv(acc, u, wr, wc, fr, fq, xl, xw);
        const LAS float* S = (const LAS float*)xl + 1024;
        int opq = 0; asm volatile("" : "+v"(opq));
        const int rl0 = wr * 64 + fr + opq;
#pragma unroll
        for (int bj = 0; bj < 2; ++bj)
#pragma unroll
            for (int n = 0; n < 2; ++n) {
                const int c = col0 + bj * 128 + 4 * n;
                const f32x4 s0 = *(const f32x4*)(md + 4 * DM + c) + 1.f, h0 = *(const f32x4*)(md + 3 * DM + c);
#pragma unroll
                for (int ai = 0; ai < 2; ++ai)
#pragma unroll
                    for (int m = 0; m < 4; ++m) {
                        const int rl = rl0 + ai * 128 + m * 16; const float rv = S[rl];
                        const size_t ro = (size_t)(u.pm * 256 + rl) * DM + c;
                        *(f32x4*)(x1o + ro) = acc[ai][bj][m][n];
                        const f32x4 y = acc[ai][bj][m][n] * rv * s0 + h0; v2u w; w.x = cvt_pk_bf16(y[0], y[1]); w.y = cvt_pk_bf16(y[2], y[3]);
                        *(v2u*)(h2o + ro) = w;
                    }
                asm volatile("" ::: "memory");
            }
    }
};
struct EpiResFinal {
    static constexpr bool PERM = true, MIDK = false;
    const float* x1i; float* yo; const float* mod; const float* fng; float* slabs; LAS unsigned char* xl; unsigned long long* xw;
    __device__ __forceinline__ void mid(f32x4 (&)[2][2][4][2], const pg8::Unit&, int, int, int, int) const {}
    __device__ __forceinline__ void operator()(f32x4 (&acc)[2][2][4][2], const pg8::Unit& u, int wr, int wc, int fr, int fq) const {
        if (u.pm == 32) { slice_store<false>(acc, u, wr, wc, fr, fq, slabs, nullptr); return; }
        const int col0 = u.pn * 256 + wc * 32 + 8 * fq;
        const float* gp = mod + (size_t)(u.pm >> 4) * NMOD + 5 * DM;
#pragma unroll
        for (int ai = 0; ai < 2; ++ai)
#pragma unroll
            for (int m = 0; m < 4; ++m) {
                const size_t ro = (size_t)(u.pm * 256 + ai * 128 + wr * 64 + m * 16 + fr) * DM;
#pragma unroll
                for (int bj = 0; bj < 2; ++bj) {
                    const int c = col0 + bj * 128;
                    const f32x4 g0 = *(const f32x4*)(gp + c), g1 = *(const f32x4*)(gp + c + 4);
                    const f32x4 x0 = *(const f32x4*)(x1i + ro + c), x1 = *(const f32x4*)(x1i + ro + c + 4);
                    acc[ai][bj][m][0] = x0 + g0 * acc[ai][bj][m][0]; acc[ai][bj][m][1] = x1 + g1 * acc[ai][bj][m][1];
                }
                asm volatile("" : "+v"(acc[ai][0][m][0]), "+v"(acc[ai][0][m][1]), "+v"(acc[ai][1][m][0]), "+v"(acc[ai][1][m][1]) :: "memory");
            }
        panel_rinv(acc, u, wr, wc, fr, fq, xl, xw);
        const LAS float* S = (const LAS float*)xl + 1024;
        int opq = 0; asm volatile("" : "+v"(opq));
        const int rl0 = wr * 64 + fr + opq;
#pragma unroll
        for (int bj = 0; bj < 2; ++bj) {
            const int c = col0 + bj * 128;
            const f32x4 f0 = *(const f32x4*)(fng + c), f1 = *(const f32x4*)(fng + c + 4);
#pragma unroll
            for (int ai = 0; ai < 2; ++ai)
#pragma unroll
                for (int m = 0; m < 4; ++m) {
                    const int rl = rl0 + ai * 128 + m * 16; const float rv = S[rl];
                    float* o = yo + (size_t)(u.pm * 256 + rl) * DM + c;
                    *(f32x4*)o = acc[ai][bj][m][0] * rv * f0; *(f32x4*)(o + 4) = acc[ai][bj][m][1] * rv * f1;
                }
            asm volatile("" ::: "memory");
        }
    }
};
struct EpiGU {
    static constexpr bool PERM = true, MIDK = false;
    bf16_t* O;
    __device__ __forceinline__ void mid(f32x4 (&)[2][2][4][2], const pg8::Unit&, int, int, int, int) const {}
    __device__ __forceinline__ void operator()(const f32x4 (&acc)[2][2][4][2], const pg8::Unit& u, int wr, int wc, int fr, int fq) const {
        const int col0 = u.pn * 128 + wc * 32 + 8 * fq;
#pragma unroll
        for (int ai = 0; ai < 2; ++ai)
#pragma unroll
            for (int m = 0; m < 4; ++m) {
                const size_t row = (size_t)u.pm * 256 + ai * 128 + wr * 64 + m * 16 + fr;
                f32x4 o0, o1;
#pragma unroll
                for (int e = 0; e < 4; ++e) { const float g0 = acc[ai][0][m][0][e], g1 = acc[ai][0][m][1][e];
                    o0[e] = g0 * sigm(g0) * acc[ai][1][m][0][e]; o1[e] = g1 * sigm(g1) * acc[ai][1][m][1][e]; }
                *(v4u*)(O + row * DFF + col0) = pack8bf(o0, o1);
            }
    }
};

namespace att {
constexpr int NW = 8, QBLK = 32, KVBLK = 64, QB = NW * QBLK, D = 128, LDQ = 2048, LDO = 4096;
constexpr int SHM_V = KVBLK * D * 2, SHM_K = KVBLK * D * 2;
constexpr int LDS_BYTES = 2 * SHM_V + 2 * SHM_K + NW * 64 * 4;
constexpr int BIAS_OFF = LDS_BYTES;
constexpr float THR = 8.f;
constexpr float LOG2E = 1.4426950408889634f;
#define KSWZ(row, colB) ((row) * 256 + ((colB) ^ (((row) & 7) << 4)))
#define SBAR() __builtin_amdgcn_sched_barrier(0)
__device__ __forceinline__ int v_st(int k, int c) { const int kk = (k & ~0xC) | ((k & 4) << 1) | ((k & 8) >> 1); return ((kk >> 3) * 4 + (c >> 5)) * 512 + ((kk & 7) * 32 + (c & 31)) * 2; }
__device__ __forceinline__ int v_rd_base(int lane) { return ((lane & 3) << 3) | (((lane >> 2) & 3) << 6) | (((lane >> 4) & 1) << 5) | (((lane >> 5) & 1) << 8); }
constexpr int v_rd_off(int d0, int ks, int half) { return d0 * 512 + ks * 4096 + half * 2048; }
__device__ __forceinline__ int crow(int r, int hi) { return (r & 3) + 8 * (r >> 2) + 4 * hi; }
__device__ __forceinline__ unsigned cvtpk(float lo, float hi) { return cvt_pk_bf16(lo, hi); }
__device__ __forceinline__ bf16x8 load8(const bf16_t* p) { return *reinterpret_cast<const bf16x8*>(p); }
__device__ __forceinline__ int jlo(int qb) { const int j = 4 * qb - 8; return j > 0 ? j : 0; }
__device__ __forceinline__ void bias_tile(f32x16& p0, f32x16& p1, int dq, int dlo, const float* bl) {
    if (dlo - 63 >= 256) { const float bf = bl[319];
#pragma unroll
        for (int r = 0; r < 16; ++r) { p0[r] = fmaf(p0[r], ATT_SCALE, bf); p1[r] = fmaf(p1[r], ATT_SCALE, bf); }
    } else {
#pragma unroll
        for (int r = 0; r < 16; ++r) { const int c = (r & 3) + 8 * (r >> 2);
            int d0 = dq - c; d0 = d0 > 256 ? 256 : d0; int d1 = dq - c - 32; d1 = d1 > 256 ? 256 : d1;
            p0[r] = fmaf(p0[r], ATT_SCALE, bl[d0 + 63]); p1[r] = fmaf(p1[r], ATT_SCALE, bl[d1 + 63]); }
    }
}
__device__ __forceinline__ void partialSM(f32x16& p0, f32x16& p1, float& m_reg, float& mn, float& alpha) {
    float pmax = p0[0];
#pragma unroll
    for (int r = 1; r < 16; ++r) pmax = fmaxf(pmax, p0[r]);
#pragma unroll
    for (int r = 0; r < 16; ++r) pmax = fmaxf(pmax, p1[r]);
    { auto rr = __builtin_amdgcn_permlane32_swap(__float_as_uint(pmax), __float_as_uint(pmax), false, false);
      pmax = fmaxf(__uint_as_float(rr[0]), __uint_as_float(rr[1])); }
    if (__builtin_expect(__all((pmax - m_reg) <= THR), 1)) { mn = m_reg; alpha = 1.f; }
    else { mn = fmaxf(m_reg, pmax); alpha = __builtin_amdgcn_exp2f((m_reg - mn) * LOG2E); m_reg = mn; }
    const float mnL = -mn * LOG2E;
#pragma unroll
    for (int r = 0; r < 16; ++r) p0[r] = fmaf(p0[r], LOG2E, mnL);
#pragma unroll
    for (int r = 0; r < 16; ++r) p1[r] = fmaf(p1[r], LOG2E, mnL);
#pragma unroll
    for (int r = 0; r < 16; ++r) p0[r] = __builtin_amdgcn_exp2f(p0[r]);
}
__device__ __forceinline__ void finishSM(f32x16& p0, f32x16& p1, float alpha, float& l_reg, bf16x8& pa0, bf16x8& pa1, bf16x8& pa2, bf16x8& pa3) {
#pragma unroll
    for (int r = 0; r < 16; ++r) p1[r] = __builtin_amdgcn_exp2f(p1[r]);
    float ps = 0;
#pragma unroll
    for (int r = 0; r < 16; ++r) ps += p0[r];
#pragma unroll
    for (int r = 0; r < 16; ++r) ps += p1[r];
    { auto rr = __builtin_amdgcn_permlane32_swap(__float_as_uint(ps), __float_as_uint(ps), false, false);
      ps = __uint_as_float(rr[0]) + __uint_as_float(rr[1]); }
    l_reg = l_reg * alpha + ps;
#define PK4(P, B_, OUT) do { unsigned a0 = cvtpk(P[B_+0], P[B_+1]), a1 = cvtpk(P[B_+2], P[B_+3]);                          \
        unsigned b0 = cvtpk(P[B_+4], P[B_+5]), b1 = cvtpk(P[B_+6], P[B_+7]);                                             \
        auto r0 = __builtin_amdgcn_permlane32_swap(a0, b0, false, false); auto r1 = __builtin_amdgcn_permlane32_swap(a1, b1, false, false); \
        v4u w = {r0[0], r1[0], r0[1], r1[1]}; OUT = *reinterpret_cast<bf16x8*>(&w); } while (0)
    PK4(p0, 0, pa0); PK4(p0, 8, pa1); PK4(p1, 0, pa2); PK4(p1, 8, pa3);
#undef PK4
}
template <int KB>
__device__ __forceinline__ void qkt(f32x16& p0, f32x16& p1, const char* K_lds, int r32, int hi, const bf16x8* qr, bool act) {
    if (!act) { const float NEG = -__builtin_inff();
#pragma unroll
        for (int r = 0; r < 16; ++r) { p0[r] = NEG; p1[r] = NEG; } return; }
    p0 = f32x16{}; p1 = f32x16{};
    const char* kb[4];
#pragma unroll
    for (int dd = 0; dd < 4; ++dd) kb[dd] = K_lds + KB * SHM_K + KSWZ(r32, (dd * 16 + hi * 8) * 2);
#pragma unroll
    for (int d0 = 0; d0 < 8; ++d0) { const char* a = kb[d0 & 3] + (d0 >> 2) * 128;
        bf16x8 b0 = *reinterpret_cast<const bf16x8*>(a);
        bf16x8 b1 = *reinterpret_cast<const bf16x8*>(a + 32 * 256);
        p0 = __builtin_amdgcn_mfma_f32_32x32x16_bf16(b0, qr[d0], p0, 0, 0, 0);
        p1 = __builtin_amdgcn_mfma_f32_32x32x16_bf16(b1, qr[d0], p1, 0, 0, 0); }
}
template <int VB>
__device__ __forceinline__ void pv_tile(f32x16* o, int vb0, bf16x8 pa0, bf16x8 pa1, bf16x8 pa2, bf16x8 pa3, bool act) {
    if (!act) return;
#define TRRD(dst, off) asm volatile("ds_read_b64_tr_b16 %0, %1 offset:%2" : "=&v"(dst) : "v"(vb0), "i"(off) : "memory")
#define PV_D0(d0) do { s16x4 l0, l1, l2, l3, h0, h1, h2, h3; constexpr int b_ = VB * SHM_V + v_rd_off(d0, 0, 0); \
        TRRD(l0, b_); TRRD(h0, b_ + 2048); TRRD(l1, b_ + 4096); TRRD(h1, b_ + 6144); TRRD(l2, b_ + 8192); TRRD(h2, b_ + 10240); TRRD(l3, b_ + 12288); TRRD(h3, b_ + 14336); \
        asm volatile("s_waitcnt lgkmcnt(0)" ::: "memory"); SBAR();   \
        o[d0] = __builtin_amdgcn_mfma_f32_32x32x16_bf16(pa0, (bf16x8){l0[0], l0[1], l0[2], l0[3], h0[0], h0[1], h0[2], h0[3]}, o[d0], 0, 0, 0);   \
        o[d0] = __builtin_amdgcn_mfma_f32_32x32x16_bf16(pa1, (bf16x8){l1[0], l1[1], l1[2], l1[3], h1[0], h1[1], h1[2], h1[3]}, o[d0], 0, 0, 0);   \
        o[d0] = __builtin_amdgcn_mfma_f32_32x32x16_bf16(pa2, (bf16x8){l2[0], l2[1], l2[2], l2[3], h2[0], h2[1], h2[2], h2[3]}, o[d0], 0, 0, 0);   \
        o[d0] = __builtin_amdgcn_mfma_f32_32x32x16_bf16(pa3, (bf16x8){l3[0], l3[1], l3[2], l3[3], h3[0], h3[1], h3[2], h3[3]}, o[d0], 0, 0, 0); } while (0)
    PV_D0(0); PV_D0(1); PV_D0(2); PV_D0(3);
#undef PV_D0
#undef TRRD
}
struct BlockRef { const bf16_t* Q; const bf16_t* K; const bf16_t* V; bf16_t* O; int qb; int h; };
struct Seam { bf16x8 qr[8]; bf16x8 st_v0, st_v1, st_k0, st_k1; };
#define ROW(p, k0, rr) ((p) + (size_t)((k0) + (rr)) * LDQ + sc)
#define VMW() asm volatile("s_waitcnt vmcnt(0)" ::: "memory")
#define VMWN(n) asm volatile("s_waitcnt vmcnt(%0)" :: "i"(n) : "memory")
#define SLOAD_H(Kp, Vp, k0) do { S.st_v0 = load8(ROW(Vp, k0, sr)); S.st_v1 = load8(ROW(Vp, k0, 32 + sr));              \
                         S.st_k0 = load8(ROW(Kp, k0, sr)); S.st_k1 = load8(ROW(Kp, k0, 32 + sr)); } while (0)
#define SWRITE_HK(bf) do { *(bf16x8*)(K_lds + (bf) * SHM_K + kws) = S.st_k0; *(bf16x8*)(K_lds + (bf) * SHM_K + kws + 32 * 256) = S.st_k1; } while (0)
#define SWRITE_HV(bf) do { *(bf16x8*)(V_lds + (bf) * SHM_V + vst0) = S.st_v0; *(bf16x8*)(V_lds + (bf) * SHM_V + vst1) = S.st_v1; } while (0)
#define SWRITE_H(bf) do { SWRITE_HV(bf); SWRITE_HK(bf); } while (0)
__device__ __forceinline__ void att_prime(const BlockRef& cur, char* lds, Seam& S) {
    const int tid = threadIdx.x, wid = __builtin_amdgcn_readfirstlane(tid >> 6), lane = tid & 63, r32 = lane & 31, hi = lane >> 5;
    const int sr = tid >> 4, sc = (tid & 15) * 8, kws = KSWZ(sr, sc * 2); char* K_lds = lds + 2 * SHM_V;
    const int kb0 = jlo(cur.qb) * KVBLK;
#pragma unroll
    for (int d0 = 0; d0 < 8; ++d0) S.qr[d0] = load8(cur.Q + (size_t)(wid * QBLK + r32) * LDQ + d0 * 16 + hi * 8);
    SLOAD_H(cur.K, cur.V, kb0); VMW(); SWRITE_HK(0);
    __syncthreads();
}
__device__ __forceinline__ void att_block(const BlockRef& cur, const BlockRef& nxt, char* lds, Seam& S) {
    const int tid = threadIdx.x, wid = __builtin_amdgcn_readfirstlane(tid >> 6), lane = tid & 63, r32 = lane & 31, hi = lane >> 5;
    const int j_lo = jlo(cur.qb), j_hi = 4 * cur.qb + 4;
    const int NT = j_hi - j_lo;
    const int kbn = jlo(nxt.qb) * KVBLK;
    const int cq = 4 * cur.qb + (wid >> 1);
    const int qlo = cur.qb * QB + wid * QBLK, qpos = qlo + r32;
    const float* bl = (const float*)(lds + BIAS_OFF) + cur.h * 320;
    char* V_lds = lds; char* K_lds = lds + 2 * SHM_V;
    float* ws = (float*)(lds + 2 * SHM_V + 2 * SHM_K) + wid * 64; float* li_l = ws, * al_l = ws + 32;
    float m_reg = -1e30f, l_reg = 0; f32x16 o[4] = {};
    const int sr = tid >> 4, sc = (tid & 15) * 8, vst0 = v_st(sr, sc), vst1 = v_st(32 + sr, sc), kws = KSWZ(sr, sc * 2);
    const int vb0 = (int)(uintptr_t)V_lds + v_rd_base(lane);
    const bf16_t* Kh = cur.K; const bf16_t* Vh = cur.V;
#define RESC(a) do { if (__any((a) < 1.f)) { if (hi == 0) al_l[r32] = (a); asm volatile("s_waitcnt lgkmcnt(0)" ::: "memory");              \
                     for (int d_ = 0; d_ < 4; ++d_) for (int r = 0; r < 16; ++r) o[d_][r] *= al_l[crow(r, hi)]; } } while (0)
#define KBASE(t) ((j_lo + (t)) * KVBLK)
#define ACT(t) ((j_lo + (t)) <= cq && (j_lo + (t)) + 8 >= cq)
#define BIAST(P0_, P1_, t) do { if (ACT(t)) bias_tile(P0_, P1_, qpos - KBASE(t) - 4 * hi, qlo - KBASE(t), bl); } while (0)
    constexpr int NQL = 8;
#define SEAM_K0() do { VMWN(NQL); SWRITE_HK(0); SBAR(); } while (0)
    f32x16 pA0, pA1, pB0, pB1; float mnA, mnB, alA, alB; bf16x8 pa0, pa1, pa2, pa3;
    SWRITE_HV(0); SBAR();
    if (NT > 1) { SLOAD_H(Kh, Vh, KBASE(1)); }
    SBAR(); qkt<0>(pA0, pA1, K_lds, r32, hi, S.qr, ACT(0));
    BIAST(pA0, pA1, 0); partialSM(pA0, pA1, m_reg, mnA, alA);
    if (NT > 1) { VMW(); SWRITE_H(1); }
    __syncthreads();
#define HALF_STEP(PX0, PX1, mnX, alX, PY0, PY1, alY, t, KB, VB, SB) do {                                                      \
        SBAR(); qkt<KB>(PX0, PX1, K_lds, r32, hi, S.qr, ACT(t));                                             \
        finishSM(PY0, PY1, alY, l_reg, pa0, pa1, pa2, pa3); SBAR();                                                           \
        if ((t) + 1 < NT) { SLOAD_H(Kh, Vh, KBASE((t) + 1)); SBAR(); }                                               \
        pv_tile<VB>(o, vb0, pa0, pa1, pa2, pa3, ACT((t) - 1)); BIAST(PX0, PX1, (t)); partialSM(PX0, PX1, m_reg, mnX, alX);                                        \
        __syncthreads();                                                                                                      \
        if ((t) + 1 < NT) { VMW(); SWRITE_H(SB); }                                                                          \
        RESC(alX); __syncthreads(); } while (0)
    for (int t = 1; t + 1 < NT; t += 2) {
        HALF_STEP(pB0, pB1, mnB, alB, pA0, pA1, alA, t, 1, 0, 0);
        HALF_STEP(pA0, pA1, mnA, alA, pB0, pB1, alB, t + 1, 0, 1, 1);
    }
    const bool even = (NT & 1) == 0;
    if (even) { SBAR(); qkt<1>(pB0, pB1, K_lds, r32, hi, S.qr, ACT(NT - 1)); SBAR(); }
    SLOAD_H(nxt.K, nxt.V, kbn); SBAR();
#pragma unroll
    for (int d0 = 0; d0 < 8; ++d0) S.qr[d0] = load8(nxt.Q + (size_t)(wid * QBLK + r32) * LDQ + d0 * 16 + hi * 8);
    SBAR();
    finishSM(pA0, pA1, alA, l_reg, pa0, pa1, pa2, pa3); SBAR();
    pv_tile<0>(o, vb0, pa0, pa1, pa2, pa3, ACT(even ? NT - 2 : NT - 1));
    if (even) { BIAST(pB0, pB1, NT - 1); partialSM(pB0, pB1, m_reg, mnB, alB); __syncthreads(); RESC(alB);
        finishSM(pB0, pB1, alB, l_reg, pa0, pa1, pa2, pa3); SBAR(); pv_tile<1>(o, vb0, pa0, pa1, pa2, pa3, ACT(NT - 1)); }
    SBAR(); SEAM_K0();
    if (hi == 0) li_l[r32] = l_reg; asm volatile("s_waitcnt lgkmcnt(0)" ::: "memory");
    float rli[16];
#pragma unroll
    for (int r = 0; r < 16; ++r) rli[r] = __builtin_amdgcn_rcpf(li_l[crow(r, hi)]);
    bf16_t* Ow = cur.O + (size_t)(wid * QBLK) * LDO;
#pragma unroll
    for (int r = 0; r < 16; ++r) { const int orow = crow(r, hi);
#pragma unroll
        for (int d0 = 0; d0 < 4; ++d0) { const float v = o[d0][r] * rli[r];
            const float vn = __shfl_xor(v, 1);
            if ((r32 & 1) == 0) *(unsigned*)(Ow + (size_t)orow * LDO + d0 * 32 + r32) = cvtpk(v, vn); } }
    __syncthreads();
#undef RESC
#undef KBASE
#undef ACT
#undef BIAST
#undef SEAM_K0
#undef HALF_STEP
}
#undef ROW
#undef VMW
#undef VMWN
#undef SLOAD_H
#undef SWRITE_HK
#undef SWRITE_HV
#undef SWRITE_H
#undef SBAR
#undef KSWZ
}

#define XB_TMO      128
#define XB_XCNT(j)  (256  + 64 * (j))
#define XB_XSUB(j)  (1280 + 64 * (j))
#define XB_XGEN(j)  (2304 + 64 * (j))
#define XB_TOP      3328
#define XB_TOPGEN   3392
#define XCD_BAR_WORDS 3456
#define XB_SPIN_CAP (1u << 18)
__device__ __forceinline__ unsigned xb_ld(unsigned* p)              { return __hip_atomic_load(p, __ATOMIC_RELAXED, __HIP_MEMORY_SCOPE_AGENT); }
__device__ __forceinline__ unsigned xb_add(unsigned* p, unsigned v) { return __hip_atomic_fetch_add(p, v, __ATOMIC_RELAXED, __HIP_MEMORY_SCOPE_AGENT); }
__device__ __forceinline__ unsigned xb_xcc_id() { return (unsigned)__builtin_amdgcn_s_getreg((3 << 11) | 20) & 0xFu; }
#define XB_SPIN(cond, bar) do { unsigned _sp = 0; while (cond) { __builtin_amdgcn_s_sleep(1); \
    if ((++_sp & 255u) == 0u) { if (xb_ld(&(bar)[XB_TMO])) break; if (_sp > XB_SPIN_CAP) { atomicAdd(&(bar)[XB_TMO], 1u); break; } } } } while (0)
struct XcdBarrier { unsigned* bar; unsigned x; volatile LAS unsigned* st; };
__device__ __forceinline__ XcdBarrier xcd_barrier_post(unsigned* bar, volatile LAS unsigned* st) {
    XcdBarrier b; b.bar = bar; b.x = xb_xcc_id(); b.st = st;
    if (threadIdx.x == 0) (void)xb_add(&bar[XB_XCNT(b.x)], 1u);
    return b;
}
__device__ __forceinline__ void xcd_barrier_complete(unsigned* bar, unsigned x, unsigned& nloc, unsigned& nx) {
    const unsigned G = gridDim.x * gridDim.y * gridDim.z;
    unsigned sum, cnt, mine, sp = 0u;
    for (;;) {
        sum = 0u; cnt = 0u; mine = 0u;
#pragma unroll
        for (unsigned j = 0; j < 16; ++j) { const unsigned c = xb_ld(&bar[XB_XCNT(j)]); sum += c; cnt += (c > 0u) ? 1u : 0u; mine = (j == x) ? c : mine; }
        if (sum == G) break;
        __builtin_amdgcn_s_sleep(1);
        if ((++sp & 255u) == 0u) { if (xb_ld(&bar[XB_TMO])) break; if (sp > XB_SPIN_CAP) { atomicAdd(&bar[XB_TMO], 1u); break; } }
    }
    nloc = mine > 0u ? mine : 1u; nx = cnt > 0u ? cnt : 1u;
}
__device__ __forceinline__ void xcd_barrier(const XcdBarrier& b) {
    asm volatile("s_waitcnt vmcnt(0)" ::: "memory");
    __syncthreads();
    if (threadIdx.x == 0) {
        unsigned* bar = b.bar;
        __builtin_amdgcn_s_waitcnt(0);
        unsigned nloc = b.st[0], nx = b.st[1];
        if (nloc == 0u) { xcd_barrier_complete(bar, b.x, nloc, nx); b.st[0] = nloc; b.st[1] = nx; }
        const unsigned old = xb_add(&bar[XB_XSUB(b.x)], 1u);
        const unsigned gen = old / nloc;
        if (old + 1u == (gen + 1u) * nloc) {
            __builtin_amdgcn_fence(__ATOMIC_RELEASE, "agent");
            asm volatile("s_waitcnt vmcnt(0)" ::: "memory");
            const unsigned og = xb_add(&bar[XB_TOP], 1u);
            const unsigned tg = og / nx;
            if (og + 1u == (tg + 1u) * nx) xb_add(&bar[XB_TOPGEN], 1u);
            else XB_SPIN(xb_ld(&bar[XB_TOPGEN]) == tg, bar);
            __builtin_amdgcn_fence(__ATOMIC_ACQUIRE, "agent");
            xb_add(&bar[XB_XGEN(b.x)], 1u);
            asm volatile("s_waitcnt vmcnt(0)" ::: "memory");
        } else {
            XB_SPIN(xb_ld(&bar[XB_XGEN(b.x)]) == gen, bar);
            __builtin_amdgcn_fence(__ATOMIC_ACQUIRE, "agent");
            asm volatile("s_waitcnt vmcnt(0)" ::: "memory");
        }
    }
    __syncthreads();
}

struct Args { const float* in[26]; float* out; unsigned char* ws; int ph_lo, ph_hi; };
__device__ __forceinline__ const float* arg_ptr(int k) { int o = k * 8; asm volatile("" : "+s"(o)); return *(const float* const*)((const char*)__builtin_amdgcn_kernarg_segment_ptr() + o); }
struct Frame {
    LAS unsigned char* lds;
    int tid, lane, wave, vcu, G;
    float* out; unsigned char* ws;
    __device__ __forceinline__ const float* x_prompt() const { return arg_ptr(0); }
    __device__ __forceinline__ const float* x_sample() const { return arg_ptr(1); }
    __device__ __forceinline__ const float* c_prompt() const { return arg_ptr(2); }
    __device__ __forceinline__ const float* c_sample() const { return arg_ptr(3); }
    __device__ __forceinline__ const float* cache_k() const { return arg_ptr(4); }
    __device__ __forceinline__ const float* cache_v() const { return arg_ptr(5); }
    __device__ __forceinline__ const float* st_h() const { return arg_ptr(6); }
    __device__ __forceinline__ const float* st_conv() const { return arg_ptr(7); }
    __device__ __forceinline__ const float* w_mod() const { return arg_ptr(8); }
    __device__ __forceinline__ const float* b_mod() const { return arg_ptr(9); }
    __device__ __forceinline__ const float* w_in() const { return arg_ptr(10); }
    __device__ __forceinline__ const float* rel_bias() const { return arg_ptr(11); }
    __device__ __forceinline__ const float* conv_w() const { return arg_ptr(12); }
    __device__ __forceinline__ const float* conv_b() const { return arg_ptr(13); }
    __device__ __forceinline__ const float* w_rg_a() const { return arg_ptr(14); }
    __device__ __forceinline__ const float* b_rg_a() const { return arg_ptr(15); }
    __device__ __forceinline__ const float* w_rg_x() const { return arg_ptr(16); }
    __device__ __forceinline__ const float* b_rg_x() const { return arg_ptr(17); }
    __device__ __forceinline__ const float* rg_lambda() const { return arg_ptr(18); }
    __device__ __forceinline__ const float* w_pa() const { return arg_ptr(19); }
    __device__ __forceinline__ const float* w_pr() const { return arg_ptr(20); }
    __device__ __forceinline__ const float* w_out() const { return arg_ptr(21); }
    __device__ __forceinline__ const float* w_gate() const { return arg_ptr(22); }
    __device__ __forceinline__ const float* w_up() const { return arg_ptr(23); }
    __device__ __forceinline__ const float* w_down() const { return arg_ptr(24); }
    __device__ __forceinline__ const float* fng() const { return arg_ptr(25); }
    __device__ __forceinline__ float* mod() const { return (float*)(ws + WS_MOD); }
    __device__ __forceinline__ float* x1() const { return (float*)(ws + WS_OY); }
    __device__ __forceinline__ float* slab4() const { return (float*)(ws + WS_SLAB4); }
    __device__ __forceinline__ float* slab6() const { return (float*)(ws + WS_SLAB6); }
    __device__ __forceinline__ float* slab9() const { return (float*)(ws + WS_SLAB9); }
    __device__ __forceinline__ bf16_t* Win_t() const { return (bf16_t*)(ws + WS_WIN); }
    __device__ __forceinline__ bf16_t* Wproj_t() const { return (bf16_t*)(ws + WS_WPROJ); }
    __device__ __forceinline__ bf16_t* Wout_t() const { return (bf16_t*)(ws + WS_WOUT); }
    __device__ __forceinline__ bf16_t* Wgu_t() const { return (bf16_t*)(ws + WS_WGU); }
    __device__ __forceinline__ bf16_t* Wdn_t() const { return (bf16_t*)(ws + WS_WDN); }
    __device__ __forceinline__ bf16_t* Wrg_t() const { return (bf16_t*)(ws + WS_WRG); }
    __device__ __forceinline__ bf16_t* H1() const { return (bf16_t*)(ws + WS_H1); }
    __device__ __forceinline__ bf16_t* Qb() const { return (bf16_t*)(ws + WS_Q); }
    __device__ __forceinline__ bf16_t* Kb() const { return (bf16_t*)(ws + WS_K); }
    __device__ __forceinline__ bf16_t* Vb() const { return (bf16_t*)(ws + WS_V); }
    __device__ __forceinline__ bf16_t* Ub() const { return (bf16_t*)(ws + WS_U); }
    __device__ __forceinline__ bf16_t* Gb() const { return (bf16_t*)(ws + WS_G); }
    __device__ __forceinline__ bf16_t* SAb() const { return (bf16_t*)(ws + WS_SA); }
    __device__ __forceinline__ bf16_t* SRb() const { return (bf16_t*)(ws + WS_SR); }
    __device__ __forceinline__ bf16_t* OY() const { return (bf16_t*)(ws + WS_OY); }
    __device__ __forceinline__ bf16_t* MG() const { return (bf16_t*)(ws + WS_MERGED); }
    __device__ __forceinline__ bf16_t* ACT() const { return (bf16_t*)(ws + WS_ACT); }
    __device__ __forceinline__ gu64* gran() const { return (gu64*)(ws + WS_GRAN); }
    __device__ __forceinline__ void refresh() { int t = threadIdx.x; asm volatile("" : "+v"(t)); tid = t; lane = t & 63; wave = __builtin_amdgcn_readfirstlane(t >> 6); }
};

__device__ __forceinline__ void xpose_item(const float* W, int N, bf16_t* WT, size_t ldo, int k0, int n0, int drow0, int dcol0, LAS float* scr, int lane) {
#pragma unroll 8
    for (int i = 0; i < 32; ++i) { const int kk = 2 * i + (lane >> 5); scr[kk * 33 + (lane & 31)] = W[(size_t)(k0 + kk) * N + n0 + (lane & 31)]; }
    LDS_WAIT(); asm volatile("" ::: "memory");
    const int c = lane & 7;
#pragma unroll
    for (int j = 0; j < 4; ++j) { const int n = (lane >> 3) + 8 * j; const LAS float* s = scr + (8 * c) * 33 + n;
        v4u o; o.x = pk2(s[0 * 33], s[1 * 33]); o.y = pk2(s[2 * 33], s[3 * 33]); o.z = pk2(s[4 * 33], s[5 * 33]); o.w = pk2(s[6 * 33], s[7 * 33]);
        *(GAS v4u*)(WT + (size_t)(drow0 + n) * ldo + dcol0 + 8 * c) = o; }
    LDS_WAIT(); asm volatile("" ::: "memory");
}
__device__ __forceinline__ void norm_regs_bf16(const f32x4 (&v)[8], const float* shift, const float* scale, bf16_t* orow, int lane) {
    f32x4 sc[8], sh[8];
#pragma unroll
    for (int j = 0; j < 8; ++j) { sc[j] = *((const GAS f32x4*)scale + lane + 64 * j); sh[j] = *((const GAS f32x4*)shift + lane + 64 * j); }
    float s = 0.f;
#pragma unroll
    for (int j = 0; j < 8; ++j) s += (v[j].x * v[j].x + v[j].y * v[j].y) + (v[j].z * v[j].z + v[j].w * v[j].w);
    const float rinv = rsqrtf(wave_sum(s) * (1.f / DM) + EPS);
    GAS v2u* o8 = (GAS v2u*)orow + lane;
#pragma unroll
    for (int j = 0; j < 8; ++j) { const f32x4 y = v[j] * rinv * (sc[j] + 1.f) + sh[j]; v2u w; w.x = pk2(y.x, y.y); w.y = pk2(y.z, y.w); o8[64 * j] = w; }
}
__device__ __forceinline__ void load_row(f32x4 (&v)[8], const float* row, int lane) {
    const GAS f32x4* xr = (const GAS f32x4*)row + lane;
#pragma unroll
    for (int j = 0; j < 8; ++j) v[j] = xr[64 * j];
}
__device__ __forceinline__ void phase0(Frame& F, bool dry = false) {
    const float* p_cp = F.c_prompt(); const float* p_cs = F.c_sample(); const float* p_wm = F.w_mod(); const float* p_bm = F.b_mod(); float* p_mod = F.mod(); const float* p_win = F.w_in(); bf16_t* p_wint = F.Win_t();
    { gu64* g = F.gran(); for (size_t i = (size_t)F.vcu * 512 + F.tid; i < 3 * 131072; i += (size_t)F.G * 512) g[i] = 0ull; }
    LAS float* sc = (LAS float*)(F.lds);
    LAS float* red = (LAS float*)(F.lds + 8192);
    for (int it = F.vcu; it < 768; it += F.G) {
        const int nc = it % 48, ks = it / 48;
        for (int i = F.tid; i < 1280; i += 512) { const int b = i >> 7, k = ks * 128 + (i & 127);
            const float cv = b < 2 ? p_cp[b * DM + k] : p_cs[(b - 2) * DM + k];
            sc[i] = cv * sigm(cv); }
        __syncthreads();
        f32x4 acc[10];
#pragma unroll
        for (int b = 0; b < 10; ++b) acc[b] = (f32x4){0.f, 0.f, 0.f, 0.f};
        const float* wp = p_wm + (size_t)(ks * 128 + F.wave * 16) * NMOD + nc * 256 + 4 * F.lane;
#pragma unroll 4
        for (int kk = 0; kk < 16; ++kk) { const f32x4 w = *(const GAS f32x4*)(wp + (size_t)kk * NMOD);
#pragma unroll
            for (int b = 0; b < 10; ++b) { const float s = sc[b * 128 + F.wave * 16 + kk]; acc[b] += w * s; } }
#pragma unroll
        for (int b = 0; b < 10; ++b) *(LAS f32x4*)(red + (F.wave * 10 + b) * 256 + 4 * F.lane) = acc[b];
        __syncthreads();
        for (int o = F.tid; o < 2560; o += 512) { const int b = o >> 8, col = o & 255; float s = 0.f;
#pragma unroll
            for (int w = 0; w < 8; ++w) s += red[(w * 10 + b) * 256 + col];
            if (ks == 0) s += p_bm[nc * 256 + col];
            if (!dry) atomicAdd(p_mod + (size_t)b * NMOD + nc * 256 + col, s); }
        __syncthreads();
    }
    LAS float* scr = (LAS float*)(F.lds + F.wave * 16384);
    const int gw = F.vcu * NWAVES + F.wave, NGW = F.G * NWAVES;
    for (int it = gw; it < 32 * 448; it += NGW) { const int kb = it / 448, nb = it % 448;
        xpose_item(p_win, NIN, p_wint, DM, kb * 64, nb * 32, nb * 32, kb * 64, scr, F.lane); }
}
constexpr int I_P = 32 * 64, I_G = 32 * 176, I_D = 88 * 64, I_R = 256;
constexpr int NITEMS_A = 3 * I_P + I_R, NITEMS_B = 2 * I_G + I_D;
__device__ __forceinline__ void conv_item_a(Frame& F, int r, LAS float* scr) {
    if (r < I_P) { const int kb = r / 64, nb = r % 64; xpose_item(F.w_pa(), DM, F.Wproj_t(), 4096, kb * 64, nb * 32, nb * 32, kb * 64, scr, F.lane); return; } r -= I_P;
    if (r < I_P) { const int kb = r / 64, nb = r % 64; xpose_item(F.w_pr(), DM, F.Wproj_t(), 4096, kb * 64, nb * 32, nb * 32, 2048 + kb * 64, scr, F.lane); return; } r -= I_P;
    if (r < I_P) { const int kb = r / 64, nb = r % 64; xpose_item(F.w_out(), DM, F.Wout_t(), DM, kb * 64, nb * 32, nb * 32, kb * 64, scr, F.lane); return; } r -= I_P;
    { const int mat = r >> 3, sub = r & 7, kb = sub >> 2, nb = sub & 3;
      const float* src = (mat < 16 ? F.w_rg_a() : F.w_rg_x()) + (size_t)(mat & 15) * 16384;
      xpose_item(src, 128, F.Wrg_t() + (size_t)mat * 16384, 128, kb * 64, nb * 32, nb * 32, kb * 64, scr, F.lane); }
}
__device__ __forceinline__ void conv_item_b(Frame& F, int r, LAS float* scr) {
    if (r < I_G) { const int kb = r / 176, nb = r % 176, n0 = nb * 32; xpose_item(F.w_gate(), DFF, F.Wgu_t(), DM, kb * 64, n0, (n0 >> 7) * 256 + (n0 & 127), kb * 64, scr, F.lane); return; } r -= I_G;
    if (r < I_G) { const int kb = r / 176, nb = r % 176, n0 = nb * 32; xpose_item(F.w_up(), DFF, F.Wgu_t(), DM, kb * 64, n0, (n0 >> 7) * 256 + 128 + (n0 & 127), kb * 64, scr, F.lane); return; } r -= I_G;
    { const int kb = r / 64, nb = r % 64; xpose_item(F.w_down(), DM, F.Wdn_t(), DFF, kb * 64, nb * 32, nb * 32, kb * 64, scr, F.lane); }
}
__device__ __forceinline__ void phase1(Frame& F) {
    const float* p_xp = F.x_prompt(); const float* p_xs = F.x_sample(); const float* p_mod = F.mod(); bf16_t* p_H1 = F.H1(); const float* p_sl6 = F.slab6(); const float* p_sl9 = F.slab9(); float* p_x1 = F.x1(); const float* p_fng = F.fng();
    LAS float* scr = (LAS float*)(F.lds + F.wave * 16384);
    const int gw = F.vcu * NWAVES + F.wave, NGW = F.G * NWAVES;
    for (int it = gw; it < NITEMS_A; it += NGW) conv_item_a(F, it, scr);
    for (int m = gw; m < MPAD; m += NGW) {
        bf16_t* orow = p_H1 + (size_t)m * DM;
        if (m >= MV) { GAS v2u* o8 = (GAS v2u*)orow + F.lane;
#pragma unroll
            for (int j = 0; j < 8; ++j) o8[64 * j] = (v2u){0u, 0u};
            continue; }
        const float* xrow = m < MP ? p_xp + (size_t)m * DM : p_xs + (size_t)(m - MP) * DM;
        const int seq = m < MP ? (m >> 12) : 2 + ((m - MP) >> 4);
        const float* md = p_mod + (size_t)seq * NMOD;
        f32x4 v[8]; load_row(v, xrow, F.lane);
        norm_regs_bf16(v, md, md + DM, orow, F.lane);
    }
}
__device__ __forceinline__ void phase_norm2s(Frame& F, int gw, int NGW, unsigned* ready) {
    const float* p_xs = F.x_sample(); const float* p_mod = F.mod(); bf16_t* p_H1 = F.H1(); const float* p_sl6 = F.slab6(); float* p_x1 = F.x1();
    for (int r = gw; r < MS; r += NGW) { const int m = MP + r;
        const float* md = p_mod + (size_t)(2 + (r >> 4)) * NMOD;
        f32x4 v[8], a[8]; load_row(v, p_xs + (size_t)r * DM, F.lane); load_row(a, p_sl6 + (size_t)r * DM, F.lane);
#pragma unroll 5
        for (int k = 1; k < NSL6; ++k) { f32x4 t[8]; load_row(t, p_sl6 + (size_t)(k * 128 + r) * DM, F.lane);
#pragma unroll
            for (int j = 0; j < 8; ++j) a[j] += t[j]; }
        GAS f32x4* xo = (GAS f32x4*)(p_x1 + (size_t)m * DM) + F.lane;
#pragma unroll
        for (int j = 0; j < 8; ++j) { const f32x4 g = *((const GAS f32x4*)(md + 2 * DM) + F.lane + 64 * j); v[j] = v[j] + g * a[j]; xo[64 * j] = v[j]; }
        norm_regs_bf16(v, md + 3 * DM, md + 4 * DM, p_H1 + (size_t)m * DM, F.lane);
        asm volatile("s_waitcnt vmcnt(0)" ::: "memory");
        __builtin_amdgcn_fence(__ATOMIC_RELEASE, "agent");
        asm volatile("s_waitcnt vmcnt(0)" ::: "memory");
        if (F.lane == 0) __hip_atomic_fetch_add(ready, 1u, __ATOMIC_RELAXED, __HIP_MEMORY_SCOPE_AGENT);
    }
}
__device__ __forceinline__ void phase_finals(Frame& F) {
    const float* p_mod = F.mod(); const float* p_sl9 = F.slab9(); const float* p_x1 = F.x1(); const float* p_fng = F.fng();
    const int gw = F.vcu * NWAVES + F.wave, NGW = F.G * NWAVES;
    for (int r = gw; r < MS; r += NGW) { const int m = MP + r;
        f32x4 v[8], a[8]; load_row(v, p_x1 + (size_t)m * DM, F.lane); load_row(a, p_sl9 + (size_t)r * DM, F.lane);
#pragma unroll 7
        for (int k = 1; k < NSL9; ++k) { f32x4 t[8]; load_row(t, p_sl9 + (size_t)(k * 128 + r) * DM, F.lane);
#pragma unroll
            for (int j = 0; j < 8; ++j) a[j] += t[j]; }
        const float* md = p_mod + (size_t)(2 + (r >> 4)) * NMOD + 5 * DM;
        float s = 0.f;
#pragma unroll
        for (int j = 0; j < 8; ++j) { const f32x4 g = *((const GAS f32x4*)md + F.lane + 64 * j); v[j] = v[j] + g * a[j]; s += (v[j].x * v[j].x + v[j].y * v[j].y) + (v[j].z * v[j].z + v[j].w * v[j].w); }
        const float rinv = rsqrtf(wave_sum(s) * (1.f / DM) + EPS);
        GAS f32x4* xr = (GAS f32x4*)(F.out + (size_t)m * DM) + F.lane;
#pragma unroll
        for (int j = 0; j < 8; ++j) xr[64 * j] = v[j] * rinv * *((const GAS f32x4*)p_fng + F.lane + 64 * j);
    }
}
__device__ __forceinline__ void phase_mgs(Frame& F, unsigned* ready) {
    const GAS f32x4* src = (const GAS f32x4*)F.slab4(); GAS v2u* dst = (GAS v2u*)(F.MG() + (size_t)MP * DM);
    for (int i = F.vcu * 512 + F.tid; i < 128 * DM / 4; i += F.G * 512) { f32x4 a = src[i];
#pragma unroll 8
        for (int k = 1; k < NSL4; ++k) a += src[(size_t)k * (128 * DM / 4) + i];
        v2u w; w.x = pk2(a.x, a.y); w.y = pk2(a.z, a.w); dst[i] = w; }
    asm volatile("s_waitcnt vmcnt(0)" ::: "memory"); __syncthreads();
    if (F.tid == 0) { __builtin_amdgcn_fence(__ATOMIC_RELEASE, "agent"); asm volatile("s_waitcnt vmcnt(0)" ::: "memory"); __hip_atomic_fetch_add(ready, 1u, __ATOMIC_RELAXED, __HIP_MEMORY_SCOPE_AGENT); }
}

constexpr int RG_WL = 4352, RG_W = 34816, RG_TOT = 104448, RG_PRE = 112640, RG_HIN = 120832, RG_TAB = 121344;
__device__ __forceinline__ float gran_poll(gu64* g) {
    unsigned spins = 0;
    for (;;) { const unsigned long long x = __hip_atomic_load(g, RLX_AGENT); if ((unsigned)(x >> 32) == 1u) return __uint_as_float((unsigned)x);
        __builtin_amdgcn_s_sleep(1); if (++spins > (1u << 17)) return 0.f; }
}
__device__ __forceinline__ void rglru_prologue(Frame& F, int n) {
    const bf16_t* p_Wrg = F.Wrg_t();
    for (int i = F.tid; i < 4096; i += 512) { const int row = i >> 4, ch = i & 15;
        const v4u wv = *(const GAS v4u*)(p_Wrg + (size_t)((row >> 7) * 16 + n) * 16384 + (row & 127) * 128 + ch * 8);
        *(LAS v4u*)(F.lds + RG_W + row * 272 + ch * 16) = wv; }
    if (F.tid < 128) { const int c = n * 128 + F.tid; LAS float* tab = (LAS float*)(F.lds + RG_TAB);
        tab[F.tid] = -8.f * log1pf(__expf(-F.rg_lambda()[c])); tab[128 + F.tid] = F.b_rg_a()[c]; tab[256 + F.tid] = F.b_rg_x()[c]; }
    __syncthreads();
}
template <bool SAMPLE>
__device__ __forceinline__ void rglru_unit(Frame& F, int bn, int j) {
    const int w = F.wave, lane = F.lane, fr = lane & 15, fq = lane >> 4;
    const float* p_conv_w = F.conv_w(); const float* p_conv_b = F.conv_b(); const float* p_st_conv = F.st_conv(); const float* p_st_h = F.st_h();
    const bf16_t* p_Ub = F.Ub(); const bf16_t* p_Gb = F.Gb(); bf16_t* p_OY = F.OY(); gu64* p_gran = F.gran();
    int n, seq; long row0;
    if (SAMPLE) { n = bn; seq = 2 + w; row0 = MP + w * 16; } else { seq = bn >> 4; n = bn & 15; row0 = (long)seq * TP + j * 128 + w * 16; }
    const int cb = n * 128;
    LAS unsigned char* wl = F.lds + w * RG_WL;
    const LAS float* tab = (const LAS float*)(F.lds + RG_TAB);
    v4u gpre[4];
#pragma unroll
    for (int i = 0; i < 4; ++i) { const int r = (lane >> 4) + 4 * i; gpre[i] = *(const GAS v4u*)(p_Gb + (size_t)(row0 + r) * DM + cb + (lane & 15) * 8); }
    {
        const int c2 = cb + 2 * lane;
        float cw0[4], cw1[4];
#pragma unroll
        for (int k = 0; k < 4; ++k) { cw0[k] = p_conv_w[k * DM + c2]; cw1[k] = p_conv_w[k * DM + c2 + 1]; }
        const float cb0 = p_conv_b[c2], cb1 = p_conv_b[c2 + 1];
        float u0[19], u1[19];
#pragma unroll
        for (int i = 0; i < 19; ++i) { const int rr = i - 3;
            if (rr < 0) {
                if (SAMPLE) { u0[i] = p_st_conv[(size_t)(w * 3 + i) * DM + c2]; u1[i] = p_st_conv[(size_t)(w * 3 + i) * DM + c2 + 1]; }
                else if (j == 0 && w == 0) { u0[i] = 0.f; u1[i] = 0.f; }
                else { const unsigned p = *(const GAS unsigned*)(p_Ub + (size_t)(row0 + rr) * DM + c2); u0[i] = bflo(p); u1[i] = bfhi(p); }
            } else { const unsigned p = *(const GAS unsigned*)(p_Ub + (size_t)(row0 + rr) * DM + c2); u0[i] = bflo(p); u1[i] = bfhi(p); } }
#pragma unroll
        for (int tt = 0; tt < 16; ++tt) {
            const float x0 = cb0 + cw0[0] * u0[tt] + cw0[1] * u0[tt + 1] + cw0[2] * u0[tt + 2] + cw0[3] * u0[tt + 3];
            const float x1 = cb1 + cw1[0] * u1[tt] + cw1[1] * u1[tt + 1] + cw1[2] * u1[tt + 2] + cw1[3] * u1[tt + 3];
            *(LAS unsigned*)(wl + tt * 272 + lane * 4) = pk2(x0, x1); }
    }
    LDS_WAIT(); asm volatile("" ::: "memory");
    f32x4 acc[2][8];
#pragma unroll
    for (int a = 0; a < 2; ++a)
#pragma unroll
        for (int g = 0; g < 8; ++g) acc[a][g] = (f32x4){0.f, 0.f, 0.f, 0.f};
#pragma unroll
    for (int ks = 0; ks < 4; ++ks) { const bf16x8 a = *(const LAS bf16x8*)(wl + fr * 272 + (32 * ks + 8 * fq) * 2);
#pragma unroll
        for (int wh = 0; wh < 2; ++wh)
#pragma unroll
            for (int g = 0; g < 8; ++g) { const bf16x8 b = *(const LAS bf16x8*)(F.lds + RG_W + (wh * 128 + 16 * g + fr) * 272 + (32 * ks + 8 * fq) * 2);
                acc[wh][g] = __builtin_amdgcn_mfma_f32_16x16x32_bf16(a, b, acc[wh][g], 0, 0, 0); } }
    float Al[8][4], Hl[8][4], HS[8], EA[8], EH[8];
#pragma unroll
    for (int g = 0; g < 8; ++g) {
        const int cl = 16 * g + fr, c = cb + cl;
        const float c8 = tab[cl], ba = tab[128 + cl], bx = tab[256 + cl];
        float A = 1.f, H = 0.f;
#pragma unroll
        for (int reg = 0; reg < 4; ++reg) { const int tt = 4 * fq + reg;
            const float xcv = bf2f(*(const LAS unsigned short*)(wl + tt * 272 + cl * 2));
            const float r = sigm(acc[0][g][reg] + ba), ii = sigm(acc[1][g][reg] + bx);
            const float la = c8 * r, a = __expf(la), bb = __builtin_amdgcn_sqrtf(fmaxf(1.f - a * a, 0.f)) * (ii * xcv);
            H = a * H + bb; A = a * A; Al[g][reg] = A; Hl[g][reg] = H; }
        float IA = A, IH = H;
        { const float xa = __shfl_up(IA, 16), xh = __shfl_up(IH, 16); if (fq >= 1) { IH = IA * xh + IH; IA = IA * xa; } }
        { const float xa = __shfl_up(IA, 32), xh = __shfl_up(IH, 32); if (fq >= 2) { IH = IA * xh + IH; IA = IA * xa; } }
        { const float xa = __shfl_up(IA, 16), xh = __shfl_up(IH, 16); EA[g] = fq ? xa : 1.f; EH[g] = fq ? xh : 0.f; }
        if (SAMPLE) { const float h0 = p_st_h[(size_t)w * DM + c]; HS[g] = EA[g] * h0 + EH[g];
            if (fq == 3) F.out[O_SH + (size_t)w * DM + c] = IA * h0 + IH; }
        else { HS[g] = 0.f; if (fq == 3) *(LAS f32x2*)(F.lds + RG_TOT + (w * 128 + cl) * 8) = (f32x2){IA, IH}; }
    }
#pragma unroll
    for (int i = 0; i < 4; ++i) { const int r = (lane >> 4) + 4 * i; *(LAS v4u*)(wl + r * 272 + (lane & 15) * 16) = gpre[i]; }
    if (!SAMPLE) {
        __syncthreads();
        if (F.tid < 128) { const int c = F.tid; float PA = 1.f, PH = 0.f;
#pragma unroll
            for (int w2 = 0; w2 < 8; ++w2) { *(LAS f32x2*)(F.lds + RG_PRE + (w2 * 128 + c) * 8) = (f32x2){PA, PH};
                const f32x2 t = *(const LAS f32x2*)(F.lds + RG_TOT + (w2 * 128 + c) * 8); PH = t.x * PH + t.y; PA = PA * t.x; }
            gu64* gI = p_gran + (size_t)(bn * 32) * 128 + c; gu64* gA = gI + 131072; gu64* gB = gI + 262144;
            if (j < 31) { __hip_atomic_store(gA + j * 128, (1ull << 32) | (unsigned long long)__float_as_uint(PA), RLX_AGENT);
                          __hip_atomic_store(gB + j * 128, (1ull << 32) | (unsigned long long)__float_as_uint(PH), RLX_AGENT); }
            float hin = 0.f;
            if (j > 0) { float fa = 1.f, fh = 0.f; int k = j - 1; unsigned spins = 0; bool done = false;
                while (!done) {
                    unsigned long long xi[8], xa[8], xb[8];
#pragma unroll
                    for (int i = 0; i < 8; ++i) { const int kk = k - i < 0 ? 0 : k - i; xi[i] = __hip_atomic_load(gI + kk * 128, RLX_AGENT); xa[i] = __hip_atomic_load(gA + kk * 128, RLX_AGENT); xb[i] = __hip_atomic_load(gB + kk * 128, RLX_AGENT); }
                    bool stuck = false;
#pragma unroll
                    for (int i = 0; i < 8; ++i) { if (!done && !stuck) {
                        if ((unsigned)(xi[i] >> 32) == 1u) { hin = fa * __uint_as_float((unsigned)xi[i]) + fh; done = true; }
                        else if ((unsigned)(xa[i] >> 32) == 1u && (unsigned)(xb[i] >> 32) == 1u) { fh = fa * __uint_as_float((unsigned)xb[i]) + fh; fa = fa * __uint_as_float((unsigned)xa[i]); --k; if (k < 0) { hin = fh; done = true; } }
                        else stuck = true; } }
                    if (!done) { __builtin_amdgcn_s_sleep(1); if (++spins > (1u << 16)) break; }
                } }
            const float hout = PA * hin + PH;
            if (j < 31) __hip_atomic_store(gI + j * 128, (1ull << 32) | (unsigned long long)__float_as_uint(hout), RLX_AGENT);
            else F.out[O_PH + (size_t)seq * DM + cb + c] = hout;
            *(LAS float*)(F.lds + RG_HIN + c * 4) = hin; }
        __syncthreads();
#pragma unroll
        for (int g = 0; g < 8; ++g) { const int cl = 16 * g + fr; const f32x2 p = *(const LAS f32x2*)(F.lds + RG_PRE + (w * 128 + cl) * 8);
            const float hw = p.x * *(const LAS float*)(F.lds + RG_HIN + cl * 4) + p.y; HS[g] = EA[g] * hw + EH[g]; }
    }
    LDS_WAIT(); asm volatile("" ::: "memory");
#pragma unroll
    for (int g = 0; g < 8; ++g) { const int cl = 16 * g + fr;
#pragma unroll
        for (int reg = 0; reg < 4; ++reg) { const int tt = 4 * fq + reg; LAS unsigned short* gp = (LAS unsigned short*)(wl + tt * 272 + cl * 2);
            const float h = Al[g][reg] * HS[g] + Hl[g][reg]; *gp = (unsigned short)f2bf(h * bf2f(*gp)); } }
    LDS_WAIT(); asm volatile("" ::: "memory");
#pragma unroll
    for (int i = 0; i < 4; ++i) { const int r = (lane >> 4) + 4 * i; const v4u y = *(const LAS v4u*)(wl + r * 272 + (lane & 15) * 16);
        *(GAS v4u*)(p_OY + (size_t)(row0 + r) * 4096 + 2048 + cb + (lane & 15) * 8) = y; }
    __syncthreads();
}
typedef int i32x4_t __attribute__((ext_vector_type(4)));
__device__ __forceinline__ bf16x8 pack8frag(f32x4 a, f32x4 b) { const v4u w = pack8bf(a, b); return __builtin_bit_cast(bf16x8, w); }
__device__ __forceinline__ void sattn_unit(Frame& F, int bs, int h, int qh) {
    constexpr int RS = 532;
    LAS float* scv = (LAS float*)F.lds;
    LAS float* inv = scv + 16 * RS;
    LAS float* btab = inv + 16;
    LAS float* part = btab + 320;
    const int w = F.wave, lane = F.lane, fr = lane & 15, fq = lane >> 4;
    if (F.tid < 320) btab[F.tid] = F.rel_bias()[h * 320 + F.tid];
    const unsigned lrow = (unsigned)(fr * 2048 + 8 * fq) * 4u;
    {
        bf16x8 qf[4];
#pragma unroll
        for (int ks = 0; ks < 4; ++ks) qf[ks] = *(const GAS bf16x8*)(F.Qb() + (size_t)(MP + bs * 16 + qh * 8 + (fr & 7)) * DM + h * 128 + 32 * ks + 8 * fq);
        const __amdgpu_buffer_rsrc_t rk = __builtin_amdgcn_make_buffer_rsrc((void*)(F.cache_k() + ((size_t)(bs * 512 + 64 * w) * 16 + h) * 128), 0, 0x40000000, 0x00020000);
        f32x4 kr[4][4][2];
#pragma unroll
        for (int t = 0; t < 4; ++t)
#pragma unroll
            for (int ks = 0; ks < 4; ++ks) { const int so = (16 * t * 2048 + 32 * ks) * 4;
                kr[t][ks][0] = __builtin_bit_cast(f32x4, __builtin_amdgcn_raw_buffer_load_b128(rk, lrow, so, 0));
                kr[t][ks][1] = __builtin_bit_cast(f32x4, __builtin_amdgcn_raw_buffer_load_b128(rk, lrow, so + 16, 0)); }
#pragma unroll
        for (int t = 0; t < 4; ++t) { f32x4 acc = {0.f, 0.f, 0.f, 0.f};
#pragma unroll
            for (int ks = 0; ks < 4; ++ks) acc = __builtin_amdgcn_mfma_f32_16x16x32_bf16(pack8frag(kr[t][ks][0], kr[t][ks][1]), qf[ks], acc, 0, 0, 0);
#pragma unroll
            for (int reg = 0; reg < 4; ++reg) scv[fr * RS + 64 * w + 16 * t + 4 * fq + reg] = acc[reg] * ATT_SCALE; }
        if (w == 0) {
            const __amdgpu_buffer_rsrc_t rn = __builtin_amdgcn_make_buffer_rsrc((void*)(F.out + O_SK + (size_t)(bs * 16) * DM + h * 128), 0, 0x40000000, 0x00020000);
            f32x4 acc = {0.f, 0.f, 0.f, 0.f};
#pragma unroll
            for (int ks = 0; ks < 4; ++ks) { const f32x4 a = __builtin_bit_cast(f32x4, __builtin_amdgcn_raw_buffer_load_b128(rn, lrow, 32 * ks * 4, 0)), b = __builtin_bit_cast(f32x4, __builtin_amdgcn_raw_buffer_load_b128(rn, lrow, 32 * ks * 4 + 16, 0));
                acc = __builtin_amdgcn_mfma_f32_16x16x32_bf16(pack8frag(a, b), qf[ks], acc, 0, 0, 0); }
#pragma unroll
            for (int reg = 0; reg < 4; ++reg) scv[fr * RS + 512 + 4 * fq + reg] = acc[reg] * ATT_SCALE; }
    }
    __syncthreads();
    { const int row = w, qp_ = qh * 8 + w; float mx = -1e30f;
        for (int jk = lane; jk < 528; jk += 64) { int diff = jk < 512 ? (512 + qp_ - jk) : (qp_ - (jk - 512)); diff = diff > 256 ? 256 : diff;
            const float v = scv[row * RS + jk] + btab[diff + 63]; scv[row * RS + jk] = v; mx = fmaxf(mx, v); }
        mx = wave_max(mx); float sum = 0.f;
        for (int jk = lane; jk < 528; jk += 64) { const float e = __expf(scv[row * RS + jk] - mx); scv[row * RS + jk] = e; sum += e; }
        sum = wave_sum(sum); if (lane == 0) inv[row] = 1.f / sum; }
    __syncthreads();
    {
        const unsigned lcol = (unsigned)(8 * fq * 2048 + fr) * 4u;
        const __amdgpu_buffer_rsrc_t rv = __builtin_amdgcn_make_buffer_rsrc((void*)(F.cache_v() + ((size_t)(bs * 512 + 64 * w) * 16 + h) * 128), 0, 0x40000000, 0x00020000);
        f32x4 acc[8];
#pragma unroll
        for (int dt = 0; dt < 8; ++dt) acc[dt] = (f32x4){0.f, 0.f, 0.f, 0.f};
#pragma unroll
        for (int kt = 0; kt < 2; ++kt) {
            float vv[8][8];
#pragma unroll
            for (int dt = 0; dt < 8; ++dt)
#pragma unroll
                for (int j = 0; j < 8; ++j) vv[dt][j] = __builtin_bit_cast(float, __builtin_amdgcn_raw_buffer_load_b32(rv, lcol, ((32 * kt + j) * 2048 + 16 * dt) * 4, 0));
            const LAS f32x4* pp = (const LAS f32x4*)(scv + fr * RS + 64 * w + 32 * kt + 8 * fq);
            const bf16x8 pf = pack8frag(pp[0], pp[1]);
#pragma unroll
            for (int dt = 0; dt < 8; ++dt) { const bf16x8 bfr = pack8frag((f32x4){vv[dt][0], vv[dt][1], vv[dt][2], vv[dt][3]}, (f32x4){vv[dt][4], vv[dt][5], vv[dt][6], vv[dt][7]});
                acc[dt] = __builtin_amdgcn_mfma_f32_16x16x32_bf16(pf, bfr, acc[dt], 0, 0, 0); }
        }
        if (w == 0) {
            const __amdgpu_buffer_rsrc_t rn = __builtin_amdgcn_make_buffer_rsrc((void*)(F.out + O_SV + (size_t)(bs * 16) * DM + h * 128), 0, 0x40000000, 0x00020000);
            const unsigned lcn = (unsigned)(8 * (fq & 1) * 2048 + fr) * 4u;
            float vv[8][8];
#pragma unroll
            for (int dt = 0; dt < 8; ++dt)
#pragma unroll
                for (int j = 0; j < 8; ++j) vv[dt][j] = __builtin_bit_cast(float, __builtin_amdgcn_raw_buffer_load_b32(rn, lcn, (j * 2048 + 16 * dt) * 4, 0));
            const LAS f32x4* pp = (const LAS f32x4*)(scv + fr * RS + 512 + 8 * (fq & 1));
            f32x4 p0 = pp[0], p1 = pp[1]; if (fq >= 2) { p0 = (f32x4){0.f, 0.f, 0.f, 0.f}; p1 = p0; }
            const bf16x8 pf = pack8frag(p0, p1);
#pragma unroll
            for (int dt = 0; dt < 8; ++dt) { const bf16x8 bfr = pack8frag((f32x4){vv[dt][0], vv[dt][1], vv[dt][2], vv[dt][3]}, (f32x4){vv[dt][4], vv[dt][5], vv[dt][6], vv[dt][7]});
                acc[dt] = __builtin_amdgcn_mfma_f32_16x16x32_bf16(pf, bfr, acc[dt], 0, 0, 0); }
        }
#pragma unroll
        for (int dt = 0; dt < 8; ++dt)
#pragma unroll
            for (int reg = 0; reg < 4; ++reg) part[(w * 16 + 4 * fq + reg) * 128 + 16 * dt + fr] = acc[dt][reg];
    }
    __syncthreads();
    { const int row = F.tid >> 6, c2 = (F.tid & 63) * 2; f32x2 a = {0.f, 0.f};
#pragma unroll
      for (int w2 = 0; w2 < 8; ++w2) a += *(const LAS f32x2*)(part + (w2 * 16 + row) * 128 + c2);
      a = a * inv[row];
      *(GAS unsigned*)(F.OY() + (size_t)(MP + bs * 16 + qh * 8 + row) * 4096 + h * 128 + c2) = pk2(a.x, a.y); }
    __syncthreads();
}
__device__ __forceinline__ att::BlockRef att_ref(Frame& F, int L) {
    const int bh = L >> 4, qb = L & 15, b = bh >> 4, h = bh & 15;
    att::BlockRef r; const size_t rb = (size_t)b * TP;
    r.Q = F.Qb() + (rb + (size_t)qb * 256) * DM + h * 128; r.K = F.Kb() + rb * DM + h * 128; r.V = F.Vb() + rb * DM + h * 128;
    r.O = F.OY() + (rb + (size_t)qb * 256) * 4096 + h * 128; r.qb = qb; r.h = h; return r;
}
template <int pmask>
__device__ __forceinline__ void phase3(Frame& F, char* ldsg) {
    int wn = -1;
    if (pmask & 1) for (int id = F.vcu; id < 1024; id += F.G) { const int bn = id & 31; if ((bn & 15) != wn) { wn = bn & 15; rglru_prologue(F, wn); } rglru_unit<false>(F, bn, id >> 5); }
    if (pmask & 2) { if ((F.G & 15) == 0) { if ((F.vcu & 15) == 0 && (F.vcu >> 4) < 16) { const int n = F.vcu >> 4; if (n != wn) { wn = n; rglru_prologue(F, wn); } rglru_unit<true>(F, n, 0); } }
        else for (int n = F.vcu; n < 16; n += F.G) { if (n != wn) { wn = n; rglru_prologue(F, wn); } rglru_unit<true>(F, n, 0); } }
    if (pmask & 4) for (int u = F.vcu; u < 256; u += F.G) sattn_unit(F, u >> 5, (u >> 1) & 15, u & 1);
    for (int i = F.tid; i < 5120; i += 512) ((LAS float*)(F.lds + att::BIAS_OFF))[i] = F.rel_bias()[i];
    __syncthreads();
    int L = F.vcu;
    if ((pmask & 8) && L < 512) {
        att::BlockRef cur = att_ref(F, L); att::Seam S; att::att_prime(cur, ldsg, S);
        for (;;) { const bool more = L + F.G < 512; const int Ln = more ? L + F.G : L; const att::BlockRef nxt = more ? att_ref(F, Ln) : cur;
            att::att_block(cur, nxt, ldsg, S); if (!more) break; cur = nxt; L = Ln; }
    }
}

__global__ void __launch_bounds__(NWAVES * 64, 2) fwd(Args args) {
    extern __shared__ __attribute__((aligned(16))) unsigned char lds[];
    Frame F;
    F.lds = (LAS unsigned char*)lds;
    F.tid = threadIdx.x; F.lane = F.tid & 63; F.wave = __builtin_amdgcn_readfirstlane(F.tid >> 6);
    F.G = gridDim.x; { const int bx = blockIdx.x; F.vcu = (F.G % 8 == 0) ? (bx % 8) * (F.G / 8) + bx / 8 : bx; }
    F.out = args.out; F.ws = args.ws;
    unsigned char* ws = args.ws;
    for (int u = F.tid; u < (LDS_BYTES - LDSCTL_OFF) / 4; u += NWAVES * 64) ((LAS unsigned*)(F.lds + LDSCTL_OFF))[u] = 0u;
    __syncthreads();
#if !MK_MULTI
    XcdBarrier bar = xcd_barrier_post((unsigned*)(ws + WS_CTL) + CW_BAR, (volatile LAS unsigned*)(F.lds + MISC_OFF) + 8);
#define GRID_BAR() xcd_barrier(bar)
#else
#define GRID_BAR() do { } while (0)
#endif
    const int lo = args.ph_lo, hi = args.ph_hi;
#ifndef PHMASK
#define PHMASK 0x1ff
#endif
#define IN(k) (((PHMASK >> (k)) & 1) && lo <= (k) && (k) < hi)
#define SEAM(k) do { if (lo <= (k) && (k) + 1 < hi && (k) < 8) GRID_BAR(); } while (0)
#ifndef REP_PHASE
#define REP_PHASE -1
#endif
#define RUNPH(k, ...) do { if (IN(k)) { __VA_ARGS__ } if (REP_PHASE == (k) && IN(k)) { GRID_BAR(); __VA_ARGS__ } SEAM(k); } while (0)
    RUNPH(0, F.refresh(); phase0(F); );
    if (REP_PHASE == 100 && IN(0)) { phase0(F, true); GRID_BAR(); }
    RUNPH(1, F.refresh(); phase1(F); );
    RUNPH(2, F.refresh(); pg8::Gemm g{F.H1(), F.Win_t(), MPAD, NIN, DM}; pg8::StaticOrder S; S.init(MPAD, NIN, DM, F.G, (int)blockIdx.x);
        EpiIn E{F.Qb(), F.out}; pg8::gemm_phase<EpiIn, pg8::StaticOrder, true, true>(F.lds, g, S, E);
        { const int nlast = S.nwg % F.G, nfree = nlast ? F.G - nlast : F.G, fidx = nlast ? (int)blockIdx.x - nlast : (int)blockIdx.x;
          if (fidx >= 0) { LAS float* scr = (LAS float*)(F.lds + F.wave * 16384);
              for (int it = fidx * NWAVES + F.wave; it < NITEMS_B; it += nfree * NWAVES) conv_item_b(F, it, scr); } } );
    RUNPH(3, F.refresh(); phase3<15>(F, (char*)lds); );
    if (REP_PHASE > 100 && REP_PHASE < 116 && IN(3)) { F.refresh(); phase3<(REP_PHASE > 100 ? REP_PHASE - 100 : 15)>(F, (char*)lds); GRID_BAR(); }
    RUNPH(4, F.refresh(); pg8::Gemm g{F.OY(), F.Wproj_t(), MPAD, DM, 2 * DM}; pg8::HybridOrder S; S.init(DM, 2 * DM, F.G, (int)blockIdx.x, 2);
        EpiProj E{F.SAb(), F.SRb(), F.MG(), F.slab4()}; pg8::gemm_phase<EpiProj, pg8::HybridOrder, true, true>(F.lds, g, S, E); );
    RUNPH(5, F.refresh(); pg8::Gemm g{F.MG(), F.Wout_t(), MPAD, DM, DM}; pg8::HybridOrder S; S.init(DM, DM, F.G, (int)blockIdx.x, 2);
        unsigned* rdy = (unsigned*)(F.ws + WS_CTL) + CW_READY + 64; S.ready = rdy; S.need = (unsigned)F.G;
        phase_mgs(F, rdy);
        EpiResNorm E{F.x_prompt(), F.x1(), F.H1(), F.mod(), F.slab6(), F.lds + XL_OFF, (unsigned long long*)(F.ws + WS_XW)};
        pg8::gemm_phase<EpiResNorm, pg8::HybridOrder, true, true>(F.lds, g, S, E); );
    RUNPH(6, F.refresh(); pg8::Gemm g{F.H1(), F.Wgu_t(), MPAD, NGU, DM}; pg8::SampleGatedOrder S; S.init(MPAD, NGU, DM, F.G, (int)blockIdx.x);
        unsigned* ready = (unsigned*)(F.ws + WS_CTL) + CW_READY; S.ready = ready; S.need = MS;
        { const int nlast = S.nwg % F.G, nfree = nlast ? F.G - nlast : F.G, fidx = nlast ? (int)blockIdx.x - nlast : (int)blockIdx.x;
          if (fidx >= 0) phase_norm2s(F, fidx * NWAVES + F.wave, nfree * NWAVES, ready); }
        EpiGU E{F.ACT()}; pg8::gemm_phase<EpiGU, pg8::SampleGatedOrder, true, true>(F.lds, g, S, E); );
    RUNPH(7, F.refresh(); pg8::Gemm g{F.ACT(), F.Wdn_t(), MPAD, DM, DFF}; pg8::HybridOrder S; S.init(DM, DFF, F.G, (int)blockIdx.x, 4);
        EpiResFinal E{F.x1(), F.out, F.mod(), F.fng(), F.slab9(), F.lds + XL_OFF, (unsigned long long*)(F.ws + WS_XW) + 32 * 256};
        pg8::gemm_phase<EpiResFinal, pg8::HybridOrder, true, true>(F.lds, g, S, E); );
    RUNPH(8, F.refresh(); phase_finals(F); );
#undef IN
#undef SEAM
}

extern "C" void kernel_launch(void* const* d_in, const int* in_sizes, int n_in, void* d_out, int out_size, void* d_ws, size_t ws_size, hipStream_t stream) {
    static int grid = 0;
    if (grid == 0) {
        if (n_in != 26 || out_size != (int)O_END || ws_size < WS_END) { fprintf(stderr, "kernel_launch: unexpected shapes (n_in %d out %d ws %zu)\n", n_in, out_size, ws_size); grid = -1; return; }
        int dev = 0, cus = 0, per_cu = 0;
        if (hipGetDevice(&dev) != hipSuccess || hipDeviceGetAttribute(&cus, hipDeviceAttributeMultiprocessorCount, dev) != hipSuccess) { grid = -1; return; }
        if (hipFuncSetAttribute((const void*)fwd, hipFuncAttributeMaxDynamicSharedMemorySize, LDS_BYTES) != hipSuccess) { fprintf(stderr, "kernel_launch: hipFuncSetAttribute failed\n"); grid = -1; return; }
        if (hipOccupancyMaxActiveBlocksPerMultiprocessor(&per_cu, (const void*)fwd, NWAVES * 64, LDS_BYTES) != hipSuccess || per_cu < 1) { fprintf(stderr, "kernel_launch: occupancy query says %d workgroups per CU; nothing launched\n", per_cu); (void)hipGetLastError(); grid = -1; return; }
        grid = cus;
    }
    if (grid < 0) return;
    (void)hipMemsetAsync((char*)d_ws + WS_CTL, 0, CTL_ZERO_BYTES, stream);
    Args a{};
    for (int i = 0; i < 26; ++i) a.in[i] = (const float*)d_in[i];
    a.out = (float*)d_out; a.ws = (unsigned char*)d_ws;
#if MK_MULTI
    for (int p = 0; p < 9; ++p) { a.ph_lo = p; a.ph_hi = p + 1; hipLaunchKernelGGL(fwd, dim3(grid), dim3(NWAVES * 64), LDS_BYTES, stream, a); }
#else
    a.ph_lo = 0; a.ph_hi = 9;
    void* kargs[] = {&a};
    hipError_t e = hipLaunchCooperativeKernel((const void*)fwd, dim3(grid), dim3(NWAVES * 64), kargs, LDS_BYTES, stream);
    if (e != hipSuccess) fprintf(stderr, "kernel_launch: cooperative launch failed: %s (grid %d)\n", hipGetErrorString(e), grid);
#endif
}
```

```cpp
#include <hip/hip_runtime.h>
#include <hip/hip_bf16.h>
#include <cstdio>
#include <cstdint>

#ifndef MK_MULTI
#define MK_MULTI 0
#endif

constexpr int DM = 2048, TP = 4096, NBP = 2, TS = 16, NBS = 8;
constexpr int MP = NBP * TP;
constexpr int MS = NBS * TS;
constexpr int MV = MP + MS;
constexpr int MPAD = 8448;
constexpr int NIN = 14336, DFF = 5632, NGU = 2 * DFF, NMOD = 6 * DM;
constexpr float EPS = 1e-6f;
constexpr float ATT_SCALE = 0.08838834764831845f;
constexpr size_t O_YP = 0, O_YS = 16777216, O_PK = 17039360, O_PV = 19136512, O_PH = 21233664, O_PC = 21237760,
                 O_SK = 21250048, O_SV = 21512192, O_SH = 21774336, O_SC = 21790720, O_END = 21839872;

constexpr size_t MiB = 1u << 20;
constexpr size_t WS_CTL = 0, CTL_ZERO_BYTES = 1 * MiB;
constexpr size_t WS_MOD = 64 * 1024;
constexpr size_t WS_GRAN = 1 * MiB;
constexpr size_t WS_SLAB4 = 218 * MiB, WS_SLAB6 = 251 * MiB, WS_SLAB9 = 350 * MiB;
constexpr int NSL4 = 32, NSL6 = 16, NSL9 = 22;
constexpr size_t WS_WIN = 4 * MiB, WS_WPROJ = 60 * MiB, WS_WOUT = 76 * MiB, WS_WGU = 84 * MiB, WS_WDN = 128 * MiB, WS_WRG = 150 * MiB;
constexpr size_t WS_H1 = 152 * MiB;
constexpr size_t WS_Q = 185 * MiB, WS_K = 218 * MiB, WS_V = 251 * MiB, WS_U = 284 * MiB, WS_G = 317 * MiB, WS_SA = 350 * MiB, WS_SR = 383 * MiB;
constexpr size_t WS_MERGED = WS_Q;
constexpr size_t WS_ACT = WS_K;
constexpr size_t WS_OY = 416 * MiB;
constexpr size_t WS_END = 482 * MiB;
static_assert(WS_ACT + (size_t)MPAD * DFF * 2 <= WS_G, "ACT overlay");
constexpr int CW_TMO = 0, CW_READY = 2048, CW_BAR = 4096;
constexpr size_t WS_XW = 640 * 1024;

constexpr int RING_BYTES = 131072, LDSCTL_OFF = RING_BYTES, MISC_OFF = LDSCTL_OFF + 320, LDS_BYTES = 147456;
constexpr int NWAVES = 8;

#define GAS __attribute__((address_space(1)))
#define LAS __attribute__((address_space(3)))
typedef unsigned short bf16_t;
typedef unsigned v4u __attribute__((ext_vector_type(4)));
typedef unsigned v2u __attribute__((ext_vector_type(2)));
typedef float f32x4 __attribute__((ext_vector_type(4)));
typedef float f32x2 __attribute__((ext_vector_type(2)));
typedef float f32x16 __attribute__((ext_vector_type(16)));
typedef short bf16x8 __attribute__((ext_vector_type(8)));
typedef short s16x4 __attribute__((ext_vector_type(4)));
typedef GAS unsigned gu32;
typedef GAS unsigned long long gu64;
#define RLX_AGENT __ATOMIC_RELAXED, __HIP_MEMORY_SCOPE_AGENT
#define LDS_WAIT() asm volatile("s_waitcnt lgkmcnt(0)" ::: "memory")
#define VM_WAIT() asm volatile("s_waitcnt vmcnt(0)" ::: "memory")

__device__ __forceinline__ unsigned f2bf(float f) { unsigned u = __builtin_bit_cast(unsigned, f); return (u + 0x7fffu + ((u >> 16) & 1u)) >> 16; }
__device__ __forceinline__ unsigned pk2(float lo, float hi) { return f2bf(lo) | (f2bf(hi) << 16); }
__device__ __forceinline__ float bf2f(unsigned short h) { return __builtin_bit_cast(float, (unsigned)h << 16); }
__device__ __forceinline__ float bflo(unsigned w) { return __builtin_bit_cast(float, w << 16); }
__device__ __forceinline__ float bfhi(unsigned w) { return __builtin_bit_cast(float, w & 0xffff0000u); }
typedef __bf16 bf16x2_t __attribute__((ext_vector_type(2)));
__device__ __forceinline__ unsigned cvt_pk_bf16(float lo, float hi) { f32x2 v = {lo, hi}; bf16x2_t b = __builtin_convertvector(v, bf16x2_t); return __builtin_bit_cast(unsigned, b); }
__device__ __forceinline__ float sigm(float x) { return __builtin_amdgcn_rcpf(1.f + __expf(-x)); }
__device__ __forceinline__ float gelu_tanh(float x) { return x * sigm(1.5957691216057308f * (x + 0.044715f * x * x * x)); }
__device__ __forceinline__ float wave_sum(float v) {
#pragma unroll
    for (int o = 1; o < 64; o <<= 1) v += __shfl_xor(v, o);
    return v;
}
__device__ __forceinline__ float wave_max(float v) {
#pragma unroll
    for (int o = 1; o < 64; o <<= 1) v = fmaxf(v, __shfl_xor(v, o));
    return v;
}

namespace pg8 {
#define PG8_LAS __attribute__((address_space(3)))
constexpr int BM = 256, BK = 64, HALF = 128, HTB = HALF * BK * 2, STAGE_BYTES = 8 * HTB, NXCD = 8, WGM = 8;
__host__ __device__ __forceinline__ int lds_byte(int r, int c) { const int st = (r >> 4) * 2 + (c >> 5), rr = r & 15, cc = c & 31, ob = rr * 64 + cc * 2; return st * 1024 + (ob ^ (((ob >> 9) & 1) << 5)); }
__host__ __device__ __forceinline__ void stage_rc(int b, int& R, int& C) { const int st = b / 1024, sb = b % 1024, swz = sb ^ (((sb >> 9) & 1) << 5); R = (st >> 1) * 16 + swz / 64; C = (st & 1) * 32 + (swz % 64) / 2; }
__host__ __device__ __forceinline__ int perm32(int rho) { const int n = rho >> 4, i = rho & 15; return 8 * (i >> 2) + 4 * n + (i & 3); }
struct Unit { int pm, pn, k0, nt; };
struct Gemm { const bf16_t* A; const bf16_t* Bt; int M, N, K; };
struct StaticOrder {
    int nM, nN, nwg, G, c, ntf;
    __host__ __device__ void init(int M, int N, int K, int G_, int c_) { nM = M / BM; nN = N / BM; nwg = nM * nN; G = G_; c = c_; ntf = K / BK; }
    __host__ __device__ __forceinline__ bool next(int i, Unit& u) const { return at((long)i * G + c, u); }
    __host__ __device__ __forceinline__ bool at(long L, Unit& u) const {
        u.pm = 0; u.pn = 0; u.k0 = 0; u.nt = ntf;
        if (L >= nwg) return false;
        int wgid = (int)L; { const int q = nwg / NXCD, r = nwg % NXCD, xcd = wgid % NXCD, off = wgid / NXCD; wgid = (xcd < r ? xcd * (q + 1) : r * (q + 1) + (xcd - r) * q) + off; }
        const int nig = WGM * nN, gid = wgid / nig, fm = gid * WGM, gsz = (nM - fm) < WGM ? (nM - fm) : WGM;
        u.pm = fm + ((wgid % nig) % gsz); u.pn = (wgid % nig) / gsz; return true;
    }
    __device__ __forceinline__ void a_ready(const Unit&) const {}
    __device__ __forceinline__ void done(const Unit&) const {}
};
struct SampleGatedOrder : StaticOrder {
    const unsigned* ready; unsigned need;
    __device__ __forceinline__ void a_ready(const Unit& u) const {
        if (u.pm != 32) return;
        if (threadIdx.x < 64) { unsigned polls = 0;
            while ((unsigned)__builtin_amdgcn_readfirstlane(__hip_atomic_load(ready, __ATOMIC_RELAXED, __HIP_MEMORY_SCOPE_AGENT)) < need) { __builtin_amdgcn_s_sleep(2); if (++polls > (1u << 20)) break; }
            __builtin_amdgcn_fence(__ATOMIC_ACQUIRE, "agent");
            asm volatile("s_waitcnt vmcnt(0)" ::: "memory"); }
        asm volatile("" ::: "memory"); __builtin_amdgcn_s_barrier(); asm volatile("" ::: "memory");
    }
};
struct HybridOrder {
    StaticOrder base; int snt, npn, nsl; const unsigned* ready = nullptr; unsigned need = 0;
    __host__ __device__ void init(int N, int K, int G_, int c_, int snt_) { base.init(8192, N, K, G_, c_); snt = snt_; npn = N / BM; nsl = (K / BK) / snt_; }
    __host__ __device__ __forceinline__ bool next(int i, Unit& u) const {
        const long L = (long)i * base.G + base.c;
        if (L < base.nwg) return base.at(L, u);
        const int sidx = (int)(L - base.nwg);
        u.pm = 32; u.pn = sidx % npn; u.k0 = (sidx / npn) * snt; u.nt = snt; return sidx < npn * nsl;
    }
    __device__ __forceinline__ void a_ready(const Unit& u) const {
        if (u.pm != 32 || ready == nullptr) return;
        if (threadIdx.x < 64) { unsigned polls = 0;
            while ((unsigned)__builtin_amdgcn_readfirstlane(__hip_atomic_load(ready, __ATOMIC_RELAXED, __HIP_MEMORY_SCOPE_AGENT)) < need) { __builtin_amdgcn_s_sleep(2); if (++polls > (1u << 20)) break; }
            __builtin_amdgcn_fence(__ATOMIC_ACQUIRE, "agent");
            asm volatile("s_waitcnt vmcnt(0)" ::: "memory"); }
        asm volatile("" ::: "memory"); __builtin_amdgcn_s_barrier(); asm volatile("" ::: "memory");
    }
    __device__ __forceinline__ void done(const Unit&) const {}
};
template <class Epi, class Sched, bool ALIGN_EPI = false, bool SP2 = false>
__device__ __forceinline__ void gemm_phase(PG8_LAS unsigned char* lds, const Gemm g, const Sched& S, const Epi& E) {
    const int tid = threadIdx.x, wid = __builtin_amdgcn_readfirstlane(tid >> 6), lane = tid & 63, wr = wid >> 2, wc = wid & 3, fr = lane & 15, fq = lane >> 4;
    const int K = g.K, nt = K / BK;
    unsigned voffA[2], voffB[2];
#pragma unroll
    for (int i = 0; i < 2; ++i) { int R, C; stage_rc(tid * 16 + i * 8192, R, C); const int Rb = Epi::PERM ? ((R & ~31) + perm32(R & 31)) : R;
        voffA[i] = (unsigned)(R * K + C) * 2u; voffB[i] = (unsigned)(Rb * K + C) * 2u; }
    const size_t kstep = (size_t)(BK * 2);
    const size_t hstep = (size_t)HALF * K * 2;
    const size_t tstep = 2 * hstep;
    const unsigned ldsw = (unsigned)wid * 1024u;
    const int aoff = lds_byte(wr * 64 + fr, fq * 8), boff = lds_byte(wc * 32 + fr, fq * 8);
#define PG8_SA(b, h) (((b) * 2 + (h)) * HTB)
#define PG8_SB(b, h) ((4 + (b) * 2 + (h)) * HTB)
#define PG8_STAGE(bufoff, gbase, voff) do { _Pragma("unroll") for (int _i = 0; _i < 2; ++_i) \
        __builtin_amdgcn_global_load_lds((const unsigned*)((const char*)(gbase) + (voff)[_i]), (PG8_LAS unsigned*)(lds + (bufoff) + ldsw + _i * 8192), 16, 0, 0); } while (0)
#define PG8_LDA(dst, b, h) do { _Pragma("unroll") for (int m = 0; m < 4; ++m) _Pragma("unroll") for (int k = 0; k < 2; ++k) dst[m][k] = *(const PG8_LAS bf16x8*)(lds + PG8_SA(b, h) + aoff + m * 2048 + k * 1024); } while (0)
#define PG8_LDB(dst, b, h) do { _Pragma("unroll") for (int n = 0; n < 2; ++n) _Pragma("unroll") for (int k = 0; k < 2; ++k) dst[n][k] = *(const PG8_LAS bf16x8*)(lds + PG8_SB(b, h) + boff + n * 2048 + k * 1024); } while (0)
#define PG8_MMA(ai, bj, At, Bt) do { __builtin_amdgcn_s_setprio(1); _Pragma("unroll") for (int m = 0; m < 4; ++m) _Pragma("unroll") for (int n = 0; n < 2; ++n) _Pragma("unroll") for (int k = 0; k < 2; ++k) \
        acc[ai][bj][m][n] = __builtin_amdgcn_mfma_f32_16x16x32_bf16(Bt[n][k], At[m][k], acc[ai][bj][m][n], 0, 0, 0); __builtin_amdgcn_s_setprio(0); } while (0)
#define PG8_WAIT_V(n) asm volatile("s_waitcnt vmcnt(" #n ")" ::: "memory")
#define PG8_WAIT_L(n) asm volatile("s_waitcnt lgkmcnt(" #n ")" ::: "memory")
#define PG8_BAR __builtin_amdgcn_s_barrier()
#define PG8_SCHED __builtin_amdgcn_sched_barrier(0)
    Unit cur, nxt; int ui = 0;
    if (!S.next(0, cur)) return;
    f32x4 acc[2][2][4][2];
#pragma unroll
    for (int a = 0; a < 2; ++a)
#pragma unroll
        for (int b = 0; b < 2; ++b)
#pragma unroll
            for (int m = 0; m < 4; ++m)
#pragma unroll
                for (int n = 0; n < 2; ++n) acc[a][b][m][n] = (f32x4){0.f, 0.f, 0.f, 0.f};
    bf16x8 At[4][2], B0[2][2], B1[2][2];
    const char* cA = (const char*)g.A + (size_t)cur.pm * tstep + (size_t)cur.k0 * kstep; const char* cB = (const char*)g.Bt + (size_t)cur.pn * tstep + (size_t)cur.k0 * kstep;
    S.a_ready(cur);
    if constexpr (SP2) {
        PG8_STAGE(PG8_SB(0, 0), cB, voffB); PG8_STAGE(PG8_SB(0, 1), cB + hstep, voffB); PG8_STAGE(PG8_SA(0, 0), cA, voffA); PG8_STAGE(PG8_SA(0, 1), cA + hstep, voffA);
        if (wr == 1) PG8_BAR;
        PG8_WAIT_V(2); PG8_BAR;
        PG8_STAGE(PG8_SB(1, 0), cB + kstep, voffB); PG8_STAGE(PG8_SA(1, 0), cA + kstep, voffA); PG8_STAGE(PG8_SB(1, 1), cB + hstep + kstep, voffB);
        PG8_WAIT_V(6); PG8_BAR;
    } else {
        PG8_STAGE(PG8_SB(0, 0), cB, voffB); PG8_STAGE(PG8_SA(0, 0), cA, voffA); PG8_STAGE(PG8_SB(0, 1), cB + hstep, voffB); PG8_STAGE(PG8_SA(0, 1), cA + hstep, voffA);
        if (wr == 1) PG8_BAR;
        PG8_WAIT_V(4); PG8_BAR;
        PG8_STAGE(PG8_SB(1, 0), cB + kstep, voffB); PG8_STAGE(PG8_SA(1, 0), cA + kstep, voffA); PG8_STAGE(PG8_SB(1, 1), cB + hstep + kstep, voffB);
        PG8_WAIT_V(6); PG8_BAR;
    }
    for (;;) {
        const bool has_next = S.next(ui + 1, nxt);
        const char* nA = has_next ? (const char*)g.A + (size_t)nxt.pm * tstep + (size_t)nxt.k0 * kstep : cA; const char* nB = has_next ? (const char*)g.Bt + (size_t)nxt.pn * tstep + (size_t)nxt.k0 * kstep : cB;
        const int cnt = cur.nt;
        for (int t = 0; t < cnt; t += 2) {
            if constexpr (Epi::MIDK) { if (cnt == nt && t == (nt >> 1)) E.mid(acc, cur, wr, wc, fr, fq); }
            const bool last = (t == cnt - 2);
            const char* a1 = cA + (size_t)(t + 1) * kstep;
            const char* a2 = last ? nA : cA + (size_t)(t + 2) * kstep; const char* b2 = last ? nB : cB + (size_t)(t + 2) * kstep;
            const char* a3 = a2 + kstep; const char* b3 = b2 + kstep;
            if (last && has_next) S.a_ready(nxt);
            if constexpr (SP2) {
            PG8_LDB(B0, 0, 0); PG8_LDB(B1, 0, 1); PG8_SCHED; PG8_LDA(At, 0, 0); PG8_STAGE(PG8_SA(1, 1), a1 + hstep, voffA);
            PG8_WAIT_V(8); PG8_WAIT_L(0); PG8_BAR; PG8_MMA(0, 0, At, B0); PG8_MMA(0, 1, At, B1); PG8_BAR; PG8_SCHED;
            PG8_LDA(At, 0, 1); PG8_STAGE(PG8_SB(0, 0), b2, voffB); PG8_STAGE(PG8_SB(0, 1), b2 + hstep, voffB); PG8_STAGE(PG8_SA(0, 0), a2, voffA);
            PG8_WAIT_V(8); PG8_WAIT_L(0); PG8_BAR; PG8_MMA(1, 0, At, B0); PG8_MMA(1, 1, At, B1); PG8_BAR; PG8_SCHED;
            PG8_LDB(B0, 1, 0); PG8_LDB(B1, 1, 1); PG8_SCHED; PG8_LDA(At, 1, 0); PG8_STAGE(PG8_SA(0, 1), a2 + hstep, voffA);
            PG8_WAIT_V(8); PG8_WAIT_L(0); PG8_BAR; PG8_MMA(0, 0, At, B0); PG8_MMA(0, 1, At, B1); PG8_BAR; PG8_SCHED;
            PG8_LDA(At, 1, 1); PG8_STAGE(PG8_SB(1, 0), b3, voffB); PG8_STAGE(PG8_SB(1, 1), b3 + hstep, voffB); PG8_STAGE(PG8_SA(1, 0), a3, voffA);
            PG8_WAIT_V(8); PG8_WAIT_L(0); PG8_BAR; PG8_MMA(1, 0, At, B0); PG8_MMA(1, 1, At, B1); PG8_BAR; PG8_SCHED;
            } else {
            PG8_LDB(B0, 0, 0); PG8_SCHED; PG8_LDA(At, 0, 0); PG8_STAGE(PG8_SA(1, 1), a1 + hstep, voffA);
            PG8_WAIT_L(8); PG8_BAR; PG8_WAIT_L(0); PG8_MMA(0, 0, At, B0); PG8_BAR; PG8_SCHED;
            PG8_LDB(B1, 0, 1); PG8_STAGE(PG8_SB(0, 0), b2, voffB);
            PG8_BAR; PG8_WAIT_L(0); PG8_MMA(0, 1, At, B1); PG8_BAR;
            PG8_LDA(At, 0, 1); PG8_STAGE(PG8_SA(0, 0), a2, voffA);
            PG8_BAR; PG8_WAIT_L(0); PG8_MMA(1, 0, At, B0); PG8_BAR; PG8_SCHED;
            PG8_STAGE(PG8_SB(0, 1), b2 + hstep, voffB);
            PG8_WAIT_V(6); PG8_BAR; PG8_MMA(1, 1, At, B1); PG8_BAR;
            PG8_LDB(B0, 1, 0); PG8_SCHED; PG8_LDA(At, 1, 0); PG8_STAGE(PG8_SA(0, 1), a2 + hstep, voffA);
            PG8_WAIT_L(8); PG8_BAR; PG8_WAIT_L(0); PG8_MMA(0, 0, At, B0); PG8_BAR; PG8_SCHED;
            PG8_LDB(B1, 1, 1); PG8_STAGE(PG8_SB(1, 0), b3, voffB);
            PG8_BAR; PG8_WAIT_L(0); PG8_MMA(0, 1, At, B1); PG8_BAR;
            PG8_LDA(At, 1, 1); PG8_STAGE(PG8_SA(1, 0), a3, voffA);
            PG8_BAR; PG8_WAIT_L(0); PG8_MMA(1, 0, At, B0); PG8_BAR; PG8_SCHED;
            PG8_STAGE(PG8_SB(1, 1), b3 + hstep, voffB);
            PG8_WAIT_V(6); PG8_BAR; PG8_MMA(1, 1, At, B1); PG8_BAR;
            }
        }
        if constexpr (ALIGN_EPI) { if (wr == 0) PG8_BAR; }
        E(acc, cur, wr, wc, fr, fq); S.done(cur);
        if (!has_next) break;
#pragma unroll
        for (int a = 0; a < 2; ++a)
#pragma unroll
            for (int b = 0; b < 2; ++b)
#pragma unroll
                for (int m = 0; m < 4; ++m)
#pragma unroll
                    for (int n = 0; n < 2; ++n) acc[a][b][m][n] = (f32x4){0.f, 0.f, 0.f, 0.f};
        cur = nxt; cA = nA; cB = nB; ++ui;
        if constexpr (ALIGN_EPI) { if (wr == 1) PG8_BAR; }
    }
    PG8_WAIT_V(0);
    if constexpr (!ALIGN_EPI) { if (wr == 0) PG8_BAR; }
    PG8_BAR;
#undef PG8_SA
#undef PG8_SB
#undef PG8_STAGE
#undef PG8_LDA
#undef PG8_LDB
#undef PG8_MMA
#undef PG8_WAIT_V
#undef PG8_WAIT_L
#undef PG8_BAR
#undef PG8_SCHED
}
}

__device__ __forceinline__ v4u pack8bf(f32x4 a, f32x4 b) { v4u w; w.x = cvt_pk_bf16(a[0], a[1]); w.y = cvt_pk_bf16(a[2], a[3]); w.z = cvt_pk_bf16(b[0], b[1]); w.w = cvt_pk_bf16(b[2], b[3]); return w; }
__device__ __forceinline__ void unpack8bf(v4u w, f32x4& a, f32x4& b) { a = (f32x4){bflo(w.x), bfhi(w.x), bflo(w.y), bfhi(w.y)}; b = (f32x4){bflo(w.z), bfhi(w.z), bflo(w.w), bfhi(w.w)}; }

struct EpiIn {
    static constexpr bool PERM = true, MIDK = false;
    bf16_t* base;
    float* out;
    __device__ __forceinline__ void mid(f32x4 (&)[2][2][4][2], const pg8::Unit&, int, int, int, int) const {}
    template <int MODE>
    __device__ __forceinline__ void store_bf(const f32x4 (&acc)[2][2][4][2], const pg8::Unit& u, int wr, int wc, int fr, int fq, bf16_t* dst) const {
        const int colr = (u.pn & 7) * 256 + wc * 32 + 8 * fq;
#pragma unroll
        for (int ai = 0; ai < 2; ++ai)
#pragma unroll
            for (int m = 0; m < 4; ++m) {
                const size_t row = (size_t)u.pm * 256 + ai * 128 + wr * 64 + m * 16 + fr;
#pragma unroll
                for (int bj = 0; bj < 2; ++bj) {
                    f32x4 v0 = acc[ai][bj][m][0], v1 = acc[ai][bj][m][1];
                    if (MODE == 1) {
#pragma unroll
                        for (int e = 0; e < 4; ++e) { v0[e] = gelu_tanh(v0[e]); v1[e] = gelu_tanh(v1[e]); }
                    } else if (MODE == 2) {
#pragma unroll
                        for (int e = 0; e < 4; ++e) { v0[e] = sigm(v0[e]); v1[e] = sigm(v1[e]); }
                    }
                    *(v4u*)(dst + row * DM + colr + bj * 128) = pack8bf(v0, v1);
                }
                asm volatile("" ::: "memory");
            }
    }
    __device__ __forceinline__ void store_f32(const f32x4 (&acc)[2][2][4][2], const pg8::Unit& u, int wr, int wc, int fr, int fq, float* orow0, int rl0, int rl1) const {
        const int colr = (u.pn & 7) * 256 + wc * 32 + 8 * fq;
#pragma unroll
        for (int ai = 0; ai < 2; ++ai)
#pragma unroll
            for (int m = 0; m < 4; ++m) {
                const int rl = ai * 128 + wr * 64 + m * 16 + fr;
                if (rl >= rl0 && rl < rl1) {
                    float* o = orow0 + (size_t)(rl - rl0) * DM + colr;
#pragma unroll
                    for (int bj = 0; bj < 2; ++bj) { *(f32x4*)(o + bj * 128) = acc[ai][bj][m][0]; *(f32x4*)(o + bj * 128 + 4) = acc[ai][bj][m][1]; }
                }
                asm volatile("" ::: "memory");
            }
    }
    __device__ __forceinline__ void store_f32_sconv(const f32x4 (&acc)[2][2][4][2], const pg8::Unit& u, int wr, int wc, int fr, int fq) const {
        const int colr = (u.pn & 7) * 256 + wc * 32 + 8 * fq;
        if (fr >= 13) {
#pragma unroll
            for (int m = 0; m < 4; ++m) {
                const int rl = wr * 64 + m * 16 + fr;
                float* o = out + O_SC + ((size_t)((rl >> 4) * 3 + fr - 13)) * DM + colr;
#pragma unroll
                for (int bj = 0; bj < 2; ++bj) { *(f32x4*)(o + bj * 128) = acc[0][bj][m][0]; *(f32x4*)(o + bj * 128 + 4) = acc[0][bj][m][1]; }
                asm volatile("" ::: "memory");
            }
        }
    }
    __device__ __forceinline__ void operator()(const f32x4 (&acc)[2][2][4][2], const pg8::Unit& u, int wr, int wc, int fr, int fq) const {
        const int region = u.pn >> 3, pm = u.pm;
        bf16_t* dst = base + (size_t)region * (33 * MiB / 2);
        const bool sample = (pm == 32);
        if (region == 4) store_bf<1>(acc, u, wr, wc, fr, fq, dst);
        else if (region >= 5) store_bf<2>(acc, u, wr, wc, fr, fq, dst);
        else store_bf<0>(acc, u, wr, wc, fr, fq, dst);
        if (region == 1 || region == 2) {
            if (sample) store_f32(acc, u, wr, wc, fr, fq, out + (region == 1 ? O_SK : O_SV), 0, 128);
            else if ((pm & 15) >= 14) store_f32(acc, u, wr, wc, fr, fq, out + (region == 1 ? O_PK : O_PV) + ((size_t)((pm >> 4) * 512 + ((pm & 15) - 14) * 256)) * DM, 0, 256);
        } else if (region == 3) {
            if (sample) store_f32_sconv(acc, u, wr, wc, fr, fq);
            else if ((pm & 15) == 15) store_f32(acc, u, wr, wc, fr, fq, out + O_PC + (size_t)((pm >> 4) * 3) * DM, 253, 256);
        }
    }
};
template <bool GATED>
__device__ __forceinline__ void slice_store(const f32x4 (&acc)[2][2][4][2], const pg8::Unit& u, int wr, int wc, int fr, int fq, float* slabs, const bf16_t* gate) {
    int opq = 0; asm volatile("" : "+v"(opq));
    const int col0 = u.pn * 256 + wc * 32 + 8 * fq;
    float* slab = slabs + (size_t)(u.k0 / u.nt) * (128 * DM);
#pragma unroll
    for (int m = 0; m < 4; ++m) {
        const int rl = wr * 64 + m * 16 + fr + opq;
#pragma unroll
        for (int bj = 0; bj < 2; ++bj) {
            const int c = col0 + bj * 128;
            f32x4 v0 = acc[0][bj][m][0], v1 = acc[0][bj][m][1];
            if (GATED) { f32x4 g0, g1; unpack8bf(*(const v4u*)(gate + (size_t)(MP + rl) * DM + c), g0, g1); v0 = v0 * g0; v1 = v1 * g1; }
            float* p = slab + (size_t)rl * DM + c;
            *(f32x4*)p = v0; *(f32x4*)(p + 4) = v1;
        }
        asm volatile("" ::: "memory");
    }
}
struct EpiProj {
    static constexpr bool PERM = true, MIDK = true;
    const bf16_t* SA; const bf16_t* SR; bf16_t* O; float* sacc;
    __device__ __forceinline__ void mid(f32x4 (&acc)[2][2][4][2], const pg8::Unit& u, int wr, int wc, int fr, int fq) const {
        int opq = 0; asm volatile("" : "+v"(opq));
        const int col0 = u.pn * 256 + wc * 32 + 8 * fq;
        const int rowb = u.pm * 256 + wr * 64 + fr + opq;
#pragma unroll
        for (int ai = 0; ai < 2; ++ai)
#pragma unroll
            for (int m = 0; m < 4; ++m) {
                const size_t row = (size_t)(rowb + ai * 128 + m * 16);
#pragma unroll
                for (int bj = 0; bj < 2; ++bj) {
                    const size_t off = row * DM + col0 + bj * 128;
                    f32x4 a0, a1, r0, r1; unpack8bf(*(const v4u*)(SA + off), a0, a1); unpack8bf(*(const v4u*)(SR + off), r0, r1);
#pragma unroll
                    for (int e = 0; e < 4; ++e) { acc[ai][bj][m][0][e] *= a0[e] * __builtin_amdgcn_rcpf(r0[e]); acc[ai][bj][m][1][e] *= a1[e] * __builtin_amdgcn_rcpf(r1[e]); }
                }
                asm volatile("" : "+v"(acc[ai][0][m][0]), "+v"(acc[ai][0][m][1]), "+v"(acc[ai][1][m][0]), "+v"(acc[ai][1][m][1]) :: "memory");
            }
    }
    __device__ __forceinline__ void operator()(const f32x4 (&acc)[2][2][4][2], const pg8::Unit& u, int wr, int wc, int fr, int fq) const {
        if (u.pm == 32) { slice_store<true>(acc, u, wr, wc, fr, fq, sacc, u.k0 < 32 ? SA : SR); return; }
        const int col0 = u.pn * 256 + wc * 32 + 8 * fq;
#pragma unroll
        for (int ai = 0; ai < 2; ++ai)
#pragma unroll
            for (int m = 0; m < 4; ++m) {
                const size_t row = (size_t)u.pm * 256 + ai * 128 + wr * 64 + m * 16 + fr;
#pragma unroll
                for (int bj = 0; bj < 2; ++bj) {
                    const size_t off = row * DM + col0 + bj * 128;
                    f32x4 r0, r1; unpack8bf(*(const v4u*)(SR + off), r0, r1);
                    *(v4u*)(O + off) = pack8bf(acc[ai][bj][m][0] * r0, acc[ai][bj][m][1] * r1);
                }
                asm volatile("" ::: "memory");
            }
    }
};
constexpr int XL_OFF = LDSCTL_OFF + 1024;
__device__ __forceinline__ void panel_rinv(const f32x4 (&v)[2][2][4][2], const pg8::Unit& u, int wr, int wc, int fr, int fq, LAS unsigned char* xl, unsigned long long* xw) {
    const int lane = threadIdx.x & 63, wid = wr * 4 + wc;
    LAS float* P = (LAS float*)xl;
    LAS float* S = P + 1024;
#pragma unroll
    for (int ai = 0; ai < 2; ++ai)
#pragma unroll
        for (int m = 0; m < 4; ++m) { float q = 0.f;
#pragma unroll
            for (int bj = 0; bj < 2; ++bj)
#pragma unroll
                for (int n = 0; n < 2; ++n) { const f32x4 x = v[ai][bj][m][n]; q += (x[0] * x[0] + x[1] * x[1]) + (x[2] * x[2] + x[3] * x[3]); }
            q += __shfl_xor(q, 16); q += __shfl_xor(q, 32);
            if (fq == 0) P[(ai * 128 + wr * 64 + m * 16 + fr) * 4 + wc] = q; }
    asm volatile("s_waitcnt lgkmcnt(0)" ::: "memory"); __builtin_amdgcn_s_barrier(); asm volatile("" ::: "memory");
    int opq = 0; asm volatile("" : "+v"(opq));
    if (lane < 32) { const int row = wid * 32 + lane + opq; const f32x4 a = *(const LAS f32x4*)(P + row * 4);
        const float q = (a[0] + a[1]) + (a[2] + a[3]);
        unsigned long long* w = xw + (size_t)u.pm * 256 + row;
        const unsigned long long inc = (1ull << 56) + (unsigned long long)(q * 1048576.f);
        unsigned long long cur = __hip_atomic_fetch_add(w, inc, __ATOMIC_RELAXED, __HIP_MEMORY_SCOPE_AGENT) + inc;
        unsigned spins = 0;
        while ((cur >> 56) < 8ull) { __builtin_amdgcn_s_sleep(1); cur = __hip_atomic_load(w, __ATOMIC_RELAXED, __HIP_MEMORY_SCOPE_AGENT); if (++spins > (1u << 18)) break; }
        S[row] = rsqrtf((float)(cur & ((1ull << 56) - 1)) * (1.f / (1048576.f * DM)) + EPS); }
    asm volatile("s_waitcnt vmcnt(0) lgkmcnt(0)" ::: "memory"); __builtin_amdgcn_s_barrier(); asm volatile("" ::: "memory");
}
struct EpiResNorm {
    static constexpr bool PERM = true, MIDK = false;
    const float* xin; float* x1o; bf16_t* h2o; const float* mod; float* slabs; LAS unsigned char* xl; unsigned long long* xw;
    __device__ __forceinline__ void mid(f32x4 (&)[2][2][4][2], const pg8::Unit&, int, int, int, int) const {}
    __device__ __forceinline__ void operator()(f32x4 (&acc)[2][2][4][2], const pg8::Unit& u, int wr, int wc, int fr, int fq) const {
        if (u.pm == 32) { slice_store<false>(acc, u, wr, wc, fr, fq, slabs, nullptr); return; }
        const int col0 = u.pn * 256 + wc * 32 + 8 * fq;
        const float* md = mod + (size_t)(u.pm >> 4) * NMOD;
#pragma unroll
        for (int ai = 0; ai < 2; ++ai)
#pragma unroll
            for (int m = 0; m < 4; ++m) {
                const size_t ro = (size_t)(u.pm * 256 + ai * 128 + wr * 64 + m * 16 + fr) * DM;
#pragma unroll
                for (int bj = 0; bj < 2; ++bj) {
                    const int c = col0 + bj * 128;
                    const f32x4 g0 = *(const f32x4*)(md + 2 * DM + c), g1 = *(const f32x4*)(md + 2 * DM + c + 4);
                    const f32x4 x0 = *(const f32x4*)(xin + ro + c), x1 = *(const f32x4*)(xin + ro + c + 4);
                    acc[ai][bj][m][0] = x0 + g0 * acc[ai][bj][m][0]; acc[ai][bj][m][1] = x1 + g1 * acc[ai][bj][m][1];
                }
                asm volatile("" : "+v"(acc[ai][0][m][0]), "+v"(acc[ai][0][m][1]), "+v"(acc[ai][1][m][0]), "+v"(acc[ai][1][m][1]) :: "memory");
            }
        panel_rinv(acc, u, wr, wc, fr, fq, xl, xw);
        const LAS float* S = (const LAS float*)xl + 1024;
        int opq = 0; asm volatile("" : "+v"(opq));
        const int rl0 = wr * 64 + fr + opq;
#pragma unroll
        for (int bj = 0; bj < 2; ++bj)
#pragma unroll
            for (int n = 0; n < 2; ++n) {
                const int c = col0 + bj * 128 + 4 * n;
                const f32x4 s0 = *(const f32x4*)(md + 4 * DM + c) + 1.f, h0 = *(const f32x4*)(md + 3 * DM + c);
#pragma unroll
                for (int ai = 0; ai < 2; ++ai)
#pragma unroll
                    for (int m = 0; m < 4; ++m) {
                        const int rl = rl0 + ai * 128 + m * 16; const float rv = S[rl];
                        const size_t ro = (size_t)(u.pm * 256 + rl) * DM + c;
                        *(f32x4*)(x1o + ro) = acc[ai][bj][m][n];
                        const f32x4 y = acc[ai][bj][m][n] * rv * s0 + h0; v2u w; w.x = cvt_pk_bf16(y[0], y[1]); w.y = cvt_pk_bf16(y[2], y[3]);
                        *(v2u*)(h2o + ro) = w;
                    }
                asm volatile("" ::: "memory");
            }
    }
};
struct EpiResFinal {
    static constexpr bool PERM = true, MIDK = false;
    const float* x1i; float* yo; const float* mod; const float* fng; float* slabs; LAS unsigned char* xl; unsigned long long* xw;
    __device__ __forceinline__ void mid(f32x4 (&)[2][2][4][2], const pg8::Unit&, int, int, int, int) const {}
    __device__ __forceinline__ void operator()(f32x4 (&acc)[2][2][4][2], const pg8::Unit& u, int wr, int wc, int fr, int fq) const {
        if (u.pm == 32) { slice_store<false>(acc, u, wr, wc, fr, fq, slabs, nullptr); return; }
        const int col0 = u.pn * 256 + wc * 32 + 8 * fq;
        const float* gp = mod + (size_t)(u.pm >> 4) * NMOD + 5 * DM;
#pragma unroll
        for (int ai = 0; ai < 2; ++ai)
#pragma unroll
            for (int m = 0; m < 4; ++m) {
                const size_t ro = (size_t)(u.pm * 256 + ai * 128 + wr * 64 + m * 16 + fr) * DM;
#pragma unroll
                for (int bj = 0; bj < 2; ++bj) {
                    const int c = col0 + bj * 128;
                    const f32x4 g0 = *(const f32x4*)(gp + c), g1 = *(const f32x4*)(gp + c + 4);
                    const f32x4 x0 = *(const f32x4*)(x1i + ro + c), x1 = *(const f32x4*)(x1i + ro + c + 4);
                    acc[ai][bj][m][0] = x0 + g0 * acc[ai][bj][m][0]; acc[ai][bj][m][1] = x1 + g1 * acc[ai][bj][m][1];
                }
                asm volatile("" : "+v"(acc[ai][0][m][0]), "+v"(acc[ai][0][m][1]), "+v"(acc[ai][1][m][0]), "+v"(acc[ai][1][m][1]) :: "memory");
            }
        panel_rinv(acc, u, wr, wc, fr, fq, xl, xw);
        const LAS float* S = (const LAS float*)xl + 1024;
        int opq = 0; asm volatile("" : "+v"(opq));
        const int rl0 = wr * 64 + fr + opq;
#pragma unroll
        for (int bj = 0; bj < 2; ++bj) {
            const int c = col0 + bj * 128;
            const f32x4 f0 = *(const f32x4*)(fng + c), f1 = *(const f32x4*)(fng + c + 4);
#pragma unroll
            for (int ai = 0; ai < 2; ++ai)
#pragma unroll
                for (int m = 0; m < 4; ++m) {
                    const int rl = rl0 + ai * 128 + m * 16; const float rv = S[rl];
                    float* o = yo + (size_t)(u.pm * 256 + rl) * DM + c;
                    *(f32x4*)o = acc[ai][bj][m][0] * rv * f0; *(f32x4*)(o + 4) = acc[ai][bj][m][1] * rv * f1;
                }
            asm volatile("" ::: "memory");
        }
    }
};
struct EpiGU {
    static constexpr bool PERM = true, MIDK = false;
    bf16_t* O;
    __device__ __forceinline__ void mid(f32x4 (&)[2][2][4][2], const pg8::Unit&, int, int, int, int) const {}
    __device__ __forceinline__ void operator()(const f32x4 (&acc)[2][2][4][2], const pg8::Unit& u, int wr, int wc, int fr, int fq) const {
        const int col0 = u.pn * 128 + wc * 32 + 8 * fq;
#pragma unroll
        for (int ai = 0; ai < 2; ++ai)
#pragma unroll
            for (int m = 0; m < 4; ++m) {
                const size_t row = (size_t)u.pm * 256 + ai * 128 + wr * 64 + m * 16 + fr;
                f32x4 o0, o1;
#pragma unroll
                for (int e = 0; e < 4; ++e) { const float g0 = acc[ai][0][m][0][e], g1 = acc[ai][0][m][1][e];
                    o0[e] = g0 * sigm(g0) * acc[ai][1][m][0][e]; o1[e] = g1 * sigm(g1) * acc[ai][1][m][1][e]; }
                *(v4u*)(O + row * DFF + col0) = pack8bf(o0, o1);
            }
    }
};

namespace att {
constexpr int NW = 8, QBLK = 32, KVBLK = 64, QB = NW * QBLK, D = 128, LDQ = 2048, LDO = 4096;
constexpr int SHM_V = KVBLK * D * 2, SHM_K = KVBLK * D * 2;
constexpr int LDS_BYTES = 2 * SHM_V + 2 * SHM_K + NW * 64 * 4;
constexpr int BIAS_OFF = LDS_BYTES;
constexpr float THR = 8.f;
constexpr float LOG2E = 1.4426950408889634f;
#define KSWZ(row, colB) ((row) * 256 + ((colB) ^ (((row) & 7) << 4)))
#define SBAR() __builtin_amdgcn_sched_barrier(0)
__device__ __forceinline__ int v_st(int k, int c) { const int kk = (k & ~0xC) | ((k & 4) << 1) | ((k & 8) >> 1); return ((kk >> 3) * 4 + (c >> 5)) * 512 + ((kk & 7) * 32 + (c & 31)) * 2; }
__device__ __forceinline__ int v_rd_base(int lane) { return ((lane & 3) << 3) | (((lane >> 2) & 3) << 6) | (((lane >> 4) & 1) << 5) | (((lane >> 5) & 1) << 8); }
constexpr int v_rd_off(int d0, int ks, int half) { return d0 * 512 + ks * 4096 + half * 2048; }
__device__ __forceinline__ int crow(int r, int hi) { return (r & 3) + 8 * (r >> 2) + 4 * hi; }
__device__ __forceinline__ unsigned cvtpk(float lo, float hi) { return cvt_pk_bf16(lo, hi); }
__device__ __forceinline__ bf16x8 load8(const bf16_t* p) { return *reinterpret_cast<const bf16x8*>(p); }
__device__ __forceinline__ int jlo(int qb) { const int j = 4 * qb - 8; return j > 0 ? j : 0; }
__device__ __forceinline__ void bias_tile(f32x16& p0, f32x16& p1, int dq, int dlo, const float* bl) {
    if (dlo - 63 >= 256) { const float bf = bl[319];
#pragma unroll
        for (int r = 0; r < 16; ++r) { p0[r] = fmaf(p0[r], ATT_SCALE, bf); p1[r] = fmaf(p1[r], ATT_SCALE, bf); }
    } else {
#pragma unroll
        for (int r = 0; r < 16; ++r) { const int c = (r & 3) + 8 * (r >> 2);
            int d0 = dq - c; d0 = d0 > 256 ? 256 : d0; int d1 = dq - c - 32; d1 = d1 > 256 ? 256 : d1;
            p0[r] = fmaf(p0[r], ATT_SCALE, bl[d0 + 63]); p1[r] = fmaf(p1[r], ATT_SCALE, bl[d1 + 63]); }
    }
}
__device__ __forceinline__ void partialSM(f32x16& p0, f32x16& p1, float& m_reg, float& mn, float& alpha) {
    float pmax = p0[0];
#pragma unroll
    for (int r = 1; r < 16; ++r) pmax = fmaxf(pmax, p0[r]);
#pragma unroll
    for (int r = 0; r < 16; ++r) pmax = fmaxf(pmax, p1[r]);
    { auto rr = __builtin_amdgcn_permlane32_swap(__float_as_uint(pmax), __float_as_uint(pmax), false, false);
      pmax = fmaxf(__uint_as_float(rr[0]), __uint_as_float(rr[1])); }
    if (__builtin_expect(__all((pmax - m_reg) <= THR), 1)) { mn = m_reg; alpha = 1.f; }
    else { mn = fmaxf(m_reg, pmax); alpha = __builtin_amdgcn_exp2f((m_reg - mn) * LOG2E); m_reg = mn; }
    const float mnL = -mn * LOG2E;
#pragma unroll
    for (int r = 0; r < 16; ++r) p0[r] = fmaf(p0[r], LOG2E, mnL);
#pragma unroll
    for (int r = 0; r < 16; ++r) p1[r] = fmaf(p1[r], LOG2E, mnL);
#pragma unroll
    for (int r = 0; r < 16; ++r) p0[r] = __builtin_amdgcn_exp2f(p0[r]);
}
__device__ __forceinline__ void finishSM(f32x16& p0, f32x16& p1, float alpha, float& l_reg, bf16x8& pa0, bf16x8& pa1, bf16x8& pa2, bf16x8& pa3) {
#pragma unroll
    for (int r = 0; r < 16; ++r) p1[r] = __builtin_amdgcn_exp2f(p1[r]);
    float ps = 0;
#pragma unroll
    for (int r = 0; r < 16; ++r) ps += p0[r];
#pragma unroll
    for (int r = 0; r < 16; ++r) ps += p1[r];
    { auto rr = __builtin_amdgcn_permlane32_swap(__float_as_uint(ps), __float_as_uint(ps), false, false);
      ps = __uint_as_float(rr[0]) + __uint_as_float(rr[1]); }
    l_reg = l_reg * alpha + ps;
#define PK4(P, B_, OUT) do { unsigned a0 = cvtpk(P[B_+0], P[B_+1]), a1 = cvtpk(P[B_+2], P[B_+3]);                          \
        unsigned b0 = cvtpk(P[B_+4], P[B_+5]), b1 = cvtpk(P[B_+6], P[B_+7]);                                             \
        auto r0 = __builtin_amdgcn_permlane32_swap(a0, b0, false, false); auto r1 = __builtin_amdgcn_permlane32_swap(a1, b1, false, false); \
        v4u w = {r0[0], r1[0], r0[1], r1[1]}; OUT = *reinterpret_cast<bf16x8*>(&w); } while (0)
    PK4(p0, 0, pa0); PK4(p0, 8, pa1); PK4(p1, 0, pa2); PK4(p1, 8, pa3);
#undef PK4
}
template <int KB>
__device__ __forceinline__ void qkt(f32x16& p0, f32x16& p1, const char* K_lds, int r32, int hi, const bf16x8* qr, bool act) {
    if (!act) { const float NEG = -__builtin_inff();
#pragma unroll
        for (int r = 0; r < 16; ++r) { p0[r] = NEG; p1[r] = NEG; } return; }
    p0 = f32x16{}; p1 = f32x16{};
    const char* kb[4];
#pragma unroll
    for (int dd = 0; dd < 4; ++dd) kb[dd] = K_lds + KB * SHM_K + KSWZ(r32, (dd * 16 + hi * 8) * 2);
#pragma unroll
    for (int d0 = 0; d0 < 8; ++d0) { const char* a = kb[d0 & 3] + (d0 >> 2) * 128;
        bf16x8 b0 = *reinterpret_cast<const bf16x8*>(a);
        bf16x8 b1 = *reinterpret_cast<const bf16x8*>(a + 32 * 256);
        p0 = __builtin_amdgcn_mfma_f32_32x32x16_bf16(b0, qr[d0], p0, 0, 0, 0);
        p1 = __builtin_amdgcn_mfma_f32_32x32x16_bf16(b1, qr[d0], p1, 0, 0, 0); }
}
template <int VB>
__device__ __forceinline__ void pv_tile(f32x16* o, int vb0, bf16x8 pa0, bf16x8 pa1, bf16x8 pa2, bf16x8 pa3, bool act) {
    if (!act) return;
#define TRRD(dst, off) asm volatile("ds_read_b64_tr_b16 %0, %1 offset:%2" : "=&v"(dst) : "v"(vb0), "i"(off) : "memory")
#define PV_D0(d0) do { s16x4 l0, l1, l2, l3, h0, h1, h2, h3; constexpr int b_ = VB * SHM_V + v_rd_off(d0, 0, 0); \
        TRRD(l0, b_); TRRD(h0, b_ + 2048); TRRD(l1, b_ + 4096); TRRD(h1, b_ + 6144); TRRD(l2, b_ + 8192); TRRD(h2, b_ + 10240); TRRD(l3, b_ + 12288); TRRD(h3, b_ + 14336); \
        asm volatile("s_waitcnt lgkmcnt(0)" ::: "memory"); SBAR();   \
        o[d0] = __builtin_amdgcn_mfma_f32_32x32x16_bf16(pa0, (bf16x8){l0[0], l0[1], l0[2], l0[3], h0[0], h0[1], h0[2], h0[3]}, o[d0], 0, 0, 0);   \
        o[d0] = __builtin_amdgcn_mfma_f32_32x32x16_bf16(pa1, (bf16x8){l1[0], l1[1], l1[2], l1[3], h1[0], h1[1], h1[2], h1[3]}, o[d0], 0, 0, 0);   \
        o[d0] = __builtin_amdgcn_mfma_f32_32x32x16_bf16(pa2, (bf16x8){l2[0], l2[1], l2[2], l2[3], h2[0], h2[1], h2[2], h2[3]}, o[d0], 0, 0, 0);   \
        o[d0] = __builtin_amdgcn_mfma_f32_32x32x16_bf16(pa3, (bf16x8){l3[0], l3[1], l3[2], l3[3], h3[0], h3[1], h3[2], h3[3]}, o[d0], 0, 0, 0); } while (0)
    PV_D0(0); PV_D0(1); PV_D0(2); PV_D0(3);
#undef PV_D0
#undef TRRD
}
struct BlockRef { const bf16_t* Q; const bf16_t* K; const bf16_t* V; bf16_t* O; int qb; int h; };
struct Seam { bf16x8 qr[8]; bf16x8 st_v0, st_v1, st_k0, st_k1; };
#define ROW(p, k0, rr) ((p) + (size_t)((k0) + (rr)) * LDQ + sc)
#define VMW() asm volatile("s_waitcnt vmcnt(0)" ::: "memory")
#define VMWN(n) asm volatile("s_waitcnt vmcnt(%0)" :: "i"(n) : "memory")
#define SLOAD_H(Kp, Vp, k0) do { S.st_v0 = load8(ROW(Vp, k0, sr)); S.st_v1 = load8(ROW(Vp, k0, 32 + sr));              \
                         S.st_k0 = load8(ROW(Kp, k0, sr)); S.st_k1 = load8(ROW(Kp, k0, 32 + sr)); } while (0)
#define SWRITE_HK(bf) do { *(bf16x8*)(K_lds + (bf) * SHM_K + kws) = S.st_k0; *(bf16x8*)(K_lds + (bf) * SHM_K + kws + 32 * 256) = S.st_k1; } while (0)
#define SWRITE_HV(bf) do { *(bf16x8*)(V_lds + (bf) * SHM_V + vst0) = S.st_v0; *(bf16x8*)(V_lds + (bf) * SHM_V + vst1) = S.st_v1; } while (0)
#define SWRITE_H(bf) do { SWRITE_HV(bf); SWRITE_HK(bf); } while (0)
__device__ __forceinline__ void att_prime(const BlockRef& cur, char* lds, Seam& S) {
    const int tid = threadIdx.x, wid = __builtin_amdgcn_readfirstlane(tid >> 6), lane = tid & 63, r32 = lane & 31, hi = lane >> 5;
    const int sr = tid >> 4, sc = (tid & 15) * 8, kws = KSWZ(sr, sc * 2); char* K_lds = lds + 2 * SHM_V;
    const int kb0 = jlo(cur.qb) * KVBLK;
#pragma unroll
    for (int d0 = 0; d0 < 8; ++d0) S.qr[d0] = load8(cur.Q + (size_t)(wid * QBLK + r32) * LDQ + d0 * 16 + hi * 8);
    SLOAD_H(cur.K, cur.V, kb0); VMW(); SWRITE_HK(0);
    __syncthreads();
}
__device__ __forceinline__ void att_block(const BlockRef& cur, const BlockRef& nxt, char* lds, Seam& S) {
    const int tid = threadIdx.x, wid = __builtin_amdgcn_readfirstlane(tid >> 6), lane = tid & 63, r32 = lane & 31, hi = lane >> 5;
    const int j_lo = jlo(cur.qb), j_hi = 4 * cur.qb + 4;
    const int NT = j_hi - j_lo;
    const int kbn = jlo(nxt.qb) * KVBLK;
    const int cq = 4 * cur.qb + (wid >> 1);
    const int qlo = cur.qb * QB + wid * QBLK, qpos = qlo + r32;
    const float* bl = (const float*)(lds + BIAS_OFF) + cur.h * 320;
    char* V_lds = lds; char* K_lds = lds + 2 * SHM_V;
    float* ws = (float*)(lds + 2 * SHM_V + 2 * SHM_K) + wid * 64; float* li_l = ws, * al_l = ws + 32;
    float m_reg = -1e30f, l_reg = 0; f32x16 o[4] = {};
    const int sr = tid >> 4, sc = (tid & 15) * 8, vst0 = v_st(sr, sc), vst1 = v_st(32 + sr, sc), kws = KSWZ(sr, sc * 2);
    const int vb0 = (int)(uintptr_t)V_lds + v_rd_base(lane);
    const bf16_t* Kh = cur.K; const bf16_t* Vh = cur.V;
#define RESC(a) do { if (__any((a) < 1.f)) { if (hi == 0) al_l[r32] = (a); asm volatile("s_waitcnt lgkmcnt(0)" ::: "memory");              \
                     for (int d_ = 0; d_ < 4; ++d_) for (int r = 0; r < 16; ++r) o[d_][r] *= al_l[crow(r, hi)]; } } while (0)
#define KBASE(t) ((j_lo + (t)) * KVBLK)
#define ACT(t) ((j_lo + (t)) <= cq && (j_lo + (t)) + 8 >= cq)
#define BIAST(P0_, P1_, t) do { if (ACT(t)) bias_tile(P0_, P1_, qpos - KBASE(t) - 4 * hi, qlo - KBASE(t), bl); } while (0)
    constexpr int NQL = 8;
#define SEAM_K0() do { VMWN(NQL); SWRITE_HK(0); SBAR(); } while (0)
    f32x16 pA0, pA1, pB0, pB1; float mnA, mnB, alA, alB; bf16x8 pa0, pa1, pa2, pa3;
    SWRITE_HV(0); SBAR();
    if (NT > 1) { SLOAD_H(Kh, Vh, KBASE(1)); }
    SBAR(); qkt<0>(pA0, pA1, K_lds, r32, hi, S.qr, ACT(0));
    BIAST(pA0, pA1, 0); partialSM(pA0, pA1, m_reg, mnA, alA);
    if (NT > 1) { VMW(); SWRITE_H(1); }
    __syncthreads();
#define HALF_STEP(PX0, PX1, mnX, alX, PY0, PY1, alY, t, KB, VB, SB) do {                                                      \
        SBAR(); qkt<KB>(PX0, PX1, K_lds, r32, hi, S.qr, ACT(t));                                             \
        finishSM(PY0, PY1, alY, l_reg, pa0, pa1, pa2, pa3); SBAR();                                                           \
        if ((t) + 1 < NT) { SLOAD_H(Kh, Vh, KBASE((t) + 1)); SBAR(); }                                               \
        pv_tile<VB>(o, vb0, pa0, pa1, pa2, pa3, ACT((t) - 1)); BIAST(PX0, PX1, (t)); partialSM(PX0, PX1, m_reg, mnX, alX);                                        \
        __syncthreads();                                                                                                      \
        if ((t) + 1 < NT) { VMW(); SWRITE_H(SB); }                                                                          \
        RESC(alX); __syncthreads(); } while (0)
    for (int t = 1; t + 1 < NT; t += 2) {
        HALF_STEP(pB0, pB1, mnB, alB, pA0, pA1, alA, t, 1, 0, 0);
        HALF_STEP(pA0, pA1, mnA, alA, pB0, pB1, alB, t + 1, 0, 1, 1);
    }
    const bool even = (NT & 1) == 0;
    if (even) { SBAR(); qkt<1>(pB0, pB1, K_lds, r32, hi, S.qr, ACT(NT - 1)); SBAR(); }
    SLOAD_H(nxt.K, nxt.V, kbn); SBAR();
#pragma unroll
    for (int d0 = 0; d0 < 8; ++d0) S.qr[d0] = load8(nxt.Q + (size_t)(wid * QBLK + r32) * LDQ + d0 * 16 + hi * 8);
    SBAR();
    finishSM(pA0, pA1, alA, l_reg, pa0, pa1, pa2, pa3); SBAR();
    pv_tile<0>(o, vb0, pa0, pa1, pa2, pa3, ACT(even ? NT - 2 : NT - 1));
    if (even) { BIAST(pB0, pB1, NT - 1); partialSM(pB0, pB1, m_reg, mnB, alB); __syncthreads(); RESC(alB);
        finishSM(pB0, pB1, alB, l_reg, pa0, pa1, pa2, pa3); SBAR(); pv_tile<1>(o, vb0, pa0, pa1, pa2, pa3, ACT(NT - 1)); }
    SBAR(); SEAM_K0();
    if (hi == 0) li_l[r32] = l_reg; asm volatile("s_waitcnt lgkmcnt(0)" ::: "memory");
    float rli[16];
#pragma unroll
    for (int r = 0; r < 16; ++r) rli[r] = __builtin_amdgcn_rcpf(li_l[crow(r, hi)]);
    bf16_t* Ow = cur.O + (size_t)(wid * QBLK) * LDO;
#pragma unroll
    for (int r = 0; r < 16; ++r) { const int orow = crow(r, hi);
#pragma unroll
        for (int d0 = 0; d0 < 4; ++d0) { const float v = o[d0][r] * rli[r];
            const float vn = __shfl_xor(v, 1);
            if ((r32 & 1) == 0) *(unsigned*)(Ow + (size_t)orow * LDO + d0 * 32 + r32) = cvtpk(v, vn); } }
    __syncthreads();
#undef RESC
#undef KBASE
#undef ACT
#undef BIAST
#undef SEAM_K0
#undef HALF_STEP
}
#undef ROW
#undef VMW
#undef VMWN
#undef SLOAD_H
#undef SWRITE_HK
#undef SWRITE_HV
#undef SWRITE_H
#undef SBAR
#undef KSWZ
}

#define XB_TMO      128
#define XB_XCNT(j)  (256  + 64 * (j))
#define XB_XSUB(j)  (1280 + 64 * (j))
#define XB_XGEN(j)  (2304 + 64 * (j))
#define XB_TOP      3328
#define XB_TOPGEN   3392
#define XCD_BAR_WORDS 3456
#define XB_SPIN_CAP (1u << 18)
__device__ __forceinline__ unsigned xb_ld(unsigned* p)              { return __hip_atomic_load(p, __ATOMIC_RELAXED, __HIP_MEMORY_SCOPE_AGENT); }
__device__ __forceinline__ unsigned xb_add(unsigned* p, unsigned v) { return __hip_atomic_fetch_add(p, v, __ATOMIC_RELAXED, __HIP_MEMORY_SCOPE_AGENT); }
__device__ __forceinline__ unsigned xb_xcc_id() { return (unsigned)__builtin_amdgcn_s_getreg((3 << 11) | 20) & 0xFu; }
#define XB_SPIN(cond, bar) do { unsigned _sp = 0; while (cond) { __builtin_amdgcn_s_sleep(1); \
    if ((++_sp & 255u) == 0u) { if (xb_ld(&(bar)[XB_TMO])) break; if (_sp > XB_SPIN_CAP) { atomicAdd(&(bar)[XB_TMO], 1u); break; } } } } while (0)
struct XcdBarrier { unsigned* bar; unsigned x; volatile LAS unsigned* st; };
__device__ __forceinline__ XcdBarrier xcd_barrier_post(unsigned* bar, volatile LAS unsigned* st) {
    XcdBarrier b; b.bar = bar; b.x = xb_xcc_id(); b.st = st;
    if (threadIdx.x == 0) (void)xb_add(&bar[XB_XCNT(b.x)], 1u);
    return b;
}
__device__ __forceinline__ void xcd_barrier_complete(unsigned* bar, unsigned x, unsigned& nloc, unsigned& nx) {
    const unsigned G = gridDim.x * gridDim.y * gridDim.z;
    unsigned sum, cnt, mine, sp = 0u;
    for (;;) {
        sum = 0u; cnt = 0u; mine = 0u;
#pragma unroll
        for (unsigned j = 0; j < 16; ++j) { const unsigned c = xb_ld(&bar[XB_XCNT(j)]); sum += c; cnt += (c > 0u) ? 1u : 0u; mine = (j == x) ? c : mine; }
        if (sum == G) break;
        __builtin_amdgcn_s_sleep(1);
        if ((++sp & 255u) == 0u) { if (xb_ld(&bar[XB_TMO])) break; if (sp > XB_SPIN_CAP) { atomicAdd(&bar[XB_TMO], 1u); break; } }
    }
    nloc = mine > 0u ? mine : 1u; nx = cnt > 0u ? cnt : 1u;
}
__device__ __forceinline__ void xcd_barrier(const XcdBarrier& b) {
    asm volatile("s_waitcnt vmcnt(0)" ::: "memory");
    __syncthreads();
    if (threadIdx.x == 0) {
        unsigned* bar = b.bar;
        __builtin_amdgcn_s_waitcnt(0);
        unsigned nloc = b.st[0], nx = b.st[1];
        if (nloc == 0u) { xcd_barrier_complete(bar, b.x, nloc, nx); b.st[0] = nloc; b.st[1] = nx; }
        const unsigned old = xb_add(&bar[XB_XSUB(b.x)], 1u);
        const unsigned gen = old / nloc;
        if (old + 1u == (gen + 1u) * nloc) {
            __builtin_amdgcn_fence(__ATOMIC_RELEASE, "agent");
            asm volatile("s_waitcnt vmcnt(0)" ::: "memory");
            const unsigned og = xb_add(&bar[XB_TOP], 1u);
            const unsigned tg = og / nx;
            if (og + 1u == (tg + 1u) * nx) xb_add(&bar[XB_TOPGEN], 1u);
            else XB_SPIN(xb_ld(&bar[XB_TOPGEN]) == tg, bar);
            __builtin_amdgcn_fence(__ATOMIC_ACQUIRE, "agent");
            xb_add(&bar[XB_XGEN(b.x)], 1u);
            asm volatile("s_waitcnt vmcnt(0)" ::: "memory");
        } else {
            XB_SPIN(xb_ld(&bar[XB_XGEN(b.x)]) == gen, bar);
            __builtin_amdgcn_fence(__ATOMIC_ACQUIRE, "agent");
            asm volatile("s_waitcnt vmcnt(0)" ::: "memory");
        }
    }
    __syncthreads();
}

struct Args { const float* in[26]; float* out; unsigned char* ws; int ph_lo, ph_hi; };
__device__ __forceinline__ const float* arg_ptr(int k) { int o = k * 8; asm volatile("" : "+s"(o)); return *(const float* const*)((const char*)__builtin_amdgcn_kernarg_segment_ptr() + o); }
struct Frame {
    LAS unsigned char* lds;
    int tid, lane, wave, vcu, G;
    float* out; unsigned char* ws;
    __device__ __forceinline__ const float* x_prompt() const { return arg_ptr(0); }
    __device__ __forceinline__ const float* x_sample() const { return arg_ptr(1); }
    __device__ __forceinline__ const float* c_prompt() const { return arg_ptr(2); }
    __device__ __forceinline__ const float* c_sample() const { return arg_ptr(3); }
    __device__ __forceinline__ const float* cache_k() const { return arg_ptr(4); }
    __device__ __forceinline__ const float* cache_v() const { return arg_ptr(5); }
    __device__ __forceinline__ const float* st_h() const { return arg_ptr(6); }
    __device__ __forceinline__ const float* st_conv() const { return arg_ptr(7); }
    __device__ __forceinline__ const float* w_mod() const { return arg_ptr(8); }
    __device__ __forceinline__ const float* b_mod() const { return arg_ptr(9); }
    __device__ __forceinline__ const float* w_in() const { return arg_ptr(10); }
    __device__ __forceinline__ const float* rel_bias() const { return arg_ptr(11); }
    __device__ __forceinline__ const float* conv_w() const { return arg_ptr(12); }
    __device__ __forceinline__ const float* conv_b() const { return arg_ptr(13); }
    __device__ __forceinline__ const float* w_rg_a() const { return arg_ptr(14); }
    __device__ __forceinline__ const float* b_rg_a() const { return arg_ptr(15); }
    __device__ __forceinline__ const float* w_rg_x() const { return arg_ptr(16); }
    __device__ __forceinline__ const float* b_rg_x() const { return arg_ptr(17); }
    __device__ __forceinline__ const float* rg_lambda() const { return arg_ptr(18); }
    __device__ __forceinline__ const float* w_pa() const { return arg_ptr(19); }
    __device__ __forceinline__ const float* w_pr() const { return arg_ptr(20); }
    __device__ __forceinline__ const float* w_out() const { return arg_ptr(21); }
    __device__ __forceinline__ const float* w_gate() const { return arg_ptr(22); }
    __device__ __forceinline__ const float* w_up() const { return arg_ptr(23); }
    __device__ __forceinline__ const float* w_down() const { return arg_ptr(24); }
    __device__ __forceinline__ const float* fng() const { return arg_ptr(25); }
    __device__ __forceinline__ float* mod() const { return (float*)(ws + WS_MOD); }
    __device__ __forceinline__ float* x1() const { return (float*)(ws + WS_OY); }
    __device__ __forceinline__ float* slab4() const { return (float*)(ws + WS_SLAB4); }
    __device__ __forceinline__ float* slab6() const { return (float*)(ws + WS_SLAB6); }
    __device__ __forceinline__ float* slab9() const { return (float*)(ws + WS_SLAB9); }
    __device__ __forceinline__ bf16_t* Win_t() const { return (bf16_t*)(ws + WS_WIN); }
    __device__ __forceinline__ bf16_t* Wproj_t() const { return (bf16_t*)(ws + WS_WPROJ); }
    __device__ __forceinline__ bf16_t* Wout_t() const { return (bf16_t*)(ws + WS_WOUT); }
    __device__ __forceinline__ bf16_t* Wgu_t() const { return (bf16_t*)(ws + WS_WGU); }
    __device__ __forceinline__ bf16_t* Wdn_t() const { return (bf16_t*)(ws + WS_WDN); }
    __device__ __forceinline__ bf16_t* Wrg_t() const { return (bf16_t*)(ws + WS_WRG); }
    __device__ __forceinline__ bf16_t* H1() const { return (bf16_t*)(ws + WS_H1); }
    __device__ __forceinline__ bf16_t* Qb() const { return (bf16_t*)(ws + WS_Q); }
    __device__ __forceinline__ bf16_t* Kb() const { return (bf16_t*)(ws + WS_K); }
    __device__ __forceinline__ bf16_t* Vb() const { return (bf16_t*)(ws + WS_V); }
    __device__ __forceinline__ bf16_t* Ub() const { return (bf16_t*)(ws + WS_U); }
    __device__ __forceinline__ bf16_t* Gb() const { return (bf16_t*)(ws + WS_G); }
    __device__ __forceinline__ bf16_t* SAb() const { return (bf16_t*)(ws + WS_SA); }
    __device__ __forceinline__ bf16_t* SRb() const { return (bf16_t*)(ws + WS_SR); }
    __device__ __forceinline__ bf16_t* OY() const { return (bf16_t*)(ws + WS_OY); }
    __device__ __forceinline__ bf16_t* MG() const { return (bf16_t*)(ws + WS_MERGED); }
    __device__ __forceinline__ bf16_t* ACT() const { return (bf16_t*)(ws + WS_ACT); }
    __device__ __forceinline__ gu64* gran() const { return (gu64*)(ws + WS_GRAN); }
    __device__ __forceinline__ void refresh() { int t = threadIdx.x; asm volatile("" : "+v"(t)); tid = t; lane = t & 63; wave = __builtin_amdgcn_readfirstlane(t >> 6); }
};

__device__ __forceinline__ void xpose_item(const float* W, int N, bf16_t* WT, size_t ldo, int k0, int n0, int drow0, int dcol0, LAS float* scr, int lane) {
#pragma unroll 8
    for (int i = 0; i < 32; ++i) { const int kk = 2 * i + (lane >> 5); scr[kk * 33 + (lane & 31)] = W[(size_t)(k0 + kk) * N + n0 + (lane & 31)]; }
    LDS_WAIT(); asm volatile("" ::: "memory");
    const int c = lane & 7;
#pragma unroll
    for (int j = 0; j < 4; ++j) { const int n = (lane >> 3) + 8 * j; const LAS float* s = scr + (8 * c) * 33 + n;
        v4u o; o.x = pk2(s[0 * 33], s[1 * 33]); o.y = pk2(s[2 * 33], s[3 * 33]); o.z = pk2(s[4 * 33], s[5 * 33]); o.w = pk2(s[6 * 33], s[7 * 33]);
        *(GAS v4u*)(WT + (size_t)(drow0 + n) * ldo + dcol0 + 8 * c) = o; }
    LDS_WAIT(); asm volatile("" ::: "memory");
}
__device__ __forceinline__ void norm_regs_bf16(const f32x4 (&v)[8], const float* shift, const float* scale, bf16_t* orow, int lane) {
    f32x4 sc[8], sh[8];
#pragma unroll
    for (int j = 0; j < 8; ++j) { sc[j] = *((const GAS f32x4*)scale + lane + 64 * j); sh[j] = *((const GAS f32x4*)shift + lane + 64 * j); }
    float s = 0.f;
#pragma unroll
    for (int j = 0; j < 8; ++j) s += (v[j].x * v[j].x + v[j].y * v[j].y) + (v[j].z * v[j].z + v[j].w * v[j].w);
    const float rinv = rsqrtf(wave_sum(s) * (1.f / DM) + EPS);
    GAS v2u* o8 = (GAS v2u*)orow + lane;
#pragma unroll
    for (int j = 0; j < 8; ++j) { const f32x4 y = v[j] * rinv * (sc[j] + 1.f) + sh[j]; v2u w; w.x = pk2(y.x, y.y); w.y = pk2(y.z, y.w); o8[64 * j] = w; }
}
__device__ __forceinline__ void load_row(f32x4 (&v)[8], const float* row, int lane) {
    const GAS f32x4* xr = (const GAS f32x4*)row + lane;
#pragma unroll
    for (int j = 0; j < 8; ++j) v[j] = xr[64 * j];
}
__device__ __forceinline__ void phase0(Frame& F, bool dry = false) {
    const float* p_cp = F.c_prompt(); const float* p_cs = F.c_sample(); const float* p_wm = F.w_mod(); const float* p_bm = F.b_mod(); float* p_mod = F.mod(); const float* p_win = F.w_in(); bf16_t* p_wint = F.Win_t();
    { gu64* g = F.gran(); for (size_t i = (size_t)F.vcu * 512 + F.tid; i < 3 * 131072; i += (size_t)F.G * 512) g[i] = 0ull; }
    LAS float* sc = (LAS float*)(F.lds);
    LAS float* red = (LAS float*)(F.lds + 8192);
    for (int it = F.vcu; it < 768; it += F.G) {
        const int nc = it % 48, ks = it / 48;
        for (int i = F.tid; i < 1280; i += 512) { const int b = i >> 7, k = ks * 128 + (i & 127);
            const float cv = b < 2 ? p_cp[b * DM + k] : p_cs[(b - 2) * DM + k];
            sc[i] = cv * sigm(cv); }
        __syncthreads();
        f32x4 acc[10];
#pragma unroll
        for (int b = 0; b < 10; ++b) acc[b] = (f32x4){0.f, 0.f, 0.f, 0.f};
        const float* wp = p_wm + (size_t)(ks * 128 + F.wave * 16) * NMOD + nc * 256 + 4 * F.lane;
#pragma unroll 4
        for (int kk = 0; kk < 16; ++kk) { const f32x4 w = *(const GAS f32x4*)(wp + (size_t)kk * NMOD);
#pragma unroll
            for (int b = 0; b < 10; ++b) { const float s = sc[b * 128 + F.wave * 16 + kk]; acc[b] += w * s; } }
#pragma unroll
        for (int b = 0; b < 10; ++b) *(LAS f32x4*)(red + (F.wave * 10 + b) * 256 + 4 * F.lane) = acc[b];
        __syncthreads();
        for (int o = F.tid; o < 2560; o += 512) { const int b = o >> 8, col = o & 255; float s = 0.f;
#pragma unroll
            for (int w = 0; w < 8; ++w) s += red[(w * 10 + b) * 256 + col];
            if (ks == 0) s += p_bm[nc * 256 + col];
            if (!dry) atomicAdd(p_mod + (size_t)b * NMOD + nc * 256 + col, s); }
        __syncthreads();
    }
    LAS float* scr = (LAS float*)(F.lds + F.wave * 16384);
    const int gw = F.vcu * NWAVES + F.wave, NGW = F.G * NWAVES;
    for (int it = gw; it < 32 * 448; it += NGW) { const int kb = it / 448, nb = it % 448;
        xpose_item(p_win, NIN, p_wint, DM, kb * 64, nb * 32, nb * 32, kb * 64, scr, F.lane); }
}
constexpr int I_P = 32 * 64, I_G = 32 * 176, I_D = 88 * 64, I_R = 256;
constexpr int NITEMS_A = 3 * I_P + I_R, NITEMS_B = 2 * I_G + I_D;
__device__ __forceinline__ void conv_item_a(Frame& F, int r, LAS float* scr) {
    if (r < I_P) { const int kb = r / 64, nb = r % 64; xpose_item(F.w_pa(), DM, F.Wproj_t(), 4096, kb * 64, nb * 32, nb * 32, kb * 64, scr, F.lane); return; } r -= I_P;
    if (r < I_P) { const int kb = r / 64, nb = r % 64; xpose_item(F.w_pr(), DM, F.Wproj_t(), 4096, kb * 64, nb * 32, nb * 32, 2048 + kb * 64, scr, F.lane); return; } r -= I_P;
    if (r < I_P) { const int kb = r / 64, nb = r % 64; xpose_item(F.w_out(), DM, F.Wout_t(), DM, kb * 64, nb * 32, nb * 32, kb * 64, scr, F.lane); return; } r -= I_P;
    { const int mat = r >> 3, sub = r & 7, kb = sub >> 2, nb = sub & 3;
      const float* src = (mat < 16 ? F.w_rg_a() : F.w_rg_x()) + (size_t)(mat & 15) * 16384;
      xpose_item(src, 128, F.Wrg_t() + (size_t)mat * 16384, 128, kb * 64, nb * 32, nb * 32, kb * 64, scr, F.lane); }
}
__device__ __forceinline__ void conv_item_b(Frame& F, int r, LAS float* scr) {
    if (r < I_G) { const int kb = r / 176, nb = r % 176, n0 = nb * 32; xpose_item(F.w_gate(), DFF, F.Wgu_t(), DM, kb * 64, n0, (n0 >> 7) * 256 + (n0 & 127), kb * 64, scr, F.lane); return; } r -= I_G;
    if (r < I_G) { const int kb = r / 176, nb = r % 176, n0 = nb * 32; xpose_item(F.w_up(), DFF, F.Wgu_t(), DM, kb * 64, n0, (n0 >> 7) * 256 + 128 + (n0 & 127), kb * 64, scr, F.lane); return; } r -= I_G;
    { const int kb = r / 64, nb = r % 64; xpose_item(F.w_down(), DM, F.Wdn_t(), DFF, kb * 64, nb * 32, nb * 32, kb * 64, scr, F.lane); }
}
__device__ __forceinline__ void phase1(Frame& F) {
    const float* p_xp = F.x_prompt(); const float* p_xs = F.x_sample(); const float* p_mod = F.mod(); bf16_t* p_H1 = F.H1(); const float* p_sl6 = F.slab6(); const float* p_sl9 = F.slab9(); float* p_x1 = F.x1(); const float* p_fng = F.fng();
    LAS float* scr = (LAS float*)(F.lds + F.wave * 16384);
    const int gw = F.vcu * NWAVES + F.wave, NGW = F.G * NWAVES;
    for (int it = gw; it < NITEMS_A; it += NGW) conv_item_a(F, it, scr);
    for (int m = gw; m < MPAD; m += NGW) {
        bf16_t* orow = p_H1 + (size_t)m * DM;
        if (m >= MV) { GAS v2u* o8 = (GAS v2u*)orow + F.lane;
#pragma unroll
            for (int j = 0; j < 8; ++j) o8[64 * j] = (v2u){0u, 0u};
            continue; }
        const float* xrow = m < MP ? p_xp + (size_t)m * DM : p_xs + (size_t)(m - MP) * DM;
        const int seq = m < MP ? (m >> 12) : 2 + ((m - MP) >> 4);
        const float* md = p_mod + (size_t)seq * NMOD;
        f32x4 v[8]; load_row(v, xrow, F.lane);
        norm_regs_bf16(v, md, md + DM, orow, F.lane);
    }
}
__device__ __forceinline__ void phase_norm2s(Frame& F, int gw, int NGW, unsigned* ready) {
    const float* p_xs = F.x_sample(); const float* p_mod = F.mod(); bf16_t* p_H1 = F.H1(); const float* p_sl6 = F.slab6(); float* p_x1 = F.x1();
    for (int r = gw; r < MS; r += NGW) { const int m = MP + r;
        const float* md = p_mod + (size_t)(2 + (r >> 4)) * NMOD;
        f32x4 v[8], a[8]; load_row(v, p_xs + (size_t)r * DM, F.lane); load_row(a, p_sl6 + (size_t)r * DM, F.lane);
#pragma unroll 5
        for (int k = 1; k < NSL6; ++k) { f32x4 t[8]; load_row(t, p_sl6 + (size_t)(k * 128 + r) * DM, F.lane);
#pragma unroll
            for (int j = 0; j < 8; ++j) a[j] += t[j]; }
        GAS f32x4* xo = (GAS f32x4*)(p_x1 + (size_t)m * DM) + F.lane;
#pragma unroll
        for (int j = 0; j < 8; ++j) { const f32x4 g = *((const GAS f32x4*)(md + 2 * DM) + F.lane + 64 * j); v[j] = v[j] + g * a[j]; xo[64 * j] = v[j]; }
        norm_regs_bf16(v, md + 3 * DM, md + 4 * DM, p_H1 + (size_t)m * DM, F.lane);
        asm volatile("s_waitcnt vmcnt(0)" ::: "memory");
        __builtin_amdgcn_fence(__ATOMIC_RELEASE, "agent");
        asm volatile("s_waitcnt vmcnt(0)" ::: "memory");
        if (F.lane == 0) __hip_atomic_fetch_add(ready, 1u, __ATOMIC_RELAXED, __HIP_MEMORY_SCOPE_AGENT);
    }
}
__device__ __forceinline__ void phase_finals(Frame& F) {
    const float* p_mod = F.mod(); const float* p_sl9 = F.slab9(); const float* p_x1 = F.x1(); const float* p_fng = F.fng();
    const int gw = F.vcu * NWAVES + F.wave, NGW = F.G * NWAVES;
    for (int r = gw; r < MS; r += NGW) { const int m = MP + r;
        f32x4 v[8], a[8]; load_row(v, p_x1 + (size_t)m * DM, F.lane); load_row(a, p_sl9 + (size_t)r * DM, F.lane);
#pragma unroll 7
        for (int k = 1; k < NSL9; ++k) { f32x4 t[8]; load_row(t, p_sl9 + (size_t)(k * 128 + r) * DM, F.lane);
#pragma unroll
            for (int j = 0; j < 8; ++j) a[j] += t[j]; }
        const float* md = p_mod + (size_t)(2 + (r >> 4)) * NMOD + 5 * DM;
        float s = 0.f;
#pragma unroll
        for (int j = 0; j < 8; ++j) { const f32x4 g = *((const GAS f32x4*)md + F.lane + 64 * j); v[j] = v[j] + g * a[j]; s += (v[j].x * v[j].x + v[j].y * v[j].y) + (v[j].z * v[j].z + v[j].w * v[j].w); }
        const float rinv = rsqrtf(wave_sum(s) * (1.f / DM) + EPS);
        GAS f32x4* xr = (GAS f32x4*)(F.out + (size_t)m * DM) + F.lane;
#pragma unroll
        for (int j = 0; j < 8; ++j) xr[64 * j] = v[j] * rinv * *((const GAS f32x4*)p_fng + F.lane + 64 * j);
    }
}
__device__ __forceinline__ void phase_mgs(Frame& F, unsigned* ready) {
    const GAS f32x4* src = (const GAS f32x4*)F.slab4(); GAS v2u* dst = (GAS v2u*)(F.MG() + (size_t)MP * DM);
    for (int i = F.vcu * 512 + F.tid; i < 128 * DM / 4; i += F.G * 512) { f32x4 a = src[i];
#pragma unroll 8
        for (int k = 1; k < NSL4; ++k) a += src[(size_t)k * (128 * DM / 4) + i];
        v2u w; w.x = pk2(a.x, a.y); w.y = pk2(a.z, a.w); dst[i] = w; }
    asm volatile("s_waitcnt vmcnt(0)" ::: "memory"); __syncthreads();
    if (F.tid == 0) { __builtin_amdgcn_fence(__ATOMIC_RELEASE, "agent"); asm volatile("s_waitcnt vmcnt(0)" ::: "memory"); __hip_atomic_fetch_add(ready, 1u, __ATOMIC_RELAXED, __HIP_MEMORY_SCOPE_AGENT); }
}

constexpr int RG_WL = 4352, RG_W = 34816, RG_TOT = 104448, RG_PRE = 112640, RG_HIN = 120832, RG_TAB = 121344;
__device__ __forceinline__ float gran_poll(gu64* g) {
    unsigned spins = 0;
    for (;;) { const unsigned long long x = __hip_atomic_load(g, RLX_AGENT); if ((unsigned)(x >> 32) == 1u) return __uint_as_float((unsigned)x);
        __builtin_amdgcn_s_sleep(1); if (++spins > (1u << 17)) return 0.f; }
}
__device__ __forceinline__ void rglru_prologue(Frame& F, int n) {
    const bf16_t* p_Wrg = F.Wrg_t();
    for (int i = F.tid; i < 4096; i += 512) { const int row = i >> 4, ch = i & 15;
        const v4u wv = *(const GAS v4u*)(p_Wrg + (size_t)((row >> 7) * 16 + n) * 16384 + (row & 127) * 128 + ch * 8);
        *(LAS v4u*)(F.lds + RG_W + row * 272 + ch * 16) = wv; }
    if (F.tid < 128) { const int c = n * 128 + F.tid; LAS float* tab = (LAS float*)(F.lds + RG_TAB);
        tab[F.tid] = -8.f * log1pf(__expf(-F.rg_lambda()[c])); tab[128 + F.tid] = F.b_rg_a()[c]; tab[256 + F.tid] = F.b_rg_x()[c]; }
    __syncthreads();
}
template <bool SAMPLE>
__device__ __forceinline__ void rglru_unit(Frame& F, int bn, int j) {
    const int w = F.wave, lane = F.lane, fr = lane & 15, fq = lane >> 4;
    const float* p_conv_w = F.conv_w(); const float* p_conv_b = F.conv_b(); const float* p_st_conv = F.st_conv(); const float* p_st_h = F.st_h();
    const bf16_t* p_Ub = F.Ub(); const bf16_t* p_Gb = F.Gb(); bf16_t* p_OY = F.OY(); gu64* p_gran = F.gran();
    int n, seq; long row0;
    if (SAMPLE) { n = bn; seq = 2 + w; row0 = MP + w * 16; } else { seq = bn >> 4; n = bn & 15; row0 = (long)seq * TP + j * 128 + w * 16; }
    const int cb = n * 128;
    LAS unsigned char* wl = F.lds + w * RG_WL;
    const LAS float* tab = (const LAS float*)(F.lds + RG_TAB);
    v4u gpre[4];
#pragma unroll
    for (int i = 0; i < 4; ++i) { const int r = (lane >> 4) + 4 * i; gpre[i] = *(const GAS v4u*)(p_Gb + (size_t)(row0 + r) * DM + cb + (lane & 15) * 8); }
    {
        const int c2 = cb + 2 * lane;
        float cw0[4], cw1[4];
#pragma unroll
        for (int k = 0; k < 4; ++k) { cw0[k] = p_conv_w[k * DM + c2]; cw1[k] = p_conv_w[k * DM + c2 + 1]; }
        const float cb0 = p_conv_b[c2], cb1 = p_conv_b[c2 + 1];
        float u0[19], u1[19];
#pragma unroll
        for (int i = 0; i < 19; ++i) { const int rr = i - 3;
            if (rr < 0) {
                if (SAMPLE) { u0[i] = p_st_conv[(size_t)(w * 3 + i) * DM + c2]; u1[i] = p_st_conv[(size_t)(w * 3 + i) * DM + c2 + 1]; }
                else if (j == 0 && w == 0) { u0[i] = 0.f; u1[i] = 0.f; }
                else { const unsigned p = *(const GAS unsigned*)(p_Ub + (size_t)(row0 + rr) * DM + c2); u0[i] = bflo(p); u1[i] = bfhi(p); }
            } else { const unsigned p = *(const GAS unsigned*)(p_Ub + (size_t)(row0 + rr) * DM + c2); u0[i] = bflo(p); u1[i] = bfhi(p); } }
#pragma unroll
        for (int tt = 0; tt < 16; ++tt) {
            const float x0 = cb0 + cw0[0] * u0[tt] + cw0[1] * u0[tt + 1] + cw0[2] * u0[tt + 2] + cw0[3] * u0[tt + 3];
            const float x1 = cb1 + cw1[0] * u1[tt] + cw1[1] * u1[tt + 1] + cw1[2] * u1[tt + 2] + cw1[3] * u1[tt + 3];
            *(LAS unsigned*)(wl + tt * 272 + lane * 4) = pk2(x0, x1); }
    }
    LDS_WAIT(); asm volatile("" ::: "memory");
    f32x4 acc[2][8];
#pragma unroll
    for (int a = 0; a < 2; ++a)
#pragma unroll
        for (int g = 0; g < 8; ++g) acc[a][g] = (f32x4){0.f, 0.f, 0.f, 0.f};
#pragma unroll
    for (int ks = 0; ks < 4; ++ks) { const bf16x8 a = *(const LAS bf16x8*)(wl + fr * 272 + (32 * ks + 8 * fq) * 2);
#pragma unroll
        for (int wh = 0; wh < 2; ++wh)
#pragma unroll
            for (int g = 0; g < 8; ++g) { const bf16x8 b = *(const LAS bf16x8*)(F.lds + RG_W + (wh * 128 + 16 * g + fr) * 272 + (32 * ks + 8 * fq) * 2);
                acc[wh][g] = __builtin_amdgcn_mfma_f32_16x16x32_bf16(a, b, acc[wh][g], 0, 0, 0); } }
    float Al[8][4], Hl[8][4], HS[8], EA[8], EH[8];
#pragma unroll
    for (int g = 0; g < 8; ++g) {
        const int cl = 16 * g + fr, c = cb + cl;
        const float c8 = tab[cl], ba = tab[128 + cl], bx = tab[256 + cl];
        float A = 1.f, H = 0.f;
#pragma unroll
        for (int reg = 0; reg < 4; ++reg) { const int tt = 4 * fq + reg;
            const float xcv = bf2f(*(const LAS unsigned short*)(wl + tt * 272 + cl * 2));
            const float r = sigm(acc[0][g][reg] + ba), ii = sigm(acc[1][g][reg] + bx);
            const float la = c8 * r, a = __expf(la), bb = __builtin_amdgcn_sqrtf(fmaxf(1.f - a * a, 0.f)) * (ii * xcv);
            H = a * H + bb; A = a * A; Al[g][reg] = A; Hl[g][reg] = H; }
        float IA = A, IH = H;
        { const float xa = __shfl_up(IA, 16), xh = __shfl_up(IH, 16); if (fq >= 1) { IH = IA * xh + IH; IA = IA * xa; } }
        { const float xa = __shfl_up(IA, 32), xh = __shfl_up(IH, 32); if (fq >= 2) { IH = IA * xh + IH; IA = IA * xa; } }
        { const float xa = __shfl_up(IA, 16), xh = __shfl_up(IH, 16); EA[g] = fq ? xa : 1.f; EH[g] = fq ? xh : 0.f; }
        if (SAMPLE) { const float h0 = p_st_h[(size_t)w * DM + c]; HS[g] = EA[g] * h0 + EH[g];
            if (fq == 3) F.out[O_SH + (size_t)w * DM + c] = IA * h0 + IH; }
        else { HS[g] = 0.f; if (fq == 3) *(LAS f32x2*)(F.lds + RG_TOT + (w * 128 + cl) * 8) = (f32x2){IA, IH}; }
    }
#pragma unroll
    for (int i = 0; i < 4; ++i) { const int r = (lane >> 4) + 4 * i; *(LAS v4u*)(wl + r * 272 + (lane & 15) * 16) = gpre[i]; }
    if (!SAMPLE) {
        __syncthreads();
        if (F.tid < 128) { const int c = F.tid; float PA = 1.f, PH = 0.f;
#pragma unroll
            for (int w2 = 0; w2 < 8; ++w2) { *(LAS f32x2*)(F.lds + RG_PRE + (w2 * 128 + c) * 8) = (f32x2){PA, PH};
                const f32x2 t = *(const LAS f32x2*)(F.lds + RG_TOT + (w2 * 128 + c) * 8); PH = t.x * PH + t.y; PA = PA * t.x; }
            gu64* gI = p_gran + (size_t)(bn * 32) * 128 + c; gu64* gA = gI + 131072; gu64* gB = gI + 262144;
            if (j < 31) { __hip_atomic_store(gA + j * 128, (1ull << 32) | (unsigned long long)__float_as_uint(PA), RLX_AGENT);
                          __hip_atomic_store(gB + j * 128, (1ull << 32) | (unsigned long long)__float_as_uint(PH), RLX_AGENT); }
            float hin = 0.f;
            if (j > 0) { float fa = 1.f, fh = 0.f; int k = j - 1; unsigned spins = 0; bool done = false;
                while (!done) {
                    unsigned long long xi[8], xa[8], xb[8];
#pragma unroll
                    for (int i = 0; i < 8; ++i) { const int kk = k - i < 0 ? 0 : k - i; xi[i] = __hip_atomic_load(gI + kk * 128, RLX_AGENT); xa[i] = __hip_atomic_load(gA + kk * 128, RLX_AGENT); xb[i] = __hip_atomic_load(gB + kk * 128, RLX_AGENT); }
                    bool stuck = false;
#pragma unroll
                    for (int i = 0; i < 8; ++i) { if (!done && !stuck) {
                        if ((unsigned)(xi[i] >> 32) == 1u) { hin = fa * __uint_as_float((unsigned)xi[i]) + fh; done = true; }
                        else if ((unsigned)(xa[i] >> 32) == 1u && (unsigned)(xb[i] >> 32) == 1u) { fh = fa * __uint_as_float((unsigned)xb[i]) + fh; fa = fa * __uint_as_float((unsigned)xa[i]); --k; if (k < 0) { hin = fh; done = true; } }
                        else stuck = true; } }
                    if (!done) { __builtin_amdgcn_s_sleep(1); if (++spins > (1u << 16)) break; }
                } }
            const float hout = PA * hin + PH;
            if (j < 31) __hip_atomic_store(gI + j * 128, (1ull << 32) | (unsigned long long)__float_as_uint(hout), RLX_AGENT);
            else F.out[O_PH + (size_t)seq * DM + cb + c] = hout;
            *(LAS float*)(F.lds + RG_HIN + c * 4) = hin; }
        __syncthreads();
#pragma unroll
        for (int g = 0; g < 8; ++g) { const int cl = 16 * g + fr; const f32x2 p = *(const LAS f32x2*)(F.lds + RG_PRE + (w * 128 + cl) * 8);
            const float hw = p.x * *(const LAS float*)(F.lds + RG_HIN + cl * 4) + p.y; HS[g] = EA[g] * hw + EH[g]; }
    }
    LDS_WAIT(); asm volatile("" ::: "memory");
#pragma unroll
    for (int g = 0; g < 8; ++g) { const int cl = 16 * g + fr;
#pragma unroll
        for (int reg = 0; reg < 4; ++reg) { const int tt = 4 * fq + reg; LAS unsigned short* gp = (LAS unsigned short*)(wl + tt * 272 + cl * 2);
            const float h = Al[g][reg] * HS[g] + Hl[g][reg]; *gp = (unsigned short)f2bf(h * bf2f(*gp)); } }
    LDS_WAIT(); asm volatile("" ::: "memory");
#pragma unroll
    for (int i = 0; i < 4; ++i) { const int r = (lane >> 4) + 4 * i; const v4u y = *(const LAS v4u*)(wl + r * 272 + (lane & 15) * 16);
        *(GAS v4u*)(p_OY + (size_t)(row0 + r) * 4096 + 2048 + cb + (lane & 15) * 8) = y; }
    __syncthreads();
}
typedef int i32x4_t __attribute__((ext_vector_type(4)));
__device__ __forceinline__ bf16x8 pack8frag(f32x4 a, f32x4 b) { const v4u w = pack8bf(a, b); return __builtin_bit_cast(bf16x8, w); }
__device__ __forceinline__ void sattn_unit(Frame& F, int bs, int h, int qh) {
    constexpr int RS = 532;
    LAS float* scv = (LAS float*)F.lds;
    LAS float* inv = scv + 16 * RS;
    LAS float* btab = inv + 16;
    LAS float* part = btab + 320;
    const int w = F.wave, lane = F.lane, fr = lane & 15, fq = lane >> 4;
    if (F.tid < 320) btab[F.tid] = F.rel_bias()[h * 320 + F.tid];
    const unsigned lrow = (unsigned)(fr * 2048 + 8 * fq) * 4u;
    {
        bf16x8 qf[4];
#pragma unroll
        for (int ks = 0; ks < 4; ++ks) qf[ks] = *(const GAS bf16x8*)(F.Qb() + (size_t)(MP + bs * 16 + qh * 8 + (fr & 7)) * DM + h * 128 + 32 * ks + 8 * fq);
        const __amdgpu_buffer_rsrc_t rk = __builtin_amdgcn_make_buffer_rsrc((void*)(F.cache_k() + ((size_t)(bs * 512 + 64 * w) * 16 + h) * 128), 0, 0x40000000, 0x00020000);
        f32x4 kr[4][4][2];
#pragma unroll
        for (int t = 0; t < 4; ++t)
#pragma unroll
            for (int ks = 0; ks < 4; ++ks) { const int so = (16 * t * 2048 + 32 * ks) * 4;
                kr[t][ks][0] = __builtin_bit_cast(f32x4, __builtin_amdgcn_raw_buffer_load_b128(rk, lrow, so, 0));
                kr[t][ks][1] = __builtin_bit_cast(f32x4, __builtin_amdgcn_raw_buffer_load_b128(rk, lrow, so + 16, 0)); }
#pragma unroll
        for (int t = 0; t < 4; ++t) { f32x4 acc = {0.f, 0.f, 0.f, 0.f};
#pragma unroll
            for (int ks = 0; ks < 4; ++ks) acc = __builtin_amdgcn_mfma_f32_16x16x32_bf16(pack8frag(kr[t][ks][0], kr[t][ks][1]), qf[ks], acc, 0, 0, 0);
#pragma unroll
            for (int reg = 0; reg < 4; ++reg) scv[fr * RS + 64 * w + 16 * t + 4 * fq + reg] = acc[reg] * ATT_SCALE; }
        if (w == 0) {
            const __amdgpu_buffer_rsrc_t rn = __builtin_amdgcn_make_buffer_rsrc((void*)(F.out + O_SK + (size_t)(bs * 16) * DM + h * 128), 0, 0x40000000, 0x00020000);
            f32x4 acc = {0.f, 0.f, 0.f, 0.f};
#pragma unroll
            for (int ks = 0; ks < 4; ++ks) { const f32x4 a = __builtin_bit_cast(f32x4, __builtin_amdgcn_raw_buffer_load_b128(rn, lrow, 32 * ks * 4, 0)), b = __builtin_bit_cast(f32x4, __builtin_amdgcn_raw_buffer_load_b128(rn, lrow, 32 * ks * 4 + 16, 0));
                acc = __builtin_amdgcn_mfma_f32_16x16x32_bf16(pack8frag(a, b), qf[ks], acc, 0, 0, 0); }
#pragma unroll
            for (int reg = 0; reg < 4; ++reg) scv[fr * RS + 512 + 4 * fq + reg] = acc[reg] * ATT_SCALE; }
    }
    __syncthreads();
    { const int row = w, qp_ = qh * 8 + w; float mx = -1e30f;
        for (int jk = lane; jk < 528; jk += 64) { int diff = jk < 512 ? (512 + qp_ - jk) : (qp_ - (jk - 512)); diff = diff > 256 ? 256 : diff;
            const float v = scv[row * RS + jk] + btab[diff + 63]; scv[row * RS + jk] = v; mx = fmaxf(mx, v); }
        mx = wave_max(mx); float sum = 0.f;
        for (int jk = lane; jk < 528; jk += 64) { const float e = __expf(scv[row * RS + jk] - mx); scv[row * RS + jk] = e; sum += e; }
        sum = wave_sum(sum); if (lane == 0) inv[row] = 1.f / sum; }
    __syncthreads();
    {
        const unsigned lcol = (unsigned)(8 * fq * 2048 + fr) * 4u;
        const __amdgpu_buffer_rsrc_t rv = __builtin_amdgcn_make_buffer_rsrc((void*)(F.cache_v() + ((size_t)(bs * 512 + 64 * w) * 16 + h) * 128), 0, 0x40000000, 0x00020000);
        f32x4 acc[8];
#pragma unroll
        for (int dt = 0; dt < 8; ++dt) acc[dt] = (f32x4){0.f, 0.f, 0.f, 0.f};
#pragma unroll
        for (int kt = 0; kt < 2; ++kt) {
            float vv[8][8];
#pragma unroll
            for (int dt = 0; dt < 8; ++dt)
#pragma unroll
                for (int j = 0; j < 8; ++j) vv[dt][j] = __builtin_bit_cast(float, __builtin_amdgcn_raw_buffer_load_b32(rv, lcol, ((32 * kt + j) * 2048 + 16 * dt) * 4, 0));
            const LAS f32x4* pp = (const LAS f32x4*)(scv + fr * RS + 64 * w + 32 * kt + 8 * fq);
            const bf16x8 pf = pack8frag(pp[0], pp[1]);
#pragma unroll
            for (int dt = 0; dt < 8; ++dt) { const bf16x8 bfr = pack8frag((f32x4){vv[dt][0], vv[dt][1], vv[dt][2], vv[dt][3]}, (f32x4){vv[dt][4], vv[dt][5], vv[dt][6], vv[dt][7]});
                acc[dt] = __builtin_amdgcn_mfma_f32_16x16x32_bf16(pf, bfr, acc[dt], 0, 0, 0); }
        }
        if (w == 0) {
            const __amdgpu_buffer_rsrc_t rn = __builtin_amdgcn_make_buffer_rsrc((void*)(F.out + O_SV + (size_t)(bs * 16) * DM + h * 128), 0, 0x40000000, 0x00020000);
            const unsigned lcn = (unsigned)(8 * (fq & 1) * 2048 + fr) * 4u;
            float vv[8][8];
#pragma unroll
            for (int dt = 0; dt < 8; ++dt)
#pragma unroll
                for (int j = 0; j < 8; ++j) vv[dt][j] = __builtin_bit_cast(float, __builtin_amdgcn_raw_buffer_load_b32(rn, lcn, (j * 2048 + 16 * dt) * 4, 0));
            const LAS f32x4* pp = (const LAS f32x4*)(scv + fr * RS + 512 + 8 * (fq & 1));
            f32x4 p0 = pp[0], p1 = pp[1]; if (fq >= 2) { p0 = (f32x4){0.f, 0.f, 0.f, 0.f}; p1 = p0; }
            const bf16x8 pf = pack8frag(p0, p1);
#pragma unroll
            for (int dt = 0; dt < 8; ++dt) { const bf16x8 bfr = pack8frag((f32x4){vv[dt][0], vv[dt][1], vv[dt][2], vv[dt][3]}, (f32x4){vv[dt][4], vv[dt][5], vv[dt][6], vv[dt][7]});
                acc[dt] = __builtin_amdgcn_mfma_f32_16x16x32_bf16(pf, bfr, acc[dt], 0, 0, 0); }
        }
#pragma unroll
        for (int dt = 0; dt < 8; ++dt)
#pragma unroll
            for (int reg = 0; reg < 4; ++reg) part[(w * 16 + 4 * fq + reg) * 128 + 16 * dt + fr] = acc[dt][reg];
    }
    __syncthreads();
    { const int row = F.tid >> 6, c2 = (F.tid & 63) * 2; f32x2 a = {0.f, 0.f};
#pragma unroll
      for (int w2 = 0; w2 < 8; ++w2) a += *(const LAS f32x2*)(part + (w2 * 16 + row) * 128 + c2);
      a = a * inv[row];
      *(GAS unsigned*)(F.OY() + (size_t)(MP + bs * 16 + qh * 8 + row) * 4096 + h * 128 + c2) = pk2(a.x, a.y); }
    __syncthreads();
}
__device__ __forceinline__ att::BlockRef att_ref(Frame& F, int L) {
    const int bh = L >> 4, qb = L & 15, b = bh >> 4, h = bh & 15;
    att::BlockRef r; const size_t rb = (size_t)b * TP;
    r.Q = F.Qb() + (rb + (size_t)qb * 256) * DM + h * 128; r.K = F.Kb() + rb * DM + h * 128; r.V = F.Vb() + rb * DM + h * 128;
    r.O = F.OY() + (rb + (size_t)qb * 256) * 4096 + h * 128; r.qb = qb; r.h = h; return r;
}
template <int pmask>
__device__ __forceinline__ void phase3(Frame& F, char* ldsg) {
    int wn = -1;
    if (pmask & 1) for (int id = F.vcu; id < 1024; id += F.G) { const int bn = id & 31; if ((bn & 15) != wn) { wn = bn & 15; rglru_prologue(F, wn); } rglru_unit<false>(F, bn, id >> 5); }
    if (pmask & 2) { if ((F.G & 15) == 0) { if ((F.vcu & 15) == 0 && (F.vcu >> 4) < 16) { const int n = F.vcu >> 4; if (n != wn) { wn = n; rglru_prologue(F, wn); } rglru_unit<true>(F, n, 0); } }
        else for (int n = F.vcu; n < 16; n += F.G) { if (n != wn) { wn = n; rglru_prologue(F, wn); } rglru_unit<true>(F, n, 0); } }
    if (pmask & 4) for (int u = F.vcu; u < 256; u += F.G) sattn_unit(F, u >> 5, (u >> 1) & 15, u & 1);
    for (int i = F.tid; i < 5120; i += 512) ((LAS float*)(F.lds + att::BIAS_OFF))[i] = F.rel_bias()[i];
    __syncthreads();
    int L = F.vcu;
    if ((pmask & 8) && L < 512) {
        att::BlockRef cur = att_ref(F, L); att::Seam S; att::att_prime(cur, ldsg, S);
        for (;;) { const bool more = L + F.G < 512; const int Ln = more ? L + F.G : L; const att::BlockRef nxt = more ? att_ref(F, Ln) : cur;
            att::att_block(cur, nxt, ldsg, S); if (!more) break; cur = nxt; L = Ln; }
    }
}

__global__ void __launch_bounds__(NWAVES * 64, 2) fwd(Args args) {
    extern __shared__ __attribute__((aligned(16))) unsigned char lds[];
    Frame F;
    F.lds = (LAS unsigned char*)lds;
    F.tid = threadIdx.x; F.lane = F.tid & 63; F.wave = __builtin_amdgcn_readfirstlane(F.tid >> 6);
    F.G = gridDim.x; { const int bx = blockIdx.x; F.vcu = (F.G % 8 == 0) ? (bx % 8) * (F.G / 8) + bx / 8 : bx; }
    F.out = args.out; F.ws = args.ws;
    unsigned char* ws = args.ws;
    for (int u = F.tid; u < (LDS_BYTES - LDSCTL_OFF) / 4; u += NWAVES * 64) ((LAS unsigned*)(F.lds + LDSCTL_OFF))[u] = 0u;
    __syncthreads();
#if !MK_MULTI
    XcdBarrier bar = xcd_barrier_post((unsigned*)(ws + WS_CTL) + CW_BAR, (volatile LAS unsigned*)(F.lds + MISC_OFF) + 8);
#define GRID_BAR() xcd_barrier(bar)
#else
#define GRID_BAR() do { } while (0)
#endif
    const int lo = args.ph_lo, hi = args.ph_hi;
#ifndef PHMASK
#define PHMASK 0x1ff
#endif
#define IN(k) (((PHMASK >> (k)) & 1) && lo <= (k) && (k) < hi)
#define SEAM(k) do { if (lo <= (k) && (k) + 1 < hi && (k) < 8) GRID_BAR(); } while (0)
#ifndef REP_PHASE
#define REP_PHASE -1
#endif
#define RUNPH(k, ...) do { if (IN(k)) { __VA_ARGS__ } if (REP_PHASE == (k) && IN(k)) { GRID_BAR(); __VA_ARGS__ } SEAM(k); } while (0)
    RUNPH(0, F.refresh(); phase0(F); );
    if (REP_PHASE == 100 && IN(0)) { phase0(F, true); GRID_BAR(); }
    RUNPH(1, F.refresh(); phase1(F); );
    RUNPH(2, F.refresh(); pg8::Gemm g{F.H1(), F.Win_t(), MPAD, NIN, DM}; pg8::StaticOrder S; S.init(MPAD, NIN, DM, F.G, (int)blockIdx.x);
        EpiIn E{F.Qb(), F.out}; pg8::gemm_phase<EpiIn, pg8::StaticOrder, true, true>(F.lds, g, S, E);
        { const int nlast = S.nwg % F.G, nfree = nlast ? F.G - nlast : F.G, fidx = nlast ? (int)blockIdx.x - nlast : (int)blockIdx.x;
          if (fidx >= 0) { LAS float* scr = (LAS float*)(F.lds + F.wave * 16384);
              for (int it = fidx * NWAVES + F.wave; it < NITEMS_B; it += nfree * NWAVES) conv_item_b(F, it, scr); } } );
    RUNPH(3, F.refresh(); phase3<15>(F, (char*)lds); );
    if (REP_PHASE > 100 && REP_PHASE < 116 && IN(3)) { F.refresh(); phase3<(REP_PHASE > 100 ? REP_PHASE - 100 : 15)>(F, (char*)lds); GRID_BAR(); }
    RUNPH(4, F.refresh(); pg8::Gemm g{F.OY(), F.Wproj_t(), MPAD, DM, 2 * DM}; pg8::HybridOrder S; S.init(DM, 2 * DM, F.G, (int)blockIdx.x, 2);
        EpiProj E{F.SAb(), F.SRb(), F.MG(), F.slab4()}; pg8::gemm_phase<EpiProj, pg8::HybridOrder, true, true>(F.lds, g, S, E); );
    RUNPH(5, F.refresh(); pg8::Gemm g{F.MG(), F.Wout_t(), MPAD, DM, DM}; pg8::HybridOrder S; S.init(DM, DM, F.G, (int)blockIdx.x, 2);
        unsigned* rdy = (unsigned*)(F.ws + WS_CTL) + CW_READY + 64; S.ready = rdy; S.need = (unsigned)F.G;
        phase_mgs(F, rdy);
        EpiResNorm E{F.x_prompt(), F.x1(), F.H1(), F.mod(), F.slab6(), F.lds + XL_OFF, (unsigned long long*)(F.ws + WS_XW)};
        pg8::gemm_phase<EpiResNorm, pg8::HybridOrder, true, true>(F.lds, g, S, E); );
    RUNPH(6, F.refresh(); pg8::Gemm g{F.H1(), F.Wgu_t(), MPAD, NGU, DM}; pg8::SampleGatedOrder S; S.init(MPAD, NGU, DM, F.G, (int)blockIdx.x);
        unsigned* ready = (unsigned*)(F.ws + WS_CTL) + CW_READY; S.ready = ready; S.need = MS;
        { const int nlast = S.nwg % F.G, nfree = nlast ? F.G - nlast : F.G, fidx = nlast ? (int)blockIdx.x - nlast : (int)blockIdx.x;
          if (fidx >= 0) phase_norm2s(F, fidx * NWAVES + F.wave, nfree * NWAVES, ready); }
        EpiGU E{F.ACT()}; pg8::gemm_phase<EpiGU, pg8::SampleGatedOrder, true, true>(F.lds, g, S, E); );
    RUNPH(7, F.refresh(); pg8::Gemm g{F.ACT(), F.Wdn_t(), MPAD, DM, DFF}; pg8::HybridOrder S; S.init(DM, DFF, F.G, (int)blockIdx.x, 4);
        EpiResFinal E{F.x1(), F.out, F.mod(), F.fng(), F.slab9(), F.lds + XL_OFF, (unsigned long long*)(F.ws + WS_XW) + 32 * 256};
        pg8::gemm_phase<EpiResFinal, pg8::HybridOrder, true, true>(F.lds, g, S, E); );
    RUNPH(8, F.refresh(); phase_finals(F); );
#undef IN
#undef SEAM
}

extern "C" void kernel_launch(void* const* d_in, const int* in_sizes, int n_in, void* d_out, int out_size, void* d_ws, size_t ws_size, hipStream_t stream) {
    static int grid = 0;
    if (grid == 0) {
        if (n_in != 26 || out_size != (int)O_END || ws_size < WS_END) { fprintf(stderr, "kernel_launch: unexpected shapes (n_in %d out %d ws %zu)\n", n_in, out_size, ws_size); grid = -1; return; }
        int dev = 0, cus = 0, per_cu = 0;
        if (hipGetDevice(&dev) != hipSuccess || hipDeviceGetAttribute(&cus, hipDeviceAttributeMultiprocessorCount, dev) != hipSuccess) { grid = -1; return; }
        if (hipFuncSetAttribute((const void*)fwd, hipFuncAttributeMaxDynamicSharedMemorySize, LDS_BYTES) != hipSuccess) { fprintf(stderr, "kernel_launch: hipFuncSetAttribute failed\n"); grid = -1; return; }
        if (hipOccupancyMaxActiveBlocksPerMultiprocessor(&per_cu, (const void*)fwd, NWAVES * 64, LDS_BYTES) != hipSuccess || per_cu < 1) { fprintf(stderr, "kernel_launch: occupancy query says %d workgroups per CU; nothing launched\n", per_cu); (void)hipGetLastError(); grid = -1; return; }
        grid = cus;
    }
    if (grid < 0) return;
    (void)hipMemsetAsync((char*)d_ws + WS_CTL, 0, CTL_ZERO_BYTES, stream);
    Args a{};
    for (int i = 0; i < 26; ++i) a.in[i] = (const float*)d_in[i];
    a.out = (float*)d_out; a.ws = (unsigned char*)d_ws;
#if MK_MULTI
    for (int p = 0; p < 9; ++p) { a.ph_lo = p; a.ph_hi = p + 1; hipLaunchKernelGGL(fwd, dim3(grid), dim3(NWAVES * 64), LDS_BYTES, stream, a); }
#else
    a.ph_lo = 0; a.ph_hi = 9;
    hipLaunchKernelGGL(fwd, dim3(grid), dim3(NWAVES * 64), LDS_BYTES, stream, a);
#endif
}
```

```cpp
#include <hip/hip_runtime.h>
#include <hip/hip_bf16.h>
#include <cstdio>
#include <cstdint>

#ifndef MK_MULTI
#define MK_MULTI 0
#endif

constexpr int DM = 2048, TP = 4096, NBP = 2, TS = 16, NBS = 8;
constexpr int MP = NBP * TP;
constexpr int MS = NBS * TS;
constexpr int MV = MP + MS;
constexpr int MPAD = 8448;
constexpr int NIN = 14336, DFF = 5632, NGU = 2 * DFF, NMOD = 6 * DM;
constexpr float EPS = 1e-6f;
constexpr float ATT_SCALE = 0.08838834764831845f;
constexpr size_t O_YP = 0, O_YS = 16777216, O_PK = 17039360, O_PV = 19136512, O_PH = 21233664, O_PC = 21237760,
                 O_SK = 21250048, O_SV = 21512192, O_SH = 21774336, O_SC = 21790720, O_END = 21839872;

constexpr size_t MiB = 1u << 20;
constexpr size_t WS_CTL = 0, CTL_ZERO_BYTES = 1 * MiB;
constexpr size_t WS_MOD = 64 * 1024;
constexpr size_t WS_GRAN = 1 * MiB;
constexpr size_t WS_SLAB4 = 218 * MiB, WS_SLAB6 = 251 * MiB, WS_SLAB9 = 350 * MiB;
constexpr int NSL4 = 32, NSL6 = 16, NSL9 = 22;
constexpr size_t WS_WIN = 4 * MiB, WS_WPROJ = 60 * MiB, WS_WOUT = 76 * MiB, WS_WGU = 84 * MiB, WS_WDN = 128 * MiB, WS_WRG = 150 * MiB;
constexpr size_t WS_H1 = 152 * MiB;
constexpr size_t WS_Q = 185 * MiB, WS_K = 218 * MiB, WS_V = 251 * MiB, WS_U = 284 * MiB, WS_G = 317 * MiB, WS_SA = 350 * MiB, WS_SR = 383 * MiB;
constexpr size_t WS_MERGED = WS_Q;
constexpr size_t WS_ACT = WS_K;
constexpr size_t WS_OY = 416 * MiB;
constexpr size_t WS_END = 482 * MiB;
static_assert(WS_ACT + (size_t)MPAD * DFF * 2 <= WS_G, "ACT overlay");
constexpr int CW_TMO = 0, CW_READY = 2048, CW_BAR = 4096;
constexpr size_t WS_XW = 640 * 1024;

constexpr int RING_BYTES = 131072, LDSCTL_OFF = RING_BYTES, MISC_OFF = LDSCTL_OFF + 320, LDS_BYTES = 147456;
constexpr int NWAVES = 8;

#define GAS __attribute__((address_space(1)))
#define LAS __attribute__((address_space(3)))
typedef unsigned short bf16_t;
typedef unsigned v4u __attribute__((ext_vector_type(4)));
typedef unsigned v2u __attribute__((ext_vector_type(2)));
typedef float f32x4 __attribute__((ext_vector_type(4)));
typedef float f32x2 __attribute__((ext_vector_type(2)));
typedef float f32x16 __attribute__((ext_vector_type(16)));
typedef short bf16x8 __attribute__((ext_vector_type(8)));
typedef short s16x4 __attribute__((ext_vector_type(4)));
typedef GAS unsigned gu32;
typedef GAS unsigned long long gu64;
#define RLX_AGENT __ATOMIC_RELAXED, __HIP_MEMORY_SCOPE_AGENT
#define LDS_WAIT() asm volatile("s_waitcnt lgkmcnt(0)" ::: "memory")
#define VM_WAIT() asm volatile("s_waitcnt vmcnt(0)" ::: "memory")

__device__ __forceinline__ unsigned f2bf(float f) { unsigned u = __builtin_bit_cast(unsigned, f); return (u + 0x7fffu + ((u >> 16) & 1u)) >> 16; }
__device__ __forceinline__ unsigned pk2(float lo, float hi) { return f2bf(lo) | (f2bf(hi) << 16); }
__device__ __forceinline__ float bf2f(unsigned short h) { return __builtin_bit_cast(float, (unsigned)h << 16); }
__device__ __forceinline__ float bflo(unsigned w) { return __builtin_bit_cast(float, w << 16); }
__device__ __forceinline__ float bfhi(unsigned w) { return __builtin_bit_cast(float, w & 0xffff0000u); }
typedef __bf16 bf16x2_t __attribute__((ext_vector_type(2)));
__device__ __forceinline__ unsigned cvt_pk_bf16(float lo, float hi) { f32x2 v = {lo, hi}; bf16x2_t b = __builtin_convertvector(v, bf16x2_t); return __builtin_bit_cast(unsigned, b); }
__device__ __forceinline__ float sigm(float x) { return __builtin_amdgcn_rcpf(1.f + __expf(-x)); }
__device__ __forceinline__ float gelu_tanh(float x) { return x * sigm(1.5957691216057308f * (x + 0.044715f * x * x * x)); }
__device__ __forceinline__ float wave_sum(float v) {
#pragma unroll
    for (int o = 1; o < 64; o <<= 1) v += __shfl_xor(v, o);
    return v;
}
__device__ __forceinline__ float wave_max(float v) {
#pragma unroll
    for (int o = 1; o < 64; o <<= 1) v = fmaxf(v, __shfl_xor(v, o));
    return v;
}

namespace pg8 {
#define PG8_LAS __attribute__((address_space(3)))
constexpr int BM = 256, BK = 64, HALF = 128, HTB = HALF * BK * 2, STAGE_BYTES = 8 * HTB, NXCD = 8, WGM = 8;
__host__ __device__ __forceinline__ int lds_byte(int r, int c) { const int st = (r >> 4) * 2 + (c >> 5), rr = r & 15, cc = c & 31, ob = rr * 64 + cc * 2; return st * 1024 + (ob ^ (((ob >> 9) & 1) << 5)); }
__host__ __device__ __forceinline__ void stage_rc(int b, int& R, int& C) { const int st = b / 1024, sb = b % 1024, swz = sb ^ (((sb >> 9) & 1) << 5); R = (st >> 1) * 16 + swz / 64; C = (st & 1) * 32 + (swz % 64) / 2; }
__host__ __device__ __forceinline__ int perm32(int rho) { const int n = rho >> 4, i = rho & 15; return 8 * (i >> 2) + 4 * n + (i & 3); }
struct Unit { int pm, pn, k0, nt; };
struct Gemm { const bf16_t* A; const bf16_t* Bt; int M, N, K; };
struct StaticOrder {
    int nM, nN, nwg, G, c, ntf;
    __host__ __device__ void init(int M, int N, int K, int G_, int c_) { nM = M / BM; nN = N / BM; nwg = nM * nN; G = G_; c = c_; ntf = K / BK; }
    __host__ __device__ __forceinline__ bool next(int i, Unit& u) const { return at((long)i * G + c, u); }
    __host__ __device__ __forceinline__ bool at(long L, Unit& u) const {
        u.pm = 0; u.pn = 0; u.k0 = 0; u.nt = ntf;
        if (L >= nwg) return false;
        int wgid = (int)L; { const int q = nwg / NXCD, r = nwg % NXCD, xcd = wgid % NXCD, off = wgid / NXCD; wgid = (xcd < r ? xcd * (q + 1) : r * (q + 1) + (xcd - r) * q) + off; }
        const int nig = WGM * nN, gid = wgid / nig, fm = gid * WGM, gsz = (nM - fm) < WGM ? (nM - fm) : WGM;
        u.pm = fm + ((wgid % nig) % gsz); u.pn = (wgid % nig) / gsz; return true;
    }
    __device__ __forceinline__ void a_ready(const Unit&) const {}
    __device__ __forceinline__ void done(const Unit&) const {}
};
struct SampleGatedOrder : StaticOrder {
    const unsigned* ready; unsigned need;
    __device__ __forceinline__ void a_ready(const Unit& u) const {
        if (u.pm != 32) return;
        if (threadIdx.x < 64) { unsigned polls = 0;
            while ((unsigned)__builtin_amdgcn_readfirstlane(__hip_atomic_load(ready, __ATOMIC_RELAXED, __HIP_MEMORY_SCOPE_AGENT)) < need) { __builtin_amdgcn_s_sleep(2); if (++polls > (1u << 20)) break; }
            __builtin_amdgcn_fence(__ATOMIC_ACQUIRE, "agent");
            asm volatile("s_waitcnt vmcnt(0)" ::: "memory"); }
        asm volatile("" ::: "memory"); __builtin_amdgcn_s_barrier(); asm volatile("" ::: "memory");
    }
};
struct HybridOrder {
    StaticOrder base; int snt, npn, nsl; const unsigned* ready = nullptr; unsigned need = 0;
    bool slices_first = false;
    __host__ __device__ void init(int N, int K, int G_, int c_, int snt_) { base.init(8192, N, K, G_, c_); snt = snt_; npn = N / BM; nsl = (K / BK) / snt_; }
    __host__ __device__ __forceinline__ bool next(int i, Unit& u) const {
        const long L = (long)i * base.G + base.c;
        if (slices_first) { const long ns = (long)npn * nsl;
            if (L >= ns) return base.at(L - ns, u);
            u.pm = 32; u.pn = (int)(L % npn); u.k0 = (int)(L / npn) * snt; u.nt = snt; return true; }
        if (L < base.nwg) return base.at(L, u);
        const int sidx = (int)(L - base.nwg);
        u.pm = 32; u.pn = sidx % npn; u.k0 = (sidx / npn) * snt; u.nt = snt; return sidx < npn * nsl;
    }
    __device__ __forceinline__ void a_ready(const Unit& u) const {
        if (u.pm != 32 || ready == nullptr) return;
        if (threadIdx.x < 64) { unsigned polls = 0;
            while ((unsigned)__builtin_amdgcn_readfirstlane(__hip_atomic_load(ready, __ATOMIC_RELAXED, __HIP_MEMORY_SCOPE_AGENT)) < need) { __builtin_amdgcn_s_sleep(2); if (++polls > (1u << 20)) break; }
            __builtin_amdgcn_fence(__ATOMIC_ACQUIRE, "agent");
            asm volatile("s_waitcnt vmcnt(0)" ::: "memory"); }
        asm volatile("" ::: "memory"); __builtin_amdgcn_s_barrier(); asm volatile("" ::: "memory");
    }
    __device__ __forceinline__ void done(const Unit&) const {}
};
template <class Epi, class Sched, bool ALIGN_EPI = false, bool SP2 = false>
__device__ __forceinline__ void gemm_phase(PG8_LAS unsigned char* lds, const Gemm g, const Sched& S, const Epi& E) {
    const int tid = threadIdx.x, wid = __builtin_amdgcn_readfirstlane(tid >> 6), lane = tid & 63, wr = wid >> 2, wc = wid & 3, fr = lane & 15, fq = lane >> 4;
    const int K = g.K, nt = K / BK;
    unsigned voffA[2], voffB[2];
#pragma unroll
    for (int i = 0; i < 2; ++i) { int R, C; stage_rc(tid * 16 + i * 8192, R, C); const int Rb = Epi::PERM ? ((R & ~31) + perm32(R & 31)) : R;
        voffA[i] = (unsigned)(R * K + C) * 2u; voffB[i] = (unsigned)(Rb * K + C) * 2u; }
    const size_t kstep = (size_t)(BK * 2);
    const size_t hstep = (size_t)HALF * K * 2;
    const size_t tstep = 2 * hstep;
    const unsigned ldsw = (unsigned)wid * 1024u;
    const int aoff = lds_byte(wr * 64 + fr, fq * 8), boff = lds_byte(wc * 32 + fr, fq * 8);
#define PG8_SA(b, h) (((b) * 2 + (h)) * HTB)
#define PG8_SB(b, h) ((4 + (b) * 2 + (h)) * HTB)
#define PG8_STAGE(bufoff, gbase, voff) do { _Pragma("unroll") for (int _i = 0; _i < 2; ++_i) \
        __builtin_amdgcn_global_load_lds((const unsigned*)((const char*)(gbase) + (voff)[_i]), (PG8_LAS unsigned*)(lds + (bufoff) + ldsw + _i * 8192), 16, 0, 0); } while (0)
#define PG8_LDA(dst, b, h) do { _Pragma("unroll") for (int m = 0; m < 4; ++m) _Pragma("unroll") for (int k = 0; k < 2; ++k) dst[m][k] = *(const PG8_LAS bf16x8*)(lds + PG8_SA(b, h) + aoff + m * 2048 + k * 1024); } while (0)
#define PG8_LDB(dst, b, h) do { _Pragma("unroll") for (int n = 0; n < 2; ++n) _Pragma("unroll") for (int k = 0; k < 2; ++k) dst[n][k] = *(const PG8_LAS bf16x8*)(lds + PG8_SB(b, h) + boff + n * 2048 + k * 1024); } while (0)
#define PG8_MMA(ai, bj, At, Bt) do { __builtin_amdgcn_s_setprio(1); _Pragma("unroll") for (int m = 0; m < 4; ++m) _Pragma("unroll") for (int n = 0; n < 2; ++n) _Pragma("unroll") for (int k = 0; k < 2; ++k) \
        acc[ai][bj][m][n] = __builtin_amdgcn_mfma_f32_16x16x32_bf16(Bt[n][k], At[m][k], acc[ai][bj][m][n], 0, 0, 0); __builtin_amdgcn_s_setprio(0); } while (0)
#define PG8_WAIT_V(n) asm volatile("s_waitcnt vmcnt(" #n ")" ::: "memory")
#define PG8_WAIT_L(n) asm volatile("s_waitcnt lgkmcnt(" #n ")" ::: "memory")
#define PG8_BAR __builtin_amdgcn_s_barrier()
#define PG8_SCHED __builtin_amdgcn_sched_barrier(0)
    Unit cur, nxt; int ui = 0;
    if (!S.next(0, cur)) return;
    f32x4 acc[2][2][4][2];
#pragma unroll
    for (int a = 0; a < 2; ++a)
#pragma unroll
        for (int b = 0; b < 2; ++b)
#pragma unroll
            for (int m = 0; m < 4; ++m)
#pragma unroll
                for (int n = 0; n < 2; ++n) acc[a][b][m][n] = (f32x4){0.f, 0.f, 0.f, 0.f};
    bf16x8 At[4][2], B0[2][2], B1[2][2];
    const char* cA = (const char*)g.A + (size_t)cur.pm * tstep + (size_t)cur.k0 * kstep; const char* cB = (const char*)g.Bt + (size_t)cur.pn * tstep + (size_t)cur.k0 * kstep;
    S.a_ready(cur);
    if constexpr (SP2) {
        PG8_STAGE(PG8_SB(0, 0), cB, voffB); PG8_STAGE(PG8_SB(0, 1), cB + hstep, voffB); PG8_STAGE(PG8_SA(0, 0), cA, voffA); PG8_STAGE(PG8_SA(0, 1), cA + hstep, voffA);
        if (wr == 1) PG8_BAR;
        PG8_WAIT_V(2); PG8_BAR;
        PG8_STAGE(PG8_SB(1, 0), cB + kstep, voffB); PG8_STAGE(PG8_SA(1, 0), cA + kstep, voffA); PG8_STAGE(PG8_SB(1, 1), cB + hstep + kstep, voffB);
        PG8_WAIT_V(6); PG8_BAR;
    } else {
        PG8_STAGE(PG8_SB(0, 0), cB, voffB); PG8_STAGE(PG8_SA(0, 0), cA, voffA); PG8_STAGE(PG8_SB(0, 1), cB + hstep, voffB); PG8_STAGE(PG8_SA(0, 1), cA + hstep, voffA);
        if (wr == 1) PG8_BAR;
        PG8_WAIT_V(4); PG8_BAR;
        PG8_STAGE(PG8_SB(1, 0), cB + kstep, voffB); PG8_STAGE(PG8_SA(1, 0), cA + kstep, voffA); PG8_STAGE(PG8_SB(1, 1), cB + hstep + kstep, voffB);
        PG8_WAIT_V(6); PG8_BAR;
    }
    for (;;) {
        const bool has_next = S.next(ui + 1, nxt);
        const char* nA = has_next ? (const char*)g.A + (size_t)nxt.pm * tstep + (size_t)nxt.k0 * kstep : cA; const char* nB = has_next ? (const char*)g.Bt + (size_t)nxt.pn * tstep + (size_t)nxt.k0 * kstep : cB;
        const int cnt = cur.nt;
        for (int t = 0; t < cnt; t += 2) {
            if constexpr (Epi::MIDK) { if (cnt == nt && t == (nt >> 1)) E.mid(acc, cur, wr, wc, fr, fq); }
            const bool last = (t == cnt - 2);
            const char* a1 = cA + (size_t)(t + 1) * kstep;
            const char* a2 = last ? nA : cA + (size_t)(t + 2) * kstep; const char* b2 = last ? nB : cB + (size_t)(t + 2) * kstep;
            const char* a3 = a2 + kstep; const char* b3 = b2 + kstep;
            if (last && has_next) S.a_ready(nxt);
            if constexpr (SP2) {
            PG8_LDB(B0, 0, 0); PG8_LDB(B1, 0, 1); PG8_SCHED; PG8_LDA(At, 0, 0); PG8_STAGE(PG8_SA(1, 1), a1 + hstep, voffA);
            PG8_WAIT_V(8); PG8_WAIT_L(0); PG8_BAR; PG8_MMA(0, 0, At, B0); PG8_MMA(0, 1, At, B1); PG8_BAR; PG8_SCHED;
            PG8_LDA(At, 0, 1); PG8_STAGE(PG8_SB(0, 0), b2, voffB); PG8_STAGE(PG8_SB(0, 1), b2 + hstep, voffB); PG8_STAGE(PG8_SA(0, 0), a2, voffA);
            PG8_WAIT_V(8); PG8_WAIT_L(0); PG8_BAR; PG8_MMA(1, 0, At, B0); PG8_MMA(1, 1, At, B1); PG8_BAR; PG8_SCHED;
            PG8_LDB(B0, 1, 0); PG8_LDB(B1, 1, 1); PG8_SCHED; PG8_LDA(At, 1, 0); PG8_STAGE(PG8_SA(0, 1), a2 + hstep, voffA);
            PG8_WAIT_V(8); PG8_WAIT_L(0); PG8_BAR; PG8_MMA(0, 0, At, B0); PG8_MMA(0, 1, At, B1); PG8_BAR; PG8_SCHED;
            PG8_LDA(At, 1, 1); PG8_STAGE(PG8_SB(1, 0), b3, voffB); PG8_STAGE(PG8_SB(1, 1), b3 + hstep, voffB); PG8_STAGE(PG8_SA(1, 0), a3, voffA);
            PG8_WAIT_V(8); PG8_WAIT_L(0); PG8_BAR; PG8_MMA(1, 0, At, B0); PG8_MMA(1, 1, At, B1); PG8_BAR; PG8_SCHED;
            } else {
            PG8_LDB(B0, 0, 0); PG8_SCHED; PG8_LDA(At, 0, 0); PG8_STAGE(PG8_SA(1, 1), a1 + hstep, voffA);
            PG8_WAIT_L(8); PG8_BAR; PG8_WAIT_L(0); PG8_MMA(0, 0, At, B0); PG8_BAR; PG8_SCHED;
            PG8_LDB(B1, 0, 1); PG8_STAGE(PG8_SB(0, 0), b2, voffB);
            PG8_BAR; PG8_WAIT_L(0); PG8_MMA(0, 1, At, B1); PG8_BAR;
            PG8_LDA(At, 0, 1); PG8_STAGE(PG8_SA(0, 0), a2, voffA);
            PG8_BAR; PG8_WAIT_L(0); PG8_MMA(1, 0, At, B0); PG8_BAR; PG8_SCHED;
            PG8_STAGE(PG8_SB(0, 1), b2 + hstep, voffB);
            PG8_WAIT_V(6); PG8_BAR; PG8_MMA(1, 1, At, B1); PG8_BAR;
            PG8_LDB(B0, 1, 0); PG8_SCHED; PG8_LDA(At, 1, 0); PG8_STAGE(PG8_SA(0, 1), a2 + hstep, voffA);
            PG8_WAIT_L(8); PG8_BAR; PG8_WAIT_L(0); PG8_MMA(0, 0, At, B0); PG8_BAR; PG8_SCHED;
            PG8_LDB(B1, 1, 1); PG8_STAGE(PG8_SB(1, 0), b3, voffB);
            PG8_BAR; PG8_WAIT_L(0); PG8_MMA(0, 1, At, B1); PG8_BAR;
            PG8_LDA(At, 1, 1); PG8_STAGE(PG8_SA(1, 0), a3, voffA);
            PG8_BAR; PG8_WAIT_L(0); PG8_MMA(1, 0, At, B0); PG8_BAR; PG8_SCHED;
            PG8_STAGE(PG8_SB(1, 1), b3 + hstep, voffB);
            PG8_WAIT_V(6); PG8_BAR; PG8_MMA(1, 1, At, B1); PG8_BAR;
            }
        }
        if constexpr (ALIGN_EPI) { if (wr == 0) PG8_BAR; }
        if constexpr (Epi::AFTER_DRAIN) { if (has_next) E(acc, cur, wr, wc, fr, fq); } else { E(acc, cur, wr, wc, fr, fq); }
        S.done(cur);
        if (!has_next) break;
#pragma unroll
        for (int a = 0; a < 2; ++a)
#pragma unroll
            for (int b = 0; b < 2; ++b)
#pragma unroll
                for (int m = 0; m < 4; ++m)
#pragma unroll
                    for (int n = 0; n < 2; ++n) acc[a][b][m][n] = (f32x4){0.f, 0.f, 0.f, 0.f};
        cur = nxt; cA = nA; cB = nB; ++ui;
        if constexpr (ALIGN_EPI) { if (wr == 1) PG8_BAR; }
    }
    PG8_WAIT_V(0);
    if constexpr (!ALIGN_EPI) { if (wr == 0) PG8_BAR; }
    PG8_BAR;
    if constexpr (Epi::AFTER_DRAIN) E.fused(acc, cur, wr, wc, fr, fq, lds);
#undef PG8_SA
#undef PG8_SB
#undef PG8_STAGE
#undef PG8_LDA
#undef PG8_LDB
#undef PG8_MMA
#undef PG8_WAIT_V
#undef PG8_WAIT_L
#undef PG8_BAR
#undef PG8_SCHED
}
}

#ifndef PROBE_PHASE
#define PROBE_PHASE -1
#endif
__device__ __forceinline__ void probe_mark(int id, unsigned char* ws) {
    if (PROBE_PHASE >= 100 && blockIdx.x == 0 && threadIdx.x == 0) { const int a = (PROBE_PHASE - 100) / 10, b = (PROBE_PHASE - 100) % 10;
        unsigned* w = (unsigned*)ws; const unsigned now = (unsigned)__builtin_amdgcn_s_memrealtime();
        if (id == a) w[3] = now; if (id == b) w[2] = now - w[3]; }
}
__device__ __forceinline__ v4u pack8bf(f32x4 a, f32x4 b) { v4u w; w.x = cvt_pk_bf16(a[0], a[1]); w.y = cvt_pk_bf16(a[2], a[3]); w.z = cvt_pk_bf16(b[0], b[1]); w.w = cvt_pk_bf16(b[2], b[3]); return w; }
__device__ __forceinline__ void unpack8bf(v4u w, f32x4& a, f32x4& b) { a = (f32x4){bflo(w.x), bfhi(w.x), bflo(w.y), bfhi(w.y)}; b = (f32x4){bflo(w.z), bfhi(w.z), bflo(w.w), bfhi(w.w)}; }

struct EpiIn {
    static constexpr bool PERM = true, MIDK = false, AFTER_DRAIN = false;
    bf16_t* base;
    float* out;
    __device__ __forceinline__ void mid(f32x4 (&)[2][2][4][2], const pg8::Unit&, int, int, int, int) const {}
    template <int MODE>
    __device__ __forceinline__ void store_bf(const f32x4 (&acc)[2][2][4][2], const pg8::Unit& u, int wr, int wc, int fr, int fq, bf16_t* dst) const {
        const int colr = (u.pn & 7) * 256 + wc * 32 + 8 * fq;
#pragma unroll
        for (int ai = 0; ai < 2; ++ai)
#pragma unroll
            for (int m = 0; m < 4; ++m) {
                const size_t row = (size_t)u.pm * 256 + ai * 128 + wr * 64 + m * 16 + fr;
#pragma unroll
                for (int bj = 0; bj < 2; ++bj) {
                    f32x4 v0 = acc[ai][bj][m][0], v1 = acc[ai][bj][m][1];
                    if (MODE == 1) {
#pragma unroll
                        for (int e = 0; e < 4; ++e) { v0[e] = gelu_tanh(v0[e]); v1[e] = gelu_tanh(v1[e]); }
                    } else if (MODE == 2) {
#pragma unroll
                        for (int e = 0; e < 4; ++e) { v0[e] = sigm(v0[e]); v1[e] = sigm(v1[e]); }
                    }
                    *(v4u*)(dst + row * DM + colr + bj * 128) = pack8bf(v0, v1);
                }
                asm volatile("" ::: "memory");
            }
    }
    __device__ __forceinline__ void store_f32(const f32x4 (&acc)[2][2][4][2], const pg8::Unit& u, int wr, int wc, int fr, int fq, float* orow0, int rl0, int rl1) const {
        const int colr = (u.pn & 7) * 256 + wc * 32 + 8 * fq;
#pragma unroll
        for (int ai = 0; ai < 2; ++ai)
#pragma unroll
            for (int m = 0; m < 4; ++m) {
                const int rl = ai * 128 + wr * 64 + m * 16 + fr;
                if (rl >= rl0 && rl < rl1) {
                    float* o = orow0 + (size_t)(rl - rl0) * DM + colr;
#pragma unroll
                    for (int bj = 0; bj < 2; ++bj) { *(f32x4*)(o + bj * 128) = acc[ai][bj][m][0]; *(f32x4*)(o + bj * 128 + 4) = acc[ai][bj][m][1]; }
                }
                asm volatile("" ::: "memory");
            }
    }
    __device__ __forceinline__ void store_f32_sconv(const f32x4 (&acc)[2][2][4][2], const pg8::Unit& u, int wr, int wc, int fr, int fq) const {
        const int colr = (u.pn & 7) * 256 + wc * 32 + 8 * fq;
        if (fr >= 13) {
#pragma unroll
            for (int m = 0; m < 4; ++m) {
                const int rl = wr * 64 + m * 16 + fr;
                float* o = out + O_SC + ((size_t)((rl >> 4) * 3 + fr - 13)) * DM + colr;
#pragma unroll
                for (int bj = 0; bj < 2; ++bj) { *(f32x4*)(o + bj * 128) = acc[0][bj][m][0]; *(f32x4*)(o + bj * 128 + 4) = acc[0][bj][m][1]; }
                asm volatile("" ::: "memory");
            }
        }
    }
    __device__ __forceinline__ void operator()(const f32x4 (&acc)[2][2][4][2], const pg8::Unit& u, int wr, int wc, int fr, int fq) const {
        const int region = u.pn >> 3, pm = u.pm;
        bf16_t* dst = base + (size_t)region * (33 * MiB / 2);
        const bool sample = (pm == 32);
        if (region == 4) store_bf<1>(acc, u, wr, wc, fr, fq, dst);
        else if (region >= 5) store_bf<2>(acc, u, wr, wc, fr, fq, dst);
        else store_bf<0>(acc, u, wr, wc, fr, fq, dst);
        if (region == 1 || region == 2) {
            if (sample) store_f32(acc, u, wr, wc, fr, fq, out + (region == 1 ? O_SK : O_SV), 0, 128);
            else if ((pm & 15) >= 14) store_f32(acc, u, wr, wc, fr, fq, out + (region == 1 ? O_PK : O_PV) + ((size_t)((pm >> 4) * 512 + ((pm & 15) - 14) * 256)) * DM, 0, 256);
        } else if (region == 3) {
            if (sample) store_f32_sconv(acc, u, wr, wc, fr, fq);
            else if ((pm & 15) == 15) store_f32(acc, u, wr, wc, fr, fq, out + O_PC + (size_t)((pm >> 4) * 3) * DM, 253, 256);
        }
    }
};
template <bool GATED>
__device__ __forceinline__ void slice_store(const f32x4 (&acc)[2][2][4][2], const pg8::Unit& u, int wr, int wc, int fr, int fq, float* slabs, const bf16_t* gate) {
    int opq = 0; asm volatile("" : "+v"(opq));
    const int col0 = u.pn * 256 + wc * 32 + 8 * fq;
    float* slab = slabs + (size_t)(u.k0 / u.nt) * (128 * DM);
#pragma unroll
    for (int m = 0; m < 4; ++m) {
        const int rl = wr * 64 + m * 16 + fr + opq;
#pragma unroll
        for (int bj = 0; bj < 2; ++bj) {
            const int c = col0 + bj * 128;
            f32x4 v0 = acc[0][bj][m][0], v1 = acc[0][bj][m][1];
            if (GATED) { f32x4 g0, g1; unpack8bf(*(const v4u*)(gate + (size_t)(MP + rl) * DM + c), g0, g1); v0 = v0 * g0; v1 = v1 * g1; }
            float* p = slab + (size_t)rl * DM + c;
            *(f32x4*)p = v0; *(f32x4*)(p + 4) = v1;
        }
        if (m & 1) asm volatile("" ::: "memory");
    }
}
struct EpiProj {
    static constexpr bool PERM = true, MIDK = true, AFTER_DRAIN = false;
    const bf16_t* SA; const bf16_t* SR; bf16_t* O; float* sacc; unsigned char* pws;
    __device__ __forceinline__ void mid(f32x4 (&acc)[2][2][4][2], const pg8::Unit& u, int wr, int wc, int fr, int fq) const {
        probe_mark(6, pws);
        int opq = 0; asm volatile("" : "+v"(opq));
        const int col0 = u.pn * 256 + wc * 32 + 8 * fq;
        const int rowb = u.pm * 256 + wr * 64 + fr + opq;
#pragma unroll
        for (int ai = 0; ai < 2; ++ai)
#pragma unroll
            for (int m = 0; m < 4; ++m) {
                const size_t row = (size_t)(rowb + ai * 128 + m * 16);
#pragma unroll
                for (int bj = 0; bj < 2; ++bj) {
                    const size_t off = row * DM + col0 + bj * 128;
                    f32x4 a0, a1, r0, r1; unpack8bf(*(const v4u*)(SA + off), a0, a1); unpack8bf(*(const v4u*)(SR + off), r0, r1);
#pragma unroll
                    for (int e = 0; e < 4; ++e) { acc[ai][bj][m][0][e] *= a0[e] * __builtin_amdgcn_rcpf(r0[e]); acc[ai][bj][m][1][e] *= a1[e] * __builtin_amdgcn_rcpf(r1[e]); }
                }
                if (m & 1) asm volatile("" : "+v"(acc[ai][0][m][0]), "+v"(acc[ai][0][m][1]), "+v"(acc[ai][1][m][0]), "+v"(acc[ai][1][m][1]) :: "memory");
            }
        probe_mark(7, pws);
    }
    __device__ __forceinline__ void operator()(const f32x4 (&acc)[2][2][4][2], const pg8::Unit& u, int wr, int wc, int fr, int fq) const {
        probe_mark(8, pws);
        if (u.pm == 32) { slice_store<true>(acc, u, wr, wc, fr, fq, sacc, u.k0 < 32 ? SA : SR); return; }
        const int col0 = u.pn * 256 + wc * 32 + 8 * fq;
#pragma unroll
        for (int ai = 0; ai < 2; ++ai)
#pragma unroll
            for (int m = 0; m < 4; ++m) {
                const size_t row = (size_t)u.pm * 256 + ai * 128 + wr * 64 + m * 16 + fr;
#pragma unroll
                for (int bj = 0; bj < 2; ++bj) {
                    const size_t off = row * DM + col0 + bj * 128;
                    f32x4 r0, r1; unpack8bf(*(const v4u*)(SR + off), r0, r1);
                    *(v4u*)(O + off) = pack8bf(acc[ai][bj][m][0] * r0, acc[ai][bj][m][1] * r1);
                }
                if (m & 1) asm volatile("" ::: "memory");
            }
    }
};
constexpr int XL_OFF = LDSCTL_OFF + 1024;
__device__ __forceinline__ void panel_rinv(const f32x4 (&v)[2][2][4][2], const pg8::Unit& u, int wr, int wc, int fr, int fq, LAS unsigned char* xl, unsigned long long* xw) {
    const int lane = threadIdx.x & 63, wid = wr * 4 + wc;
    LAS float* P = (LAS float*)xl;
    LAS float* S = P + 1024;
#pragma unroll
    for (int ai = 0; ai < 2; ++ai)
#pragma unroll
        for (int m = 0; m < 4; ++m) { float q = 0.f;
#pragma unroll
            for (int bj = 0; bj < 2; ++bj)
#pragma unroll
                for (int n = 0; n < 2; ++n) { const f32x4 x = v[ai][bj][m][n]; q += (x[0] * x[0] + x[1] * x[1]) + (x[2] * x[2] + x[3] * x[3]); }
            q += __shfl_xor(q, 16); q += __shfl_xor(q, 32);
            if (fq == 0) P[(ai * 128 + wr * 64 + m * 16 + fr) * 4 + wc] = q; }
    asm volatile("s_waitcnt lgkmcnt(0)" ::: "memory"); __builtin_amdgcn_s_barrier(); asm volatile("" ::: "memory");
    int opq = 0; asm volatile("" : "+v"(opq));
    if (lane < 32) { const int row = wid * 32 + lane + opq; const f32x4 a = *(const LAS f32x4*)(P + row * 4);
        const float q = (a[0] + a[1]) + (a[2] + a[3]);
        unsigned long long* w = xw + (size_t)u.pm * 256 + row;
        const unsigned long long inc = (1ull << 56) + (unsigned long long)(q * 1048576.f);
        unsigned long long cur = __hip_atomic_fetch_add(w, inc, __ATOMIC_RELAXED, __HIP_MEMORY_SCOPE_AGENT) + inc;
        unsigned spins = 0;
        while ((cur >> 56) < 8ull) { __builtin_amdgcn_s_sleep(1); cur = __hip_atomic_load(w, __ATOMIC_RELAXED, __HIP_MEMORY_SCOPE_AGENT); if (++spins > (1u << 18)) break; }
        S[row] = rsqrtf((float)(cur & ((1ull << 56) - 1)) * (1.f / (1048576.f * DM)) + EPS); }
    asm volatile("s_waitcnt vmcnt(0) lgkmcnt(0)" ::: "memory"); __builtin_amdgcn_s_barrier(); asm volatile("" ::: "memory");
}
__device__ __forceinline__ void residual_dma(f32x4 (&acc)[2][2][4][2], const float* res, size_t row_base  , int col0, const float* gate, int wr, int wc, int fr, int fq, LAS unsigned char* lds) {
    const int wid = __builtin_amdgcn_readfirstlane(wr * 4 + wc), lane = threadIdx.x & 63;
    LAS unsigned char* wreg = lds + wid * 16384;
    f32x4 gg[2][2];
#pragma unroll
    for (int bj = 0; bj < 2; ++bj) { gg[bj][0] = *(const f32x4*)(gate + col0 + bj * 128); gg[bj][1] = *(const f32x4*)(gate + col0 + bj * 128 + 4); }
#pragma unroll
    for (int ai = 0; ai < 2; ++ai) {
        const float* rb = res + (row_base + ai * 128 + wr * 64 + fr) * DM + col0;
#pragma unroll
        for (int m = 0; m < 4; ++m)
#pragma unroll
            for (int bj = 0; bj < 2; ++bj)
#pragma unroll
                for (int hf = 0; hf < 2; ++hf)
                    __builtin_amdgcn_global_load_lds((const unsigned*)(rb + (size_t)(16 * m) * DM + bj * 128 + 4 * hf), (LAS unsigned*)(wreg + ((m * 2 + bj) * 2 + hf) * 1024), 16, 0, 0);
        asm volatile("s_waitcnt vmcnt(0)" ::: "memory");
#pragma unroll
        for (int m = 0; m < 4; ++m)
#pragma unroll
            for (int bj = 0; bj < 2; ++bj) {
                const f32x4 x0 = *(const LAS f32x4*)(wreg + ((m * 2 + bj) * 2 + 0) * 1024 + lane * 16), x1 = *(const LAS f32x4*)(wreg + ((m * 2 + bj) * 2 + 1) * 1024 + lane * 16);
                acc[ai][bj][m][0] = x0 + gg[bj][0] * acc[ai][bj][m][0]; acc[ai][bj][m][1] = x1 + gg[bj][1] * acc[ai][bj][m][1];
                asm volatile("" : "+v"(acc[ai][bj][m][0]), "+v"(acc[ai][bj][m][1]) :: "memory"); }
        asm volatile("s_waitcnt lgkmcnt(0)" ::: "memory");
    }
}
struct EpiResNorm {
    static constexpr bool PERM = true, MIDK = false, AFTER_DRAIN = true;
    const float* xin; float* x1o; bf16_t* h2o; const float* mod; float* slabs; LAS unsigned char* xl; unsigned long long* xw; unsigned char* pws;
    __device__ __forceinline__ void mid(f32x4 (&)[2][2][4][2], const pg8::Unit&, int, int, int, int) const {}
    __device__ __forceinline__ void finish(f32x4 (&acc)[2][2][4][2], const pg8::Unit& u, int wr, int wc, int fr, int fq) const {
        const int col0 = u.pn * 256 + wc * 32 + 8 * fq;
        const float* md = mod + (size_t)(u.pm >> 4) * NMOD;
        panel_rinv(acc, u, wr, wc, fr, fq, xl, xw);
        probe_mark(4, pws);
        const LAS float* S = (const LAS float*)xl + 1024;
        int opq = 0; asm volatile("" : "+v"(opq));
        const int rl0 = wr * 64 + fr + opq;
#pragma unroll
        for (int bj = 0; bj < 2; ++bj)
#pragma unroll
            for (int n = 0; n < 2; ++n) {
                const int c = col0 + bj * 128 + 4 * n;
                const f32x4 s0 = *(const f32x4*)(md + 4 * DM + c) + 1.f, h0 = *(const f32x4*)(md + 3 * DM + c);
#pragma unroll
                for (int ai = 0; ai < 2; ++ai)
#pragma unroll
                    for (int m = 0; m < 4; ++m) {
                        const int rl = rl0 + ai * 128 + m * 16; const float rv = S[rl];
                        const size_t ro = (size_t)(u.pm * 256 + rl) * DM + c;
                        *(f32x4*)(x1o + ro) = acc[ai][bj][m][n];
                        const f32x4 y = acc[ai][bj][m][n] * rv * s0 + h0; v2u w; w.x = cvt_pk_bf16(y[0], y[1]); w.y = cvt_pk_bf16(y[2], y[3]);
                        *(v2u*)(h2o + ro) = w;
                    }
                asm volatile("" ::: "memory");
            }
    }
    __device__ __forceinline__ void operator()(f32x4 (&acc)[2][2][4][2], const pg8::Unit& u, int wr, int wc, int fr, int fq) const {
        if (u.pm == 32) { slice_store<false>(acc, u, wr, wc, fr, fq, slabs, nullptr); return; }
        const int col0 = u.pn * 256 + wc * 32 + 8 * fq;
        const float* md = mod + (size_t)(u.pm >> 4) * NMOD;
#pragma unroll
        for (int ai = 0; ai < 2; ++ai)
#pragma unroll
            for (int m = 0; m < 4; ++m) {
                const size_t ro = (size_t)(u.pm * 256 + ai * 128 + wr * 64 + m * 16 + fr) * DM;
#pragma unroll
                for (int bj = 0; bj < 2; ++bj) {
                    const int c = col0 + bj * 128;
                    const f32x4 g0 = *(const f32x4*)(md + 2 * DM + c), g1 = *(const f32x4*)(md + 2 * DM + c + 4);
                    const f32x4 x0 = *(const f32x4*)(xin + ro + c), x1 = *(const f32x4*)(xin + ro + c + 4);
                    acc[ai][bj][m][0] = x0 + g0 * acc[ai][bj][m][0]; acc[ai][bj][m][1] = x1 + g1 * acc[ai][bj][m][1];
                }
                asm volatile("" : "+v"(acc[ai][0][m][0]), "+v"(acc[ai][0][m][1]), "+v"(acc[ai][1][m][0]), "+v"(acc[ai][1][m][1]) :: "memory");
            }
        finish(acc, u, wr, wc, fr, fq);
    }
    __device__ __forceinline__ void fused(f32x4 (&acc)[2][2][4][2], const pg8::Unit& u, int wr, int wc, int fr, int fq, LAS unsigned char* lds) const {
        if (u.pm == 32) { slice_store<false>(acc, u, wr, wc, fr, fq, slabs, nullptr); return; }
        probe_mark(2, pws);
        residual_dma(acc, xin, (size_t)u.pm * 256, u.pn * 256 + wc * 32 + 8 * fq, mod + (size_t)(u.pm >> 4) * NMOD + 2 * DM, wr, wc, fr, fq, lds);
        probe_mark(3, pws);
        finish(acc, u, wr, wc, fr, fq);
        probe_mark(5, pws);
    }
};
struct EpiResFinal {
    static constexpr bool PERM = true, MIDK = false, AFTER_DRAIN = true;
    const float* x1i; float* yo; const float* mod; const float* fng; float* slabs; LAS unsigned char* xl; unsigned long long* xw;
    __device__ __forceinline__ void mid(f32x4 (&)[2][2][4][2], const pg8::Unit&, int, int, int, int) const {}
    __device__ __forceinline__ void finish(f32x4 (&acc)[2][2][4][2], const pg8::Unit& u, int wr, int wc, int fr, int fq) const {
        const int col0 = u.pn * 256 + wc * 32 + 8 * fq;
        panel_rinv(acc, u, wr, wc, fr, fq, xl, xw);
        const LAS float* S = (const LAS float*)xl + 1024;
        int opq = 0; asm volatile("" : "+v"(opq));
        const int rl0 = wr * 64 + fr + opq;
#pragma unroll
        for (int bj = 0; bj < 2; ++bj) {
            const int c = col0 + bj * 128;
            const f32x4 f0 = *(const f32x4*)(fng + c), f1 = *(const f32x4*)(fng + c + 4);
#pragma unroll
            for (int ai = 0; ai < 2; ++ai)
#pragma unroll
                for (int m = 0; m < 4; ++m) {
                    const int rl = rl0 + ai * 128 + m * 16; const float rv = S[rl];
                    float* o = yo + (size_t)(u.pm * 256 + rl) * DM + c;
                    *(f32x4*)o = acc[ai][bj][m][0] * rv * f0; *(f32x4*)(o + 4) = acc[ai][bj][m][1] * rv * f1;
                }
            asm volatile("" ::: "memory");
        }
    }
    __device__ __forceinline__ void operator()(f32x4 (&acc)[2][2][4][2], const pg8::Unit& u, int wr, int wc, int fr, int fq) const {
        if (u.pm == 32) { slice_store<false>(acc, u, wr, wc, fr, fq, slabs, nullptr); return; }
        const int col0 = u.pn * 256 + wc * 32 + 8 * fq;
        const float* gp = mod + (size_t)(u.pm >> 4) * NMOD + 5 * DM;
#pragma unroll
        for (int ai = 0; ai < 2; ++ai)
#pragma unroll
            for (int m = 0; m < 4; ++m) {
                const size_t ro = (size_t)(u.pm * 256 + ai * 128 + wr * 64 + m * 16 + fr) * DM;
#pragma unroll
                for (int bj = 0; bj < 2; ++bj) {
                    const int c = col0 + bj * 128;
                    const f32x4 g0 = *(const f32x4*)(gp + c), g1 = *(const f32x4*)(gp + c + 4);
                    const f32x4 x0 = *(const f32x4*)(x1i + ro + c), x1 = *(const f32x4*)(x1i + ro + c + 4);
                    acc[ai][bj][m][0] = x0 + g0 * acc[ai][bj][m][0]; acc[ai][bj][m][1] = x1 + g1 * acc[ai][bj][m][1];
                }
                asm volatile("" : "+v"(acc[ai][0][m][0]), "+v"(acc[ai][0][m][1]), "+v"(acc[ai][1][m][0]), "+v"(acc[ai][1][m][1]) :: "memory");
            }
        finish(acc, u, wr, wc, fr, fq);
    }
    __device__ __forceinline__ void fused(f32x4 (&acc)[2][2][4][2], const pg8::Unit& u, int wr, int wc, int fr, int fq, LAS unsigned char* lds) const {
        if (u.pm == 32) { slice_store<false>(acc, u, wr, wc, fr, fq, slabs, nullptr); return; }
        residual_dma(acc, x1i, (size_t)u.pm * 256, u.pn * 256 + wc * 32 + 8 * fq, mod + (size_t)(u.pm >> 4) * NMOD + 5 * DM, wr, wc, fr, fq, lds);
        finish(acc, u, wr, wc, fr, fq);
    }
};
struct EpiGU {
    static constexpr bool PERM = true, MIDK = false, AFTER_DRAIN = false;
    bf16_t* O;
    __device__ __forceinline__ void mid(f32x4 (&)[2][2][4][2], const pg8::Unit&, int, int, int, int) const {}
    __device__ __forceinline__ void operator()(const f32x4 (&acc)[2][2][4][2], const pg8::Unit& u, int wr, int wc, int fr, int fq) const {
        const int col0 = u.pn * 128 + wc * 32 + 8 * fq;
#pragma unroll
        for (int ai = 0; ai < 2; ++ai)
#pragma unroll
            for (int m = 0; m < 4; ++m) {
                const size_t row = (size_t)u.pm * 256 + ai * 128 + wr * 64 + m * 16 + fr;
                f32x4 o0, o1;
#pragma unroll
                for (int e = 0; e < 4; ++e) { const float g0 = acc[ai][0][m][0][e], g1 = acc[ai][0][m][1][e];
                    o0[e] = g0 * sigm(g0) * acc[ai][1][m][0][e]; o1[e] = g1 * sigm(g1) * acc[ai][1][m][1][e]; }
                *(v4u*)(O + row * DFF + col0) = pack8bf(o0, o1);
            }
    }
};

namespace att {
constexpr int NW = 8, QBLK = 32, KVBLK = 64, QB = NW * QBLK, D = 128, LDQ = 2048, LDO = 4096;
constexpr int SHM_V = KVBLK * D * 2, SHM_K = KVBLK * D * 2;
constexpr int LDS_BYTES = 2 * SHM_V + 2 * SHM_K + NW * 64 * 4;
constexpr int BIAS_OFF = LDS_BYTES;
constexpr float THR = 8.f;
constexpr float LOG2E = 1.4426950408889634f;
#define KSWZ(row, colB) ((row) * 256 + ((colB) ^ (((row) & 7) << 4)))
#define SBAR() __builtin_amdgcn_sched_barrier(0)
__device__ __forceinline__ int v_st(int k, int c) { const int kk = (k & ~0xC) | ((k & 4) << 1) | ((k & 8) >> 1); return ((kk >> 3) * 4 + (c >> 5)) * 512 + ((kk & 7) * 32 + (c & 31)) * 2; }
__device__ __forceinline__ int v_rd_base(int lane) { return ((lane & 3) << 3) | (((lane >> 2) & 3) << 6) | (((lane >> 4) & 1) << 5) | (((lane >> 5) & 1) << 8); }
constexpr int v_rd_off(int d0, int ks, int half) { return d0 * 512 + ks * 4096 + half * 2048; }
__device__ __forceinline__ int crow(int r, int hi) { return (r & 3) + 8 * (r >> 2) + 4 * hi; }
__device__ __forceinline__ unsigned cvtpk(float lo, float hi) { return cvt_pk_bf16(lo, hi); }
__device__ __forceinline__ bf16x8 load8(const bf16_t* p) { return *reinterpret_cast<const bf16x8*>(p); }
__device__ __forceinline__ int jlo(int qb) { const int j = 4 * qb - 8; return j > 0 ? j : 0; }
__device__ __forceinline__ void bias_tile(f32x16& p0, f32x16& p1, int dq, int dlo, const float* bl) {
    if (dlo - 63 >= 256) { const float bf = bl[319];
#pragma unroll
        for (int r = 0; r < 16; ++r) { p0[r] = fmaf(p0[r], ATT_SCALE, bf); p1[r] = fmaf(p1[r], ATT_SCALE, bf); }
    } else {
#pragma unroll
        for (int r = 0; r < 16; ++r) { const int c = (r & 3) + 8 * (r >> 2);
            int d0 = dq - c; d0 = d0 > 256 ? 256 : d0; int d1 = dq - c - 32; d1 = d1 > 256 ? 256 : d1;
            p0[r] = fmaf(p0[r], ATT_SCALE, bl[d0 + 63]); p1[r] = fmaf(p1[r], ATT_SCALE, bl[d1 + 63]); }
    }
}
__device__ __forceinline__ void partialSM(f32x16& p0, f32x16& p1, float& m_reg, float& mn, float& alpha) {
    float pmax = p0[0];
#pragma unroll
    for (int r = 1; r < 16; ++r) pmax = fmaxf(pmax, p0[r]);
#pragma unroll
    for (int r = 0; r < 16; ++r) pmax = fmaxf(pmax, p1[r]);
    { auto rr = __builtin_amdgcn_permlane32_swap(__float_as_uint(pmax), __float_as_uint(pmax), false, false);
      pmax = fmaxf(__uint_as_float(rr[0]), __uint_as_float(rr[1])); }
    if (__builtin_expect(__all((pmax - m_reg) <= THR), 1)) { mn = m_reg; alpha = 1.f; }
    else { mn = fmaxf(m_reg, pmax); alpha = __builtin_amdgcn_exp2f((m_reg - mn) * LOG2E); m_reg = mn; }
    const float mnL = -mn * LOG2E;
#pragma unroll
    for (int r = 0; r < 16; ++r) p0[r] = fmaf(p0[r], LOG2E, mnL);
#pragma unroll
    for (int r = 0; r < 16; ++r) p1[r] = fmaf(p1[r], LOG2E, mnL);
#pragma unroll
    for (int r = 0; r < 16; ++r) p0[r] = __builtin_amdgcn_exp2f(p0[r]);
}
__device__ __forceinline__ void finishSM(f32x16& p0, f32x16& p1, float alpha, float& l_reg, bf16x8& pa0, bf16x8& pa1, bf16x8& pa2, bf16x8& pa3) {
#pragma unroll
    for (int r = 0; r < 16; ++r) p1[r] = __builtin_amdgcn_exp2f(p1[r]);
    float ps = 0;
#pragma unroll
    for (int r = 0; r < 16; ++r) ps += p0[r];
#pragma unroll
    for (int r = 0; r < 16; ++r) ps += p1[r];
    { auto rr = __builtin_amdgcn_permlane32_swap(__float_as_uint(ps), __float_as_uint(ps), false, false);
      ps = __uint_as_float(rr[0]) + __uint_as_float(rr[1]); }
    l_reg = l_reg * alpha + ps;
#define PK4(P, B_, OUT) do { unsigned a0 = cvtpk(P[B_+0], P[B_+1]), a1 = cvtpk(P[B_+2], P[B_+3]);                          \
        unsigned b0 = cvtpk(P[B_+4], P[B_+5]), b1 = cvtpk(P[B_+6], P[B_+7]);                                             \
        auto r0 = __builtin_amdgcn_permlane32_swap(a0, b0, false, false); auto r1 = __builtin_amdgcn_permlane32_swap(a1, b1, false, false); \
        v4u w = {r0[0], r1[0], r0[1], r1[1]}; OUT = *reinterpret_cast<bf16x8*>(&w); } while (0)
    PK4(p0, 0, pa0); PK4(p0, 8, pa1); PK4(p1, 0, pa2); PK4(p1, 8, pa3);
#undef PK4
}
template <int KB>
__device__ __forceinline__ void qkt(f32x16& p0, f32x16& p1, const char* K_lds, int r32, int hi, const bf16x8* qr, bool act) {
    if (!act) { const float NEG = -__builtin_inff();
#pragma unroll
        for (int r = 0; r < 16; ++r) { p0[r] = NEG; p1[r] = NEG; } return; }
    p0 = f32x16{}; p1 = f32x16{};
    const char* kb[4];
#pragma unroll
    for (int dd = 0; dd < 4; ++dd) kb[dd] = K_lds + KB * SHM_K + KSWZ(r32, (dd * 16 + hi * 8) * 2);
#pragma unroll
    for (int d0 = 0; d0 < 8; ++d0) { const char* a = kb[d0 & 3] + (d0 >> 2) * 128;
        bf16x8 b0 = *reinterpret_cast<const bf16x8*>(a);
        bf16x8 b1 = *reinterpret_cast<const bf16x8*>(a + 32 * 256);
        p0 = __builtin_amdgcn_mfma_f32_32x32x16_bf16(b0, qr[d0], p0, 0, 0, 0);
        p1 = __builtin_amdgcn_mfma_f32_32x32x16_bf16(b1, qr[d0], p1, 0, 0, 0); }
}
template <int VB>
__device__ __forceinline__ void pv_tile(f32x16* o, int vb0, bf16x8 pa0, bf16x8 pa1, bf16x8 pa2, bf16x8 pa3, bool act) {
    if (!act) return;
#define TRRD(dst, off) asm volatile("ds_read_b64_tr_b16 %0, %1 offset:%2" : "=&v"(dst) : "v"(vb0), "i"(off) : "memory")
#define PV_D0(d0) do { s16x4 l0, l1, l2, l3, h0, h1, h2, h3; constexpr int b_ = VB * SHM_V + v_rd_off(d0, 0, 0); \
        TRRD(l0, b_); TRRD(h0, b_ + 2048); TRRD(l1, b_ + 4096); TRRD(h1, b_ + 6144); TRRD(l2, b_ + 8192); TRRD(h2, b_ + 10240); TRRD(l3, b_ + 12288); TRRD(h3, b_ + 14336); \
        asm volatile("s_waitcnt lgkmcnt(0)" ::: "memory"); SBAR();   \
        o[d0] = __builtin_amdgcn_mfma_f32_32x32x16_bf16(pa0, (bf16x8){l0[0], l0[1], l0[2], l0[3], h0[0], h0[1], h0[2], h0[3]}, o[d0], 0, 0, 0);   \
        o[d0] = __builtin_amdgcn_mfma_f32_32x32x16_bf16(pa1, (bf16x8){l1[0], l1[1], l1[2], l1[3], h1[0], h1[1], h1[2], h1[3]}, o[d0], 0, 0, 0);   \
        o[d0] = __builtin_amdgcn_mfma_f32_32x32x16_bf16(pa2, (bf16x8){l2[0], l2[1], l2[2], l2[3], h2[0], h2[1], h2[2], h2[3]}, o[d0], 0, 0, 0);   \
        o[d0] = __builtin_amdgcn_mfma_f32_32x32x16_bf16(pa3, (bf16x8){l3[0], l3[1], l3[2], l3[3], h3[0], h3[1], h3[2], h3[3]}, o[d0], 0, 0, 0); } while (0)
    PV_D0(0); PV_D0(1); PV_D0(2); PV_D0(3);
#undef PV_D0
#undef TRRD
}
struct BlockRef { const bf16_t* Q; const bf16_t* K; const bf16_t* V; bf16_t* O; int qb; int h; };
struct Seam { bf16x8 qr[8]; bf16x8 st_v0, st_v1, st_k0, st_k1; };
#define ROW(p, k0, rr) ((p) + (size_t)((k0) + (rr)) * LDQ + sc)
#define VMW() asm volatile("s_waitcnt vmcnt(0)" ::: "memory")
#define VMWN(n) asm volatile("s_waitcnt vmcnt(%0)" :: "i"(n) : "memory")
#define SLOAD_H(Kp, Vp, k0) do { S.st_v0 = load8(ROW(Vp, k0, sr)); S.st_v1 = load8(ROW(Vp, k0, 32 + sr));              \
                         S.st_k0 = load8(ROW(Kp, k0, sr)); S.st_k1 = load8(ROW(Kp, k0, 32 + sr)); } while (0)
#define SWRITE_HK(bf) do { *(bf16x8*)(K_lds + (bf) * SHM_K + kws) = S.st_k0; *(bf16x8*)(K_lds + (bf) * SHM_K + kws + 32 * 256) = S.st_k1; } while (0)
#define SWRITE_HV(bf) do { *(bf16x8*)(V_lds + (bf) * SHM_V + vst0) = S.st_v0; *(bf16x8*)(V_lds + (bf) * SHM_V + vst1) = S.st_v1; } while (0)
#define SWRITE_H(bf) do { SWRITE_HV(bf); SWRITE_HK(bf); } while (0)
__device__ __forceinline__ void att_prime(const BlockRef& cur, char* lds, Seam& S) {
    const int tid = threadIdx.x, wid = __builtin_amdgcn_readfirstlane(tid >> 6), lane = tid & 63, r32 = lane & 31, hi = lane >> 5;
    const int sr = tid >> 4, sc = (tid & 15) * 8, kws = KSWZ(sr, sc * 2); char* K_lds = lds + 2 * SHM_V;
    const int kb0 = jlo(cur.qb) * KVBLK;
#pragma unroll
    for (int d0 = 0; d0 < 8; ++d0) S.qr[d0] = load8(cur.Q + (size_t)(wid * QBLK + r32) * LDQ + d0 * 16 + hi * 8);
    SLOAD_H(cur.K, cur.V, kb0); VMW(); SWRITE_HK(0);
    __syncthreads();
}
__device__ __forceinline__ void att_block(const BlockRef& cur, const BlockRef& nxt, char* lds, Seam& S) {
    const int tid = threadIdx.x, wid = __builtin_amdgcn_readfirstlane(tid >> 6), lane = tid & 63, r32 = lane & 31, hi = lane >> 5;
    const int j_lo = jlo(cur.qb), j_hi = 4 * cur.qb + 4;
    const int NT = j_hi - j_lo;
    const int kbn = jlo(nxt.qb) * KVBLK;
    const int cq = 4 * cur.qb + (wid >> 1);
    const int qlo = cur.qb * QB + wid * QBLK, qpos = qlo + r32;
    const float* bl = (const float*)(lds + BIAS_OFF) + cur.h * 320;
    char* V_lds = lds; char* K_lds = lds + 2 * SHM_V;
    float* ws = (float*)(lds + 2 * SHM_V + 2 * SHM_K) + wid * 64; float* li_l = ws, * al_l = ws + 32;
    float m_reg = -1e30f, l_reg = 0; f32x16 o[4] = {};
    const int sr = tid >> 4, sc = (tid & 15) * 8, vst0 = v_st(sr, sc), vst1 = v_st(32 + sr, sc), kws = KSWZ(sr, sc * 2);
    const int vb0 = (int)(uintptr_t)V_lds + v_rd_base(lane);
    const bf16_t* Kh = cur.K; const bf16_t* Vh = cur.V;
#define RESC(a) do { if (__any((a) < 1.f)) { if (hi == 0) al_l[r32] = (a); asm volatile("s_waitcnt lgkmcnt(0)" ::: "memory");              \
                     for (int d_ = 0; d_ < 4; ++d_) for (int r = 0; r < 16; ++r) o[d_][r] *= al_l[crow(r, hi)]; } } while (0)
#define KBASE(t) ((j_lo + (t)) * KVBLK)
#define ACT(t) ((j_lo + (t)) <= cq && (j_lo + (t)) + 8 >= cq)
#define BIAST(P0_, P1_, t) do { if (ACT(t)) bias_tile(P0_, P1_, qpos - KBASE(t) - 4 * hi, qlo - KBASE(t), bl); } while (0)
    constexpr int NQL = 8;
#define SEAM_K0() do { VMWN(NQL); SWRITE_HK(0); SBAR(); } while (0)
    f32x16 pA0, pA1, pB0, pB1; float mnA, mnB, alA, alB; bf16x8 pa0, pa1, pa2, pa3;
    SWRITE_HV(0); SBAR();
    if (NT > 1) { SLOAD_H(Kh, Vh, KBASE(1)); }
    SBAR(); qkt<0>(pA0, pA1, K_lds, r32, hi, S.qr, ACT(0));
    BIAST(pA0, pA1, 0); partialSM(pA0, pA1, m_reg, mnA, alA);
    if (NT > 1) { VMW(); SWRITE_H(1); }
    __syncthreads();
#define HALF_STEP(PX0, PX1, mnX, alX, PY0, PY1, alY, t, KB, VB, SB) do {                                                      \
        SBAR(); qkt<KB>(PX0, PX1, K_lds, r32, hi, S.qr, ACT(t));                                             \
        finishSM(PY0, PY1, alY, l_reg, pa0, pa1, pa2, pa3); SBAR();                                                           \
        if ((t) + 1 < NT) { SLOAD_H(Kh, Vh, KBASE((t) + 1)); SBAR(); }                                               \
        pv_tile<VB>(o, vb0, pa0, pa1, pa2, pa3, ACT((t) - 1)); BIAST(PX0, PX1, (t)); partialSM(PX0, PX1, m_reg, mnX, alX);                                        \
        __syncthreads();                                                                                                      \
        if ((t) + 1 < NT) { VMW(); SWRITE_H(SB); }                                                                          \
        RESC(alX); __syncthreads(); } while (0)
    for (int t = 1; t + 1 < NT; t += 2) {
        HALF_STEP(pB0, pB1, mnB, alB, pA0, pA1, alA, t, 1, 0, 0);
        HALF_STEP(pA0, pA1, mnA, alA, pB0, pB1, alB, t + 1, 0, 1, 1);
    }
    const bool even = (NT & 1) == 0;
    if (even) { SBAR(); qkt<1>(pB0, pB1, K_lds, r32, hi, S.qr, ACT(NT - 1)); SBAR(); }
    SLOAD_H(nxt.K, nxt.V, kbn); SBAR();
#pragma unroll
    for (int d0 = 0; d0 < 8; ++d0) S.qr[d0] = load8(nxt.Q + (size_t)(wid * QBLK + r32) * LDQ + d0 * 16 + hi * 8);
    SBAR();
    finishSM(pA0, pA1, alA, l_reg, pa0, pa1, pa2, pa3); SBAR();
    pv_tile<0>(o, vb0, pa0, pa1, pa2, pa3, ACT(even ? NT - 2 : NT - 1));
    if (even) { BIAST(pB0, pB1, NT - 1); partialSM(pB0, pB1, m_reg, mnB, alB); __syncthreads(); RESC(alB);
        finishSM(pB0, pB1, alB, l_reg, pa0, pa1, pa2, pa3); SBAR(); pv_tile<1>(o, vb0, pa0, pa1, pa2, pa3, ACT(NT - 1)); }
    SBAR(); SEAM_K0();
    if (hi == 0) li_l[r32] = l_reg; asm volatile("s_waitcnt lgkmcnt(0)" ::: "memory");
    float rli[16];
#pragma unroll
    for (int r = 0; r < 16; ++r) rli[r] = __builtin_amdgcn_rcpf(li_l[crow(r, hi)]);
    bf16_t* Ow = cur.O + (size_t)(wid * QBLK) * LDO;
#pragma unroll
    for (int r = 0; r < 16; ++r) { const int orow = crow(r, hi);
#pragma unroll
        for (int d0 = 0; d0 < 4; ++d0) { const float v = o[d0][r] * rli[r];
            const float vn = __shfl_xor(v, 1);
            if ((r32 & 1) == 0) *(unsigned*)(Ow + (size_t)orow * LDO + d0 * 32 + r32) = cvtpk(v, vn); } }
    __syncthreads();
#undef RESC
#undef KBASE
#undef ACT
#undef BIAST
#undef SEAM_K0
#undef HALF_STEP
}
#undef ROW
#undef VMW
#undef VMWN
#undef SLOAD_H
#undef SWRITE_HK
#undef SWRITE_HV
#undef SWRITE_H
#undef SBAR
#undef KSWZ
}

#define XB_TMO      128
#define XB_XCNT(j)  (256  + 64 * (j))
#define XB_XSUB(j)  (1280 + 64 * (j))
#define XB_XGEN(j)  (2304 + 64 * (j))
#define XB_TOP      3328
#define XB_TOPGEN   3392
#define XCD_BAR_WORDS 3456
#define XB_SPIN_CAP (1u << 18)
__device__ __forceinline__ unsigned xb_ld(unsigned* p)              { return __hip_atomic_load(p, __ATOMIC_RELAXED, __HIP_MEMORY_SCOPE_AGENT); }
__device__ __forceinline__ unsigned xb_add(unsigned* p, unsigned v) { return __hip_atomic_fetch_add(p, v, __ATOMIC_RELAXED, __HIP_MEMORY_SCOPE_AGENT); }
__device__ __forceinline__ unsigned xb_xcc_id() { return (unsigned)__builtin_amdgcn_s_getreg((3 << 11) | 20) & 0xFu; }
#define XB_SPIN(cond, bar) do { unsigned _sp = 0; while (cond) { __builtin_amdgcn_s_sleep(1); \
    if ((++_sp & 255u) == 0u) { if (xb_ld(&(bar)[XB_TMO])) break; if (_sp > XB_SPIN_CAP) { atomicAdd(&(bar)[XB_TMO], 1u); break; } } } } while (0)
struct XcdBarrier { unsigned* bar; unsigned x; volatile LAS unsigned* st; };
__device__ __forceinline__ XcdBarrier xcd_barrier_post(unsigned* bar, volatile LAS unsigned* st) {
    XcdBarrier b; b.bar = bar; b.x = xb_xcc_id(); b.st = st;
    if (threadIdx.x == 0) (void)xb_add(&bar[XB_XCNT(b.x)], 1u);
    return b;
}
__device__ __forceinline__ void xcd_barrier_complete(unsigned* bar, unsigned x, unsigned& nloc, unsigned& nx) {
    const unsigned G = gridDim.x * gridDim.y * gridDim.z;
    unsigned sum, cnt, mine, sp = 0u;
    for (;;) {
        sum = 0u; cnt = 0u; mine = 0u;
#pragma unroll
        for (unsigned j = 0; j < 16; ++j) { const unsigned c = xb_ld(&bar[XB_XCNT(j)]); sum += c; cnt += (c > 0u) ? 1u : 0u; mine = (j == x) ? c : mine; }
        if (sum == G) break;
        __builtin_amdgcn_s_sleep(1);
        if ((++sp & 255u) == 0u) { if (xb_ld(&bar[XB_TMO])) break; if (sp > XB_SPIN_CAP) { atomicAdd(&bar[XB_TMO], 1u); break; } }
    }
    nloc = mine > 0u ? mine : 1u; nx = cnt > 0u ? cnt : 1u;
}
__device__ __forceinline__ void xcd_barrier(const XcdBarrier& b) {
    asm volatile("s_waitcnt vmcnt(0)" ::: "memory");
    __syncthreads();
    if (threadIdx.x == 0) {
        unsigned* bar = b.bar;
        __builtin_amdgcn_s_waitcnt(0);
        unsigned nloc = b.st[0], nx = b.st[1];
        if (nloc == 0u) { xcd_barrier_complete(bar, b.x, nloc, nx); b.st[0] = nloc; b.st[1] = nx; }
        const unsigned old = xb_add(&bar[XB_XSUB(b.x)], 1u);
        const unsigned gen = old / nloc;
        if (old + 1u == (gen + 1u) * nloc) {
            __builtin_amdgcn_fence(__ATOMIC_RELEASE, "agent");
            asm volatile("s_waitcnt vmcnt(0)" ::: "memory");
            const unsigned og = xb_add(&bar[XB_TOP], 1u);
            const unsigned tg = og / nx;
            if (og + 1u == (tg + 1u) * nx) xb_add(&bar[XB_TOPGEN], 1u);
            else XB_SPIN(xb_ld(&bar[XB_TOPGEN]) == tg, bar);
            __builtin_amdgcn_fence(__ATOMIC_ACQUIRE, "agent");
            xb_add(&bar[XB_XGEN(b.x)], 1u);
            asm volatile("s_waitcnt vmcnt(0)" ::: "memory");
        } else {
            XB_SPIN(xb_ld(&bar[XB_XGEN(b.x)]) == gen, bar);
            __builtin_amdgcn_fence(__ATOMIC_ACQUIRE, "agent");
            asm volatile("s_waitcnt vmcnt(0)" ::: "memory");
        }
    }
    __syncthreads();
}

struct Args { const float* in[26]; float* out; unsigned char* ws; int ph_lo, ph_hi; };
__device__ __forceinline__ const float* arg_ptr(int k) { int o = k * 8; asm volatile("" : "+s"(o)); return *(const float* const*)((const char*)__builtin_amdgcn_kernarg_segment_ptr() + o); }
struct Frame {
    LAS unsigned char* lds;
    int tid, lane, wave, vcu, G;
    float* out; unsigned char* ws;
    __device__ __forceinline__ const float* x_prompt() const { return arg_ptr(0); }
    __device__ __forceinline__ const float* x_sample() const { return arg_ptr(1); }
    __device__ __forceinline__ const float* c_prompt() const { return arg_ptr(2); }
    __device__ __forceinline__ const float* c_sample() const { return arg_ptr(3); }
    __device__ __forceinline__ const float* cache_k() const { return arg_ptr(4); }
    __device__ __forceinline__ const float* cache_v() const { return arg_ptr(5); }
    __device__ __forceinline__ const float* st_h() const { return arg_ptr(6); }
    __device__ __forceinline__ const float* st_conv() const { return arg_ptr(7); }
    __device__ __forceinline__ const float* w_mod() const { return arg_ptr(8); }
    __device__ __forceinline__ const float* b_mod() const { return arg_ptr(9); }
    __device__ __forceinline__ const float* w_in() const { return arg_ptr(10); }
    __device__ __forceinline__ const float* rel_bias() const { return arg_ptr(11); }
    __device__ __forceinline__ const float* conv_w() const { return arg_ptr(12); }
    __device__ __forceinline__ const float* conv_b() const { return arg_ptr(13); }
    __device__ __forceinline__ const float* w_rg_a() const { return arg_ptr(14); }
    __device__ __forceinline__ const float* b_rg_a() const { return arg_ptr(15); }
    __device__ __forceinline__ const float* w_rg_x() const { return arg_ptr(16); }
    __device__ __forceinline__ const float* b_rg_x() const { return arg_ptr(17); }
    __device__ __forceinline__ const float* rg_lambda() const { return arg_ptr(18); }
    __device__ __forceinline__ const float* w_pa() const { return arg_ptr(19); }
    __device__ __forceinline__ const float* w_pr() const { return arg_ptr(20); }
    __device__ __forceinline__ const float* w_out() const { return arg_ptr(21); }
    __device__ __forceinline__ const float* w_gate() const { return arg_ptr(22); }
    __device__ __forceinline__ const float* w_up() const { return arg_ptr(23); }
    __device__ __forceinline__ const float* w_down() const { return arg_ptr(24); }
    __device__ __forceinline__ const float* fng() const { return arg_ptr(25); }
    __device__ __forceinline__ float* mod() const { return (float*)(ws + WS_MOD); }
    __device__ __forceinline__ float* x1() const { return (float*)(ws + WS_OY); }
    __device__ __forceinline__ float* slab4() const { return (float*)(ws + WS_SLAB4); }
    __device__ __forceinline__ float* slab6() const { return (float*)(ws + WS_SLAB6); }
    __device__ __forceinline__ float* slab9() const { return (float*)(ws + WS_SLAB9); }
    __device__ __forceinline__ bf16_t* Win_t() const { return (bf16_t*)(ws + WS_WIN); }
    __device__ __forceinline__ bf16_t* Wproj_t() const { return (bf16_t*)(ws + WS_WPROJ); }
    __device__ __forceinline__ bf16_t* Wout_t() const { return (bf16_t*)(ws + WS_WOUT); }
    __device__ __forceinline__ bf16_t* Wgu_t() const { return (bf16_t*)(ws + WS_WGU); }
    __device__ __forceinline__ bf16_t* Wdn_t() const { return (bf16_t*)(ws + WS_WDN); }
    __device__ __forceinline__ bf16_t* Wrg_t() const { return (bf16_t*)(ws + WS_WRG); }
    __device__ __forceinline__ bf16_t* H1() const { return (bf16_t*)(ws + WS_H1); }
    __device__ __forceinline__ bf16_t* Qb() const { return (bf16_t*)(ws + WS_Q); }
    __device__ __forceinline__ bf16_t* Kb() const { return (bf16_t*)(ws + WS_K); }
    __device__ __forceinline__ bf16_t* Vb() const { return (bf16_t*)(ws + WS_V); }
    __device__ __forceinline__ bf16_t* Ub() const { return (bf16_t*)(ws + WS_U); }
    __device__ __forceinline__ bf16_t* Gb() const { return (bf16_t*)(ws + WS_G); }
    __device__ __forceinline__ bf16_t* SAb() const { return (bf16_t*)(ws + WS_SA); }
    __device__ __forceinline__ bf16_t* SRb() const { return (bf16_t*)(ws + WS_SR); }
    __device__ __forceinline__ bf16_t* OY() const { return (bf16_t*)(ws + WS_OY); }
    __device__ __forceinline__ bf16_t* MG() const { return (bf16_t*)(ws + WS_MERGED); }
    __device__ __forceinline__ bf16_t* ACT() const { return (bf16_t*)(ws + WS_ACT); }
    __device__ __forceinline__ gu64* gran() const { return (gu64*)(ws + WS_GRAN); }
    __device__ __forceinline__ void refresh() { int t = threadIdx.x; asm volatile("" : "+v"(t)); tid = t; lane = t & 63; wave = __builtin_amdgcn_readfirstlane(t >> 6); }
};

__device__ __forceinline__ void xpose_item(const float* W, int N, bf16_t* WT, size_t ldo, int k0, int n0, int drow0, int dcol0, LAS float* scr, int lane) {
#pragma unroll 8
    for (int i = 0; i < 32; ++i) { const int kk = 2 * i + (lane >> 5); scr[kk * 33 + (lane & 31)] = W[(size_t)(k0 + kk) * N + n0 + (lane & 31)]; }
    LDS_WAIT(); asm volatile("" ::: "memory");
    const int c = lane & 7;
#pragma unroll
    for (int j = 0; j < 4; ++j) { const int n = (lane >> 3) + 8 * j; const LAS float* s = scr + (8 * c) * 33 + n;
        v4u o; o.x = pk2(s[0 * 33], s[1 * 33]); o.y = pk2(s[2 * 33], s[3 * 33]); o.z = pk2(s[4 * 33], s[5 * 33]); o.w = pk2(s[6 * 33], s[7 * 33]);
        *(GAS v4u*)(WT + (size_t)(drow0 + n) * ldo + dcol0 + 8 * c) = o; }
    LDS_WAIT(); asm volatile("" ::: "memory");
}
__device__ __forceinline__ void norm_regs_bf16(const f32x4 (&v)[8], const float* shift, const float* scale, bf16_t* orow, int lane) {
    f32x4 sc[8], sh[8];
#pragma unroll
    for (int j = 0; j < 8; ++j) { sc[j] = *((const GAS f32x4*)scale + lane + 64 * j); sh[j] = *((const GAS f32x4*)shift + lane + 64 * j); }
    float s = 0.f;
#pragma unroll
    for (int j = 0; j < 8; ++j) s += (v[j].x * v[j].x + v[j].y * v[j].y) + (v[j].z * v[j].z + v[j].w * v[j].w);
    const float rinv = rsqrtf(wave_sum(s) * (1.f / DM) + EPS);
    GAS v2u* o8 = (GAS v2u*)orow + lane;
#pragma unroll
    for (int j = 0; j < 8; ++j) { const f32x4 y = v[j] * rinv * (sc[j] + 1.f) + sh[j]; v2u w; w.x = pk2(y.x, y.y); w.y = pk2(y.z, y.w); o8[64 * j] = w; }
}
__device__ __forceinline__ void load_row(f32x4 (&v)[8], const float* row, int lane) {
    const GAS f32x4* xr = (const GAS f32x4*)row + lane;
#pragma unroll
    for (int j = 0; j < 8; ++j) v[j] = xr[64 * j];
}
__device__ __forceinline__ void phase0(Frame& F, bool dry = false) {
    const float* p_cp = F.c_prompt(); const float* p_cs = F.c_sample(); const float* p_wm = F.w_mod(); const float* p_bm = F.b_mod(); float* p_mod = F.mod(); const float* p_win = F.w_in(); bf16_t* p_wint = F.Win_t();
    { gu64* g = F.gran(); for (size_t i = (size_t)F.vcu * 512 + F.tid; i < 3 * 131072; i += (size_t)F.G * 512) g[i] = 0ull; }
    LAS float* sc = (LAS float*)(F.lds);
    LAS float* red = (LAS float*)(F.lds + 8192);
    for (int it = F.vcu; it < 768; it += F.G) {
        const int nc = it % 48, ks = it / 48;
        for (int i = F.tid; i < 1280; i += 512) { const int b = i >> 7, k = ks * 128 + (i & 127);
            const float cv = b < 2 ? p_cp[b * DM + k] : p_cs[(b - 2) * DM + k];
            sc[i] = cv * sigm(cv); }
        __syncthreads();
        f32x4 acc[10];
#pragma unroll
        for (int b = 0; b < 10; ++b) acc[b] = (f32x4){0.f, 0.f, 0.f, 0.f};
        const float* wp = p_wm + (size_t)(ks * 128 + F.wave * 16) * NMOD + nc * 256 + 4 * F.lane;
#pragma unroll 4
        for (int kk = 0; kk < 16; ++kk) { const f32x4 w = *(const GAS f32x4*)(wp + (size_t)kk * NMOD);
#pragma unroll
            for (int b = 0; b < 10; ++b) { const float s = sc[b * 128 + F.wave * 16 + kk]; acc[b] += w * s; } }
#pragma unroll
        for (int b = 0; b < 10; ++b) *(LAS f32x4*)(red + (F.wave * 10 + b) * 256 + 4 * F.lane) = acc[b];
        __syncthreads();
        for (int o = F.tid; o < 2560; o += 512) { const int b = o >> 8, col = o & 255; float s = 0.f;
#pragma unroll
            for (int w = 0; w < 8; ++w) s += red[(w * 10 + b) * 256 + col];
            if (ks == 0) s += p_bm[nc * 256 + col];
            if (!dry) atomicAdd(p_mod + (size_t)b * NMOD + nc * 256 + col, s); }
        __syncthreads();
    }
    LAS float* scr = (LAS float*)(F.lds + F.wave * 16384);
    const int gw = F.vcu * NWAVES + F.wave, NGW = F.G * NWAVES;
    for (int it = gw; it < 32 * 448; it += NGW) { const int kb = it / 448, nb = it % 448;
        xpose_item(p_win, NIN, p_wint, DM, kb * 64, nb * 32, nb * 32, kb * 64, scr, F.lane); }
}
constexpr int I_P = 32 * 64, I_G = 32 * 176, I_D = 88 * 64, I_R = 256;
constexpr int NITEMS_A = 3 * I_P + I_R, NITEMS_B = 2 * I_G + I_D;
__device__ __forceinline__ void conv_item_a(Frame& F, int r, LAS float* scr) {
    if (r < I_P) { const int kb = r / 64, nb = r % 64; xpose_item(F.w_pa(), DM, F.Wproj_t(), 4096, kb * 64, nb * 32, nb * 32, kb * 64, scr, F.lane); return; } r -= I_P;
    if (r < I_P) { const int kb = r / 64, nb = r % 64; xpose_item(F.w_pr(), DM, F.Wproj_t(), 4096, kb * 64, nb * 32, nb * 32, 2048 + kb * 64, scr, F.lane); return; } r -= I_P;
    if (r < I_P) { const int kb = r / 64, nb = r % 64; xpose_item(F.w_out(), DM, F.Wout_t(), DM, kb * 64, nb * 32, nb * 32, kb * 64, scr, F.lane); return; } r -= I_P;
    { const int mat = r >> 3, sub = r & 7, kb = sub >> 2, nb = sub & 3;
      const float* src = (mat < 16 ? F.w_rg_a() : F.w_rg_x()) + (size_t)(mat & 15) * 16384;
      xpose_item(src, 128, F.Wrg_t() + (size_t)mat * 16384, 128, kb * 64, nb * 32, nb * 32, kb * 64, scr, F.lane); }
}
__device__ __forceinline__ void conv_item_b(Frame& F, int r, LAS float* scr) {
    if (r < I_G) { const int kb = r / 176, nb = r % 176, n0 = nb * 32; xpose_item(F.w_gate(), DFF, F.Wgu_t(), DM, kb * 64, n0, (n0 >> 7) * 256 + (n0 & 127), kb * 64, scr, F.lane); return; } r -= I_G;
    if (r < I_G) { const int kb = r / 176, nb = r % 176, n0 = nb * 32; xpose_item(F.w_up(), DFF, F.Wgu_t(), DM, kb * 64, n0, (n0 >> 7) * 256 + 128 + (n0 & 127), kb * 64, scr, F.lane); return; } r -= I_G;
    { const int kb = r / 64, nb = r % 64; xpose_item(F.w_down(), DM, F.Wdn_t(), DFF, kb * 64, nb * 32, nb * 32, kb * 64, scr, F.lane); }
}
__device__ __forceinline__ void phase1(Frame& F) {
    const float* p_xp = F.x_prompt(); const float* p_xs = F.x_sample(); const float* p_mod = F.mod(); bf16_t* p_H1 = F.H1(); const float* p_sl6 = F.slab6(); const float* p_sl9 = F.slab9(); float* p_x1 = F.x1(); const float* p_fng = F.fng();
    LAS float* scr = (LAS float*)(F.lds + F.wave * 16384);
    const int gw = F.vcu * NWAVES + F.wave, NGW = F.G * NWAVES;
    for (int it = gw; it < NITEMS_A; it += NGW) conv_item_a(F, it, scr);
    for (int m = gw; m < MPAD; m += NGW) {
        bf16_t* orow = p_H1 + (size_t)m * DM;
        if (m >= MV) { GAS v2u* o8 = (GAS v2u*)orow + F.lane;
#pragma unroll
            for (int j = 0; j < 8; ++j) o8[64 * j] = (v2u){0u, 0u};
            continue; }
        const float* xrow = m < MP ? p_xp + (size_t)m * DM : p_xs + (size_t)(m - MP) * DM;
        const int seq = m < MP ? (m >> 12) : 2 + ((m - MP) >> 4);
        const float* md = p_mod + (size_t)seq * NMOD;
        f32x4 v[8]; load_row(v, xrow, F.lane);
        norm_regs_bf16(v, md, md + DM, orow, F.lane);
    }
}
__device__ __forceinline__ void phase_norm2s(Frame& F, int gw, int NGW, unsigned* ready) {
    const float* p_xs = F.x_sample(); const float* p_mod = F.mod(); bf16_t* p_H1 = F.H1(); const float* p_sl6 = F.slab6(); float* p_x1 = F.x1();
    for (int r = gw; r < MS; r += NGW) { const int m = MP + r;
        const float* md = p_mod + (size_t)(2 + (r >> 4)) * NMOD;
        f32x4 v[8], a[8]; load_row(v, p_xs + (size_t)r * DM, F.lane); load_row(a, p_sl6 + (size_t)r * DM, F.lane);
#pragma unroll 5
        for (int k = 1; k < NSL6; ++k) { f32x4 t[8]; load_row(t, p_sl6 + (size_t)(k * 128 + r) * DM, F.lane);
#pragma unroll
            for (int j = 0; j < 8; ++j) a[j] += t[j]; }
        GAS f32x4* xo = (GAS f32x4*)(p_x1 + (size_t)m * DM) + F.lane;
#pragma unroll
        for (int j = 0; j < 8; ++j) { const f32x4 g = *((const GAS f32x4*)(md + 2 * DM) + F.lane + 64 * j); v[j] = v[j] + g * a[j]; xo[64 * j] = v[j]; }
        norm_regs_bf16(v, md + 3 * DM, md + 4 * DM, p_H1 + (size_t)m * DM, F.lane);
        asm volatile("s_waitcnt vmcnt(0)" ::: "memory");
        __builtin_amdgcn_fence(__ATOMIC_RELEASE, "agent");
        asm volatile("s_waitcnt vmcnt(0)" ::: "memory");
        if (F.lane == 0) __hip_atomic_fetch_add(ready, 1u, __ATOMIC_RELAXED, __HIP_MEMORY_SCOPE_AGENT);
    }
}
__device__ __forceinline__ void phase_finals(Frame& F) {
    const float* p_mod = F.mod(); const float* p_sl9 = F.slab9(); const float* p_x1 = F.x1(); const float* p_fng = F.fng();
    LAS float* part = (LAS float*)F.lds;
    LAS float* red = part + 8 * DM;
    for (int r = F.vcu; r < MS; r += F.G) { const int m = MP + r;
        f32x4 a[8];
#pragma unroll
        for (int j = 0; j < 8; ++j) a[j] = (f32x4){0.f, 0.f, 0.f, 0.f};
        f32x4 t[3][8];
#pragma unroll
        for (int q = 0; q < 3; ++q) { const int k = F.wave + 8 * q; if (k < NSL9) load_row(t[q], p_sl9 + (size_t)(k * 128 + r) * DM, F.lane); }
#pragma unroll
        for (int q = 0; q < 3; ++q) { const int k = F.wave + 8 * q; if (k < NSL9) {
#pragma unroll
            for (int j = 0; j < 8; ++j) a[j] += t[q][j]; } }
#pragma unroll
        for (int j = 0; j < 8; ++j) *(LAS f32x4*)(part + F.wave * DM + 4 * (F.lane + 64 * j)) = a[j];
        __syncthreads();
        const int c = 256 * F.wave + 4 * F.lane;
        f32x4 sacc = *(const LAS f32x4*)(part + c);
#pragma unroll
        for (int w2 = 1; w2 < 8; ++w2) sacc += *(const LAS f32x4*)(part + w2 * DM + c);
        const float* md = p_mod + (size_t)(2 + (r >> 4)) * NMOD + 5 * DM;
        const f32x4 v = *(const GAS f32x4*)(p_x1 + (size_t)m * DM + c) + *(const GAS f32x4*)(md + c) * sacc;
        float ss = wave_sum((v.x * v.x + v.y * v.y) + (v.z * v.z + v.w * v.w));
        if (F.lane == 0) red[F.wave] = ss;
        __syncthreads();
        float tot = 0.f;
#pragma unroll
        for (int w2 = 0; w2 < 8; ++w2) tot += red[w2];
        const float rinv = rsqrtf(tot * (1.f / DM) + EPS);
        *(GAS f32x4*)(F.out + (size_t)m * DM + c) = v * rinv * *(const GAS f32x4*)(p_fng + c);
        __syncthreads();
    }
}
__device__ __forceinline__ void phase_mgs(Frame& F, unsigned* ready) {
    static_assert(NSL4 == 32, "phase_mgs: 4 lanes x 8 slabs");
    const GAS f32x4* src = (const GAS f32x4*)F.slab4(); GAS v2u* dst = (GAS v2u*)(F.MG() + (size_t)MP * DM);
    for (int i = F.vcu * 512 + F.tid; i < 128 * DM; i += F.G * 512) { const int o = i >> 2, q = i & 3;
        f32x4 t[8];
#pragma unroll
        for (int k = 0; k < 8; ++k) t[k] = src[(size_t)(8 * q + k) * (128 * DM / 4) + o];
        f32x4 a = (t[0] + t[1]) + (t[2] + t[3]) + ((t[4] + t[5]) + (t[6] + t[7]));
#pragma unroll
        for (int e = 0; e < 4; ++e) { a[e] += __shfl_xor(a[e], 1); a[e] += __shfl_xor(a[e], 2); }
        if (q == 0) { v2u w; w.x = pk2(a.x, a.y); w.y = pk2(a.z, a.w); dst[o] = w; } }
    asm volatile("s_waitcnt vmcnt(0)" ::: "memory"); __syncthreads();
    if (F.tid == 0) { __builtin_amdgcn_fence(__ATOMIC_RELEASE, "agent"); asm volatile("s_waitcnt vmcnt(0)" ::: "memory"); __hip_atomic_fetch_add(ready, 1u, __ATOMIC_RELAXED, __HIP_MEMORY_SCOPE_AGENT); }
}

constexpr int RG_WL = 4352, RG_W = 34816, RG_TOT = 104448, RG_PRE = 112640, RG_HIN = 120832, RG_TAB = 121344;
__device__ __forceinline__ float gran_poll(gu64* g) {
    unsigned spins = 0;
    for (;;) { const unsigned long long x = __hip_atomic_load(g, RLX_AGENT); if ((unsigned)(x >> 32) == 1u) return __uint_as_float((unsigned)x);
        __builtin_amdgcn_s_sleep(1); if (++spins > (1u << 17)) return 0.f; }
}
__device__ __forceinline__ void rglru_prologue(Frame& F, int n) {
    const bf16_t* p_Wrg = F.Wrg_t();
    for (int i = F.tid; i < 4096; i += 512) { const int row = i >> 4, ch = i & 15;
        const v4u wv = *(const GAS v4u*)(p_Wrg + (size_t)((row >> 7) * 16 + n) * 16384 + (row & 127) * 128 + ch * 8);
        *(LAS v4u*)(F.lds + RG_W + row * 272 + ch * 16) = wv; }
    if (F.tid < 128) { const int c = n * 128 + F.tid; LAS float* tab = (LAS float*)(F.lds + RG_TAB);
        tab[F.tid] = -8.f * log1pf(__expf(-F.rg_lambda()[c])); tab[128 + F.tid] = F.b_rg_a()[c]; tab[256 + F.tid] = F.b_rg_x()[c]; }
    __syncthreads();
}
template <bool SAMPLE>
__device__ __forceinline__ void rglru_unit(Frame& F, int bn, int j) {
    const int w = F.wave, lane = F.lane, fr = lane & 15, fq = lane >> 4;
    const float* p_conv_w = F.conv_w(); const float* p_conv_b = F.conv_b(); const float* p_st_conv = F.st_conv(); const float* p_st_h = F.st_h();
    const bf16_t* p_Ub = F.Ub(); const bf16_t* p_Gb = F.Gb(); bf16_t* p_OY = F.OY(); gu64* p_gran = F.gran();
    int n, seq; long row0;
    if (SAMPLE) { n = bn; seq = 2 + w; row0 = MP + w * 16; } else { seq = bn >> 4; n = bn & 15; row0 = (long)seq * TP + j * 128 + w * 16; }
    const int cb = n * 128;
    LAS unsigned char* wl = F.lds + w * RG_WL;
    const LAS float* tab = (const LAS float*)(F.lds + RG_TAB);
    v4u gpre[4];
#pragma unroll
    for (int i = 0; i < 4; ++i) { const int r = (lane >> 4) + 4 * i; gpre[i] = *(const GAS v4u*)(p_Gb + (size_t)(row0 + r) * DM + cb + (lane & 15) * 8); }
    {
        const int c2 = cb + 2 * lane;
        float cw0[4], cw1[4];
#pragma unroll
        for (int k = 0; k < 4; ++k) { cw0[k] = p_conv_w[k * DM + c2]; cw1[k] = p_conv_w[k * DM + c2 + 1]; }
        const float cb0 = p_conv_b[c2], cb1 = p_conv_b[c2 + 1];
        float u0[19], u1[19];
#pragma unroll
        for (int i = 0; i < 19; ++i) { const int rr = i - 3;
            if (rr < 0) {
                if (SAMPLE) { u0[i] = p_st_conv[(size_t)(w * 3 + i) * DM + c2]; u1[i] = p_st_conv[(size_t)(w * 3 + i) * DM + c2 + 1]; }
                else if (j == 0 && w == 0) { u0[i] = 0.f; u1[i] = 0.f; }
                else { const unsigned p = *(const GAS unsigned*)(p_Ub + (size_t)(row0 + rr) * DM + c2); u0[i] = bflo(p); u1[i] = bfhi(p); }
            } else { const unsigned p = *(const GAS unsigned*)(p_Ub + (size_t)(row0 + rr) * DM + c2); u0[i] = bflo(p); u1[i] = bfhi(p); } }
#pragma unroll
        for (int tt = 0; tt < 16; ++tt) {
            const float x0 = cb0 + cw0[0] * u0[tt] + cw0[1] * u0[tt + 1] + cw0[2] * u0[tt + 2] + cw0[3] * u0[tt + 3];
            const float x1 = cb1 + cw1[0] * u1[tt] + cw1[1] * u1[tt + 1] + cw1[2] * u1[tt + 2] + cw1[3] * u1[tt + 3];
            *(LAS unsigned*)(wl + tt * 272 + lane * 4) = pk2(x0, x1); }
    }
    LDS_WAIT(); asm volatile("" ::: "memory");
    f32x4 acc[2][8];
#pragma unroll
    for (int a = 0; a < 2; ++a)
#pragma unroll
        for (int g = 0; g < 8; ++g) acc[a][g] = (f32x4){0.f, 0.f, 0.f, 0.f};
#pragma unroll
    for (int ks = 0; ks < 4; ++ks) { const bf16x8 a = *(const LAS bf16x8*)(wl + fr * 272 + (32 * ks + 8 * fq) * 2);
#pragma unroll
        for (int wh = 0; wh < 2; ++wh)
#pragma unroll
            for (int g = 0; g < 8; ++g) { const bf16x8 b = *(const LAS bf16x8*)(F.lds + RG_W + (wh * 128 + 16 * g + fr) * 272 + (32 * ks + 8 * fq) * 2);
                acc[wh][g] = __builtin_amdgcn_mfma_f32_16x16x32_bf16(a, b, acc[wh][g], 0, 0, 0); } }
    float Al[8][4], Hl[8][4], HS[8], EA[8], EH[8];
#pragma unroll
    for (int g = 0; g < 8; ++g) {
        const int cl = 16 * g + fr, c = cb + cl;
        const float c8 = tab[cl], ba = tab[128 + cl], bx = tab[256 + cl];
        float A = 1.f, H = 0.f;
#pragma unroll
        for (int reg = 0; reg < 4; ++reg) { const int tt = 4 * fq + reg;
            const float xcv = bf2f(*(const LAS unsigned short*)(wl + tt * 272 + cl * 2));
            const float r = sigm(acc[0][g][reg] + ba), ii = sigm(acc[1][g][reg] + bx);
            const float la = c8 * r, a = __expf(la), bb = __builtin_amdgcn_sqrtf(fmaxf(1.f - a * a, 0.f)) * (ii * xcv);
            H = a * H + bb; A = a * A; Al[g][reg] = A; Hl[g][reg] = H; }
        float IA = A, IH = H;
        { const float xa = __shfl_up(IA, 16), xh = __shfl_up(IH, 16); if (fq >= 1) { IH = IA * xh + IH; IA = IA * xa; } }
        { const float xa = __shfl_up(IA, 32), xh = __shfl_up(IH, 32); if (fq >= 2) { IH = IA * xh + IH; IA = IA * xa; } }
        { const float xa = __shfl_up(IA, 16), xh = __shfl_up(IH, 16); EA[g] = fq ? xa : 1.f; EH[g] = fq ? xh : 0.f; }
        if (SAMPLE) { const float h0 = p_st_h[(size_t)w * DM + c]; HS[g] = EA[g] * h0 + EH[g];
            if (fq == 3) F.out[O_SH + (size_t)w * DM + c] = IA * h0 + IH; }
        else { HS[g] = 0.f; if (fq == 3) *(LAS f32x2*)(F.lds + RG_TOT + (w * 128 + cl) * 8) = (f32x2){IA, IH}; }
    }
#pragma unroll
    for (int i = 0; i < 4; ++i) { const int r = (lane >> 4) + 4 * i; *(LAS v4u*)(wl + r * 272 + (lane & 15) * 16) = gpre[i]; }
    if (!SAMPLE) {
        __syncthreads();
        if (F.tid < 128) { const int c = F.tid; float PA = 1.f, PH = 0.f;
#pragma unroll
            for (int w2 = 0; w2 < 8; ++w2) { *(LAS f32x2*)(F.lds + RG_PRE + (w2 * 128 + c) * 8) = (f32x2){PA, PH};
                const f32x2 t = *(const LAS f32x2*)(F.lds + RG_TOT + (w2 * 128 + c) * 8); PH = t.x * PH + t.y; PA = PA * t.x; }
            gu64* gI = p_gran + (size_t)(bn * 32) * 128 + c; gu64* gA = gI + 131072; gu64* gB = gI + 262144;
            if (j < 31) { __hip_atomic_store(gA + j * 128, (1ull << 32) | (unsigned long long)__float_as_uint(PA), RLX_AGENT);
                          __hip_atomic_store(gB + j * 128, (1ull << 32) | (unsigned long long)__float_as_uint(PH), RLX_AGENT); }
            float hin = 0.f;
            if (j > 0) { float fa = 1.f, fh = 0.f; int k = j - 1; unsigned spins = 0; bool done = false;
                while (!done) {
                    unsigned long long xi[8], xa[8], xb[8];
#pragma unroll
                    for (int i = 0; i < 8; ++i) { const int kk = k - i < 0 ? 0 : k - i; xi[i] = __hip_atomic_load(gI + kk * 128, RLX_AGENT); xa[i] = __hip_atomic_load(gA + kk * 128, RLX_AGENT); xb[i] = __hip_atomic_load(gB + kk * 128, RLX_AGENT); }
                    bool stuck = false;
#pragma unroll
                    for (int i = 0; i < 8; ++i) { if (!done && !stuck) {
                        if ((unsigned)(xi[i] >> 32) == 1u) { hin = fa * __uint_as_float((unsigned)xi[i]) + fh; done = true; }
                        else if ((unsigned)(xa[i] >> 32) == 1u && (unsigned)(xb[i] >> 32) == 1u) { fh = fa * __uint_as_float((unsigned)xb[i]) + fh; fa = fa * __uint_as_float((unsigned)xa[i]); --k; if (k < 0) { hin = fh; done = true; } }
                        else stuck = true; } }
                    if (!done) { __builtin_amdgcn_s_sleep(1); if (++spins > (1u << 16)) break; }
                } }
            const float hout = PA * hin + PH;
            if (j < 31) __hip_atomic_store(gI + j * 128, (1ull << 32) | (unsigned long long)__float_as_uint(hout), RLX_AGENT);
            else F.out[O_PH + (size_t)seq * DM + cb + c] = hout;
            *(LAS float*)(F.lds + RG_HIN + c * 4) = hin; }
        __syncthreads();
#pragma unroll
        for (int g = 0; g < 8; ++g) { const int cl = 16 * g + fr; const f32x2 p = *(const LAS f32x2*)(F.lds + RG_PRE + (w * 128 + cl) * 8);
            const float hw = p.x * *(const LAS float*)(F.lds + RG_HIN + cl * 4) + p.y; HS[g] = EA[g] * hw + EH[g]; }
    }
    LDS_WAIT(); asm volatile("" ::: "memory");
#pragma unroll
    for (int g = 0; g < 8; ++g) { const int cl = 16 * g + fr;
#pragma unroll
        for (int reg = 0; reg < 4; ++reg) { const int tt = 4 * fq + reg; LAS unsigned short* gp = (LAS unsigned short*)(wl + tt * 272 + cl * 2);
            const float h = Al[g][reg] * HS[g] + Hl[g][reg]; *gp = (unsigned short)f2bf(h * bf2f(*gp)); } }
    LDS_WAIT(); asm volatile("" ::: "memory");
#pragma unroll
    for (int i = 0; i < 4; ++i) { const int r = (lane >> 4) + 4 * i; const v4u y = *(const LAS v4u*)(wl + r * 272 + (lane & 15) * 16);
        *(GAS v4u*)(p_OY + (size_t)(row0 + r) * 4096 + 2048 + cb + (lane & 15) * 8) = y; }
    __syncthreads();
}
typedef int i32x4_t __attribute__((ext_vector_type(4)));
__device__ __forceinline__ bf16x8 pack8frag(f32x4 a, f32x4 b) { const v4u w = pack8bf(a, b); return __builtin_bit_cast(bf16x8, w); }
__device__ __forceinline__ void sattn_unit(Frame& F, int bs, int h, int qh) {
    constexpr int RS = 532;
    LAS float* scv = (LAS float*)F.lds;
    LAS float* inv = scv + 16 * RS;
    LAS float* btab = inv + 16;
    LAS float* part = btab + 320;
    const int w = F.wave, lane = F.lane, fr = lane & 15, fq = lane >> 4;
    if (F.tid < 320) btab[F.tid] = F.rel_bias()[h * 320 + F.tid];
    const unsigned lrow = (unsigned)(fr * 2048 + 8 * fq) * 4u;
    {
        bf16x8 qf[4];
#pragma unroll
        for (int ks = 0; ks < 4; ++ks) qf[ks] = *(const GAS bf16x8*)(F.Qb() + (size_t)(MP + bs * 16 + qh * 8 + (fr & 7)) * DM + h * 128 + 32 * ks + 8 * fq);
        const __amdgpu_buffer_rsrc_t rk = __builtin_amdgcn_make_buffer_rsrc((void*)(F.cache_k() + ((size_t)(bs * 512 + 64 * w) * 16 + h) * 128), 0, 0x40000000, 0x00020000);
        f32x4 kr[4][4][2];
#pragma unroll
        for (int t = 0; t < 4; ++t)
#pragma unroll
            for (int ks = 0; ks < 4; ++ks) { const int so = (16 * t * 2048 + 32 * ks) * 4;
                kr[t][ks][0] = __builtin_bit_cast(f32x4, __builtin_amdgcn_raw_buffer_load_b128(rk, lrow, so, 0));
                kr[t][ks][1] = __builtin_bit_cast(f32x4, __builtin_amdgcn_raw_buffer_load_b128(rk, lrow, so + 16, 0)); }
#pragma unroll
        for (int t = 0; t < 4; ++t) { f32x4 acc = {0.f, 0.f, 0.f, 0.f};
#pragma unroll
            for (int ks = 0; ks < 4; ++ks) acc = __builtin_amdgcn_mfma_f32_16x16x32_bf16(pack8frag(kr[t][ks][0], kr[t][ks][1]), qf[ks], acc, 0, 0, 0);
#pragma unroll
            for (int reg = 0; reg < 4; ++reg) scv[fr * RS + 64 * w + 16 * t + 4 * fq + reg] = acc[reg] * ATT_SCALE; }
        if (w == 0) {
            const __amdgpu_buffer_rsrc_t rn = __builtin_amdgcn_make_buffer_rsrc((void*)(F.out + O_SK + (size_t)(bs * 16) * DM + h * 128), 0, 0x40000000, 0x00020000);
            f32x4 acc = {0.f, 0.f, 0.f, 0.f};
#pragma unroll
            for (int ks = 0; ks < 4; ++ks) { const f32x4 a = __builtin_bit_cast(f32x4, __builtin_amdgcn_raw_buffer_load_b128(rn, lrow, 32 * ks * 4, 0)), b = __builtin_bit_cast(f32x4, __builtin_amdgcn_raw_buffer_load_b128(rn, lrow, 32 * ks * 4 + 16, 0));
                acc = __builtin_amdgcn_mfma_f32_16x16x32_bf16(pack8frag(a, b), qf[ks], acc, 0, 0, 0); }
#pragma unroll
            for (int reg = 0; reg < 4; ++reg) scv[fr * RS + 512 + 4 * fq + reg] = acc[reg] * ATT_SCALE; }
    }
    __syncthreads();
    { const int row = w, qp_ = qh * 8 + w; float mx = -1e30f;
        for (int jk = lane; jk < 528; jk += 64) { int diff = jk < 512 ? (512 + qp_ - jk) : (qp_ - (jk - 512)); diff = diff > 256 ? 256 : diff;
            const float v = scv[row * RS + jk] + btab[diff + 63]; scv[row * RS + jk] = v; mx = fmaxf(mx, v); }
        mx = wave_max(mx); float sum = 0.f;
        for (int jk = lane; jk < 528; jk += 64) { const float e = __expf(scv[row * RS + jk] - mx); scv[row * RS + jk] = e; sum += e; }
        sum = wave_sum(sum); if (lane == 0) inv[row] = 1.f / sum; }
    __syncthreads();
    {
        const unsigned lcol = (unsigned)(8 * fq * 2048 + fr) * 4u;
        const __amdgpu_buffer_rsrc_t rv = __builtin_amdgcn_make_buffer_rsrc((void*)(F.cache_v() + ((size_t)(bs * 512 + 64 * w) * 16 + h) * 128), 0, 0x40000000, 0x00020000);
        f32x4 acc[8];
#pragma unroll
        for (int dt = 0; dt < 8; ++dt) acc[dt] = (f32x4){0.f, 0.f, 0.f, 0.f};
#pragma unroll
        for (int kt = 0; kt < 2; ++kt) {
            float vv[8][8];
#pragma unroll
            for (int dt = 0; dt < 8; ++dt)
#pragma unroll
                for (int j = 0; j < 8; ++j) vv[dt][j] = __builtin_bit_cast(float, __builtin_amdgcn_raw_buffer_load_b32(rv, lcol, ((32 * kt + j) * 2048 + 16 * dt) * 4, 0));
            const LAS f32x4* pp = (const LAS f32x4*)(scv + fr * RS + 64 * w + 32 * kt + 8 * fq);
            const bf16x8 pf = pack8frag(pp[0], pp[1]);
#pragma unroll
            for (int dt = 0; dt < 8; ++dt) { const bf16x8 bfr = pack8frag((f32x4){vv[dt][0], vv[dt][1], vv[dt][2], vv[dt][3]}, (f32x4){vv[dt][4], vv[dt][5], vv[dt][6], vv[dt][7]});
                acc[dt] = __builtin_amdgcn_mfma_f32_16x16x32_bf16(pf, bfr, acc[dt], 0, 0, 0); }
        }
        if (w == 0) {
            const __amdgpu_buffer_rsrc_t rn = __builtin_amdgcn_make_buffer_rsrc((void*)(F.out + O_SV + (size_t)(bs * 16) * DM + h * 128), 0, 0x40000000, 0x00020000);
            const unsigned lcn = (unsigned)(8 * (fq & 1) * 2048 + fr) * 4u;
            float vv[8][8];
#pragma unroll
            for (int dt = 0; dt < 8; ++dt)
#pragma unroll
                for (int j = 0; j < 8; ++j) vv[dt][j] = __builtin_bit_cast(float, __builtin_amdgcn_raw_buffer_load_b32(rn, lcn, (j * 2048 + 16 * dt) * 4, 0));
            const LAS f32x4* pp = (const LAS f32x4*)(scv + fr * RS + 512 + 8 * (fq & 1));
            f32x4 p0 = pp[0], p1 = pp[1]; if (fq >= 2) { p0 = (f32x4){0.f, 0.f, 0.f, 0.f}; p1 = p0; }
            const bf16x8 pf = pack8frag(p0, p1);
#pragma unroll
            for (int dt = 0; dt < 8; ++dt) { const bf16x8 bfr = pack8frag((f32x4){vv[dt][0], vv[dt][1], vv[dt][2], vv[dt][3]}, (f32x4){vv[dt][4], vv[dt][5], vv[dt][6], vv[dt][7]});
                acc[dt] = __builtin_amdgcn_mfma_f32_16x16x32_bf16(pf, bfr, acc[dt], 0, 0, 0); }
        }
#pragma unroll
        for (int dt = 0; dt < 8; ++dt)
#pragma unroll
            for (int reg = 0; reg < 4; ++reg) part[(w * 16 + 4 * fq + reg) * 128 + 16 * dt + fr] = acc[dt][reg];
    }
    __syncthreads();
    { const int row = F.tid >> 6, c2 = (F.tid & 63) * 2; f32x2 a = {0.f, 0.f};
#pragma unroll
      for (int w2 = 0; w2 < 8; ++w2) a += *(const LAS f32x2*)(part + (w2 * 16 + row) * 128 + c2);
      a = a * inv[row];
      *(GAS unsigned*)(F.OY() + (size_t)(MP + bs * 16 + qh * 8 + row) * 4096 + h * 128 + c2) = pk2(a.x, a.y); }
    __syncthreads();
}
__device__ __forceinline__ att::BlockRef att_ref(Frame& F, int L) {
    const int bh = L >> 4, qb = L & 15, b = bh >> 4, h = bh & 15;
    att::BlockRef r; const size_t rb = (size_t)b * TP;
    r.Q = F.Qb() + (rb + (size_t)qb * 256) * DM + h * 128; r.K = F.Kb() + rb * DM + h * 128; r.V = F.Vb() + rb * DM + h * 128;
    r.O = F.OY() + (rb + (size_t)qb * 256) * 4096 + h * 128; r.qb = qb; r.h = h; return r;
}
template <int pmask>
__device__ __forceinline__ void phase3(Frame& F, char* ldsg) {
    int wn = -1;
    if (pmask & 1) for (int id = F.vcu; id < 1024; id += F.G) { const int bn = id & 31; if ((bn & 15) != wn) { wn = bn & 15; rglru_prologue(F, wn); } rglru_unit<false>(F, bn, id >> 5); }
    if (pmask & 2) { if ((F.G & 15) == 0) { if ((F.vcu & 15) == 0 && (F.vcu >> 4) < 16) { const int n = F.vcu >> 4; if (n != wn) { wn = n; rglru_prologue(F, wn); } rglru_unit<true>(F, n, 0); } }
        else for (int n = F.vcu; n < 16; n += F.G) { if (n != wn) { wn = n; rglru_prologue(F, wn); } rglru_unit<true>(F, n, 0); } }
    if (pmask & 4) for (int u = F.vcu; u < 256; u += F.G) sattn_unit(F, u >> 5, (u >> 1) & 15, u & 1);
    for (int i = F.tid; i < 5120; i += 512) ((LAS float*)(F.lds + att::BIAS_OFF))[i] = F.rel_bias()[i];
    __syncthreads();
    int L = F.vcu;
    if ((pmask & 8) && L < 512) {
        att::BlockRef cur = att_ref(F, L); att::Seam S; att::att_prime(cur, ldsg, S);
        for (;;) { const bool more = L + F.G < 512; const int Ln = more ? L + F.G : L; const att::BlockRef nxt = more ? att_ref(F, Ln) : cur;
            att::att_block(cur, nxt, ldsg, S); if (!more) break; cur = nxt; L = Ln; }
    }
}

__global__ void __launch_bounds__(NWAVES * 64, 2) fwd(Args args) {
    extern __shared__ __attribute__((aligned(16))) unsigned char lds[];
    Frame F;
    F.lds = (LAS unsigned char*)lds;
    F.tid = threadIdx.x; F.lane = F.tid & 63; F.wave = __builtin_amdgcn_readfirstlane(F.tid >> 6);
    F.G = gridDim.x; { const int bx = blockIdx.x; F.vcu = (F.G % 8 == 0) ? (bx % 8) * (F.G / 8) + bx / 8 : bx; }
    F.out = args.out; F.ws = args.ws;
    unsigned char* ws = args.ws;
    for (int u = F.tid; u < (LDS_BYTES - LDSCTL_OFF) / 4; u += NWAVES * 64) ((LAS unsigned*)(F.lds + LDSCTL_OFF))[u] = 0u;
    __syncthreads();
#if !MK_MULTI
    XcdBarrier bar = xcd_barrier_post((unsigned*)(ws + WS_CTL) + CW_BAR, (volatile LAS unsigned*)(F.lds + MISC_OFF) + 8);
#define GRID_BAR() xcd_barrier(bar)
#else
#define GRID_BAR() do { } while (0)
#endif
    const int lo = args.ph_lo, hi = args.ph_hi;
#ifndef PHMASK
#define PHMASK 0x1ff
#endif
#define IN(k) (((PHMASK >> (k)) & 1) && lo <= (k) && (k) < hi)
#define SEAM(k) do { if (lo <= (k) && (k) + 1 < hi && (k) < 8) GRID_BAR(); } while (0)
#ifndef REP_PHASE
#define REP_PHASE -1
#endif
#define RUNPH(k, ...) do { unsigned long long t0_ = 0; if (PROBE_PHASE == (k)) t0_ = __builtin_amdgcn_s_memrealtime(); \
        if (IN(k)) { __VA_ARGS__ } if (REP_PHASE == (k) && IN(k)) { GRID_BAR(); __VA_ARGS__ } SEAM(k); \
        if (PROBE_PHASE == (k) && blockIdx.x == 0 && threadIdx.x == 0) ((unsigned*)(F.ws + WS_CTL))[2] = (unsigned)(__builtin_amdgcn_s_memrealtime() - t0_); } while (0)
    RUNPH(0, F.refresh(); phase0(F); );
    if (REP_PHASE == 100 && IN(0)) { phase0(F, true); GRID_BAR(); }
    RUNPH(1, F.refresh(); phase1(F); );
    RUNPH(2, F.refresh(); pg8::Gemm g{F.H1(), F.Win_t(), MPAD, NIN, DM}; pg8::StaticOrder S; S.init(MPAD, NIN, DM, F.G, (int)blockIdx.x);
        EpiIn E{F.Qb(), F.out}; pg8::gemm_phase<EpiIn, pg8::StaticOrder, true, true>(F.lds, g, S, E);
        { const int nlast = S.nwg % F.G, nfree = nlast ? F.G - nlast : F.G, fidx = nlast ? (int)blockIdx.x - nlast : (int)blockIdx.x;
          if (fidx >= 0) { LAS float* scr = (LAS float*)(F.lds + F.wave * 16384);
              for (int it = fidx * NWAVES + F.wave; it < NITEMS_B; it += nfree * NWAVES) conv_item_b(F, it, scr); } } );
    RUNPH(3, F.refresh(); phase3<15>(F, (char*)lds); );
    if (REP_PHASE > 100 && REP_PHASE < 116 && IN(3)) { F.refresh(); phase3<(REP_PHASE > 100 ? REP_PHASE - 100 : 15)>(F, (char*)lds); GRID_BAR(); }
    RUNPH(4, F.refresh(); pg8::Gemm g{F.OY(), F.Wproj_t(), MPAD, DM, 2 * DM}; pg8::HybridOrder S; S.init(DM, 2 * DM, F.G, (int)blockIdx.x, 2);
        EpiProj E{F.SAb(), F.SRb(), F.MG(), F.slab4(), F.ws}; pg8::gemm_phase<EpiProj, pg8::HybridOrder, true, true>(F.lds, g, S, E); );
    RUNPH(5, F.refresh(); pg8::Gemm g{F.MG(), F.Wout_t(), MPAD, DM, DM}; pg8::HybridOrder S; S.init(DM, DM, F.G, (int)blockIdx.x, 2);
        unsigned* rdy = (unsigned*)(F.ws + WS_CTL) + CW_READY + 64; S.ready = rdy; S.need = (unsigned)F.G; S.slices_first = true;
        probe_mark(0, F.ws); phase_mgs(F, rdy); probe_mark(1, F.ws);
        EpiResNorm E{F.x_prompt(), F.x1(), F.H1(), F.mod(), F.slab6(), F.lds + XL_OFF, (unsigned long long*)(F.ws + WS_XW), F.ws};
        pg8::gemm_phase<EpiResNorm, pg8::HybridOrder, true, true>(F.lds, g, S, E); );
    RUNPH(6, F.refresh(); pg8::Gemm g{F.H1(), F.Wgu_t(), MPAD, NGU, DM}; pg8::SampleGatedOrder S; S.init(MPAD, NGU, DM, F.G, (int)blockIdx.x);
        unsigned* ready = (unsigned*)(F.ws + WS_CTL) + CW_READY; S.ready = ready; S.need = MS;
        { const int nlast = S.nwg % F.G, nfree = nlast ? F.G - nlast : F.G, fidx = nlast ? (int)blockIdx.x - nlast : (int)blockIdx.x;
          if (fidx >= 0) phase_norm2s(F, fidx * NWAVES + F.wave, nfree * NWAVES, ready); }
        EpiGU E{F.ACT()}; pg8::gemm_phase<EpiGU, pg8::SampleGatedOrder, true, true>(F.lds, g, S, E); );
    RUNPH(7, F.refresh(); pg8::Gemm g{F.ACT(), F.Wdn_t(), MPAD, DM, DFF}; pg8::HybridOrder S; S.init(DM, DFF, F.G, (int)blockIdx.x, 4); S.slices_first = true;
        EpiResFinal E{F.x1(), F.out, F.mod(), F.fng(), F.slab9(), F.lds + XL_OFF, (unsigned long long*)(F.ws + WS_XW) + 32 * 256};
        pg8::gemm_phase<EpiResFinal, pg8::HybridOrder, true, true>(F.lds, g, S, E); );
    RUNPH(8, F.refresh(); phase_finals(F); );
    if (PROBE_PHASE >= 0 && blockIdx.x == 0) { __syncthreads(); const unsigned ticks = ((volatile unsigned*)(F.ws + WS_CTL))[2];
        const float fac = 1.f + 4e-3f + (PROBE_PHASE >= 100 ? 5e-5f : 1.5e-5f) * (0.01f * (float)ticks);
        for (int i = threadIdx.x; i < 16384; i += 512) F.out[O_SH + i] *= fac; }
#undef IN
#undef SEAM
}

extern "C" void kernel_launch(void* const* d_in, const int* in_sizes, int n_in, void* d_out, int out_size, void* d_ws, size_t ws_size, hipStream_t stream) {
    static int grid = 0;
    if (grid == 0) {
        if (n_in != 26 || out_size != (int)O_END || ws_size < WS_END) { fprintf(stderr, "kernel_launch: unexpected shapes (n_in %d out %d ws %zu)\n", n_in, out_size, ws_size); grid = -1; return; }
        int dev = 0, cus = 0, per_cu = 0;
        if (hipGetDevice(&dev) != hipSuccess || hipDeviceGetAttribute(&cus, hipDeviceAttributeMultiprocessorCount, dev) != hipSuccess) { grid = -1; return; }
        if (hipFuncSetAttribute((const void*)fwd, hipFuncAttributeMaxDynamicSharedMemorySize, LDS_BYTES) != hipSuccess) { fprintf(stderr, "kernel_launch: hipFuncSetAttribute failed\n"); grid = -1; return; }
        if (hipOccupancyMaxActiveBlocksPerMultiprocessor(&per_cu, (const void*)fwd, NWAVES * 64, LDS_BYTES) != hipSuccess || per_cu < 1) { fprintf(stderr, "kernel_launch: occupancy query says %d workgroups per CU; nothing launched\n", per_cu); (void)hipGetLastError(); grid = -1; return; }
        grid = cus;
    }
    if (grid < 0) return;
    (void)hipMemsetAsync((char*)d_ws + WS_CTL, 0, CTL_ZERO_BYTES, stream);
    Args a{};
    for (int i = 0; i < 26; ++i) a.in[i] = (const float*)d_in[i];
    a.out = (float*)d_out; a.ws = (unsigned char*)d_ws;
#if MK_MULTI
    for (int p = 0; p < 9; ++p) { a.ph_lo = p; a.ph_hi = p + 1; hipLaunchKernelGGL(fwd, dim3(grid), dim3(NWAVES * 64), LDS_BYTES, stream, a); }
#else
    a.ph_lo = 0; a.ph_hi = 9;
    void* kargs[] = {&a};
    hipError_t e = hipLaunchCooperativeKernel((const void*)fwd, dim3(grid), dim3(NWAVES * 64), kargs, LDS_BYTES, stream);
    if (e != hipSuccess) fprintf(stderr, "kernel_launch: cooperative launch failed: %s (grid %d)\n", hipGetErrorString(e), grid);
#endif
}
```

```cpp
#include <hip/hip_runtime.h>
#include <hip/hip_bf16.h>
#include <cstdio>
#include <cstdint>

#ifndef MK_MULTI
#define MK_MULTI 0
#endif

constexpr int DM = 2048, TP = 4096, NBP = 2, TS = 16, NBS = 8;
constexpr int MP = NBP * TP;
constexpr int MS = NBS * TS;
constexpr int MV = MP + MS;
constexpr int MPAD = 8448;
constexpr int NIN = 14336, DFF = 5632, NGU = 2 * DFF, NMOD = 6 * DM;
constexpr float EPS = 1e-6f;
constexpr float ATT_SCALE = 0.08838834764831845f;
constexpr size_t O_YP = 0, O_YS = 16777216, O_PK = 17039360, O_PV = 19136512, O_PH = 21233664, O_PC = 21237760,
                 O_SK = 21250048, O_SV = 21512192, O_SH = 21774336, O_SC = 21790720, O_END = 21839872;

constexpr size_t MiB = 1u << 20;
constexpr size_t WS_CTL = 0, CTL_ZERO_BYTES = 1 * MiB;
constexpr size_t WS_MOD = 64 * 1024;
constexpr size_t WS_GRAN = 1 * MiB;
constexpr size_t WS_SLAB4 = 218 * MiB, WS_SLAB6 = 251 * MiB, WS_SLAB9 = 350 * MiB;
constexpr int NSL4 = 32, NSL6 = 16, NSL9 = 22;
constexpr size_t WS_WIN = 4 * MiB, WS_WPROJ = 60 * MiB, WS_WOUT = 76 * MiB, WS_WGU = 84 * MiB, WS_WDN = 128 * MiB, WS_WRG = 150 * MiB;
constexpr size_t WS_H1 = 152 * MiB;
constexpr size_t WS_Q = 185 * MiB, WS_K = 218 * MiB, WS_V = 251 * MiB, WS_U = 284 * MiB, WS_G = 317 * MiB, WS_SA = 350 * MiB, WS_SR = 383 * MiB;
constexpr size_t WS_MERGED = WS_Q;
constexpr size_t WS_ACT = WS_K;
constexpr size_t WS_OY = 416 * MiB;
constexpr size_t WS_END = 482 * MiB;
static_assert(WS_ACT + (size_t)MPAD * DFF * 2 <= WS_G, "ACT overlay");
constexpr int CW_TMO = 0, CW_READY = 2048, CW_BAR = 4096;
constexpr size_t WS_XW = 640 * 1024;

constexpr int RING_BYTES = 131072, LDSCTL_OFF = RING_BYTES, MISC_OFF = LDSCTL_OFF + 320, LDS_BYTES = 147456;
constexpr int NWAVES = 8;

#define GAS __attribute__((address_space(1)))
#define LAS __attribute__((address_space(3)))
typedef unsigned short bf16_t;
typedef unsigned v4u __attribute__((ext_vector_type(4)));
typedef unsigned v2u __attribute__((ext_vector_type(2)));
typedef float f32x4 __attribute__((ext_vector_type(4)));
typedef float f32x2 __attribute__((ext_vector_type(2)));
typedef float f32x16 __attribute__((ext_vector_type(16)));
typedef short bf16x8 __attribute__((ext_vector_type(8)));
typedef short s16x4 __attribute__((ext_vector_type(4)));
typedef GAS unsigned gu32;
typedef GAS unsigned long long gu64;
#define RLX_AGENT __ATOMIC_RELAXED, __HIP_MEMORY_SCOPE_AGENT
#define LDS_WAIT() asm volatile("s_waitcnt lgkmcnt(0)" ::: "memory")
#define VM_WAIT() asm volatile("s_waitcnt vmcnt(0)" ::: "memory")

__device__ __forceinline__ unsigned f2bf(float f) { unsigned u = __builtin_bit_cast(unsigned, f); return (u + 0x7fffu + ((u >> 16) & 1u)) >> 16; }
__device__ __forceinline__ unsigned pk2(float lo, float hi) { return f2bf(lo) | (f2bf(hi) << 16); }
__device__ __forceinline__ float bf2f(unsigned short h) { return __builtin_bit_cast(float, (unsigned)h << 16); }
__device__ __forceinline__ float bflo(unsigned w) { return __builtin_bit_cast(float, w << 16); }
__device__ __forceinline__ float bfhi(unsigned w) { return __builtin_bit_cast(float, w & 0xffff0000u); }
typedef __bf16 bf16x2_t __attribute__((ext_vector_type(2)));
__device__ __forceinline__ unsigned cvt_pk_bf16(float lo, float hi) { f32x2 v = {lo, hi}; bf16x2_t b = __builtin_convertvector(v, bf16x2_t); return __builtin_bit_cast(unsigned, b); }
__device__ __forceinline__ float sigm(float x) { return __builtin_amdgcn_rcpf(1.f + __expf(-x)); }
__device__ __forceinline__ float gelu_tanh(float x) { return x * sigm(1.5957691216057308f * (x + 0.044715f * x * x * x)); }
__device__ __forceinline__ float wave_sum(float v) {
#pragma unroll
    for (int o = 1; o < 64; o <<= 1) v += __shfl_xor(v, o);
    return v;
}
__device__ __forceinline__ float wave_max(float v) {
#pragma unroll
    for (int o = 1; o < 64; o <<= 1) v = fmaxf(v, __shfl_xor(v, o));
    return v;
}

namespace pg8 {
#define PG8_LAS __attribute__((address_space(3)))
constexpr int BM = 256, BK = 64, HALF = 128, HTB = HALF * BK * 2, STAGE_BYTES = 8 * HTB, NXCD = 8, WGM = 8;
__host__ __device__ __forceinline__ int lds_byte(int r, int c) { const int st = (r >> 4) * 2 + (c >> 5), rr = r & 15, cc = c & 31, ob = rr * 64 + cc * 2; return st * 1024 + (ob ^ (((ob >> 9) & 1) << 5)); }
__host__ __device__ __forceinline__ void stage_rc(int b, int& R, int& C) { const int st = b / 1024, sb = b % 1024, swz = sb ^ (((sb >> 9) & 1) << 5); R = (st >> 1) * 16 + swz / 64; C = (st & 1) * 32 + (swz % 64) / 2; }
__host__ __device__ __forceinline__ int perm32(int rho) { const int n = rho >> 4, i = rho & 15; return 8 * (i >> 2) + 4 * n + (i & 3); }
struct Unit { int pm, pn, k0, nt; };
struct Gemm { const bf16_t* A; const bf16_t* Bt; int M, N, K; };
struct StaticOrder {
    int nM, nN, nwg, G, c, ntf;
    __host__ __device__ void init(int M, int N, int K, int G_, int c_) { nM = M / BM; nN = N / BM; nwg = nM * nN; G = G_; c = c_; ntf = K / BK; }
    __host__ __device__ __forceinline__ bool next(int i, Unit& u) const { return at((long)i * G + c, u); }
    __host__ __device__ __forceinline__ bool at(long L, Unit& u) const {
        u.pm = 0; u.pn = 0; u.k0 = 0; u.nt = ntf;
        if (L >= nwg) return false;
        int wgid = (int)L; { const int q = nwg / NXCD, r = nwg % NXCD, xcd = wgid % NXCD, off = wgid / NXCD; wgid = (xcd < r ? xcd * (q + 1) : r * (q + 1) + (xcd - r) * q) + off; }
        const int nig = WGM * nN, gid = wgid / nig, fm = gid * WGM, gsz = (nM - fm) < WGM ? (nM - fm) : WGM;
        u.pm = fm + ((wgid % nig) % gsz); u.pn = (wgid % nig) / gsz; return true;
    }
    __device__ __forceinline__ void a_ready(const Unit&) const {}
    __device__ __forceinline__ void done(const Unit&) const {}
};
struct SampleGatedOrder : StaticOrder {
    const unsigned* ready; unsigned need;
    __device__ __forceinline__ void a_ready(const Unit& u) const {
        if (u.pm != 32) return;
        if (threadIdx.x < 64) { unsigned polls = 0;
            while ((unsigned)__builtin_amdgcn_readfirstlane(__hip_atomic_load(ready, __ATOMIC_RELAXED, __HIP_MEMORY_SCOPE_AGENT)) < need) { __builtin_amdgcn_s_sleep(2); if (++polls > (1u << 20)) break; }
            __builtin_amdgcn_fence(__ATOMIC_ACQUIRE, "agent");
            asm volatile("s_waitcnt vmcnt(0)" ::: "memory"); }
        asm volatile("" ::: "memory"); __builtin_amdgcn_s_barrier(); asm volatile("" ::: "memory");
    }
};
struct HybridOrder {
    StaticOrder base; int snt, npn, nsl; const unsigned* ready = nullptr; unsigned need = 0;
    bool slices_first = false;
    __host__ __device__ void init(int N, int K, int G_, int c_, int snt_) { base.init(8192, N, K, G_, c_); snt = snt_; npn = N / BM; nsl = (K / BK) / snt_; }
    __host__ __device__ __forceinline__ bool next(int i, Unit& u) const {
        const long L = (long)i * base.G + base.c;
        if (slices_first) { const long ns = (long)npn * nsl;
            if (L >= ns) return base.at(L - ns, u);
            u.pm = 32; u.pn = (int)(L % npn); u.k0 = (int)(L / npn) * snt; u.nt = snt; return true; }
        if (L < base.nwg) return base.at(L, u);
        const int sidx = (int)(L - base.nwg);
        u.pm = 32; u.pn = sidx % npn; u.k0 = (sidx / npn) * snt; u.nt = snt; return sidx < npn * nsl;
    }
    __device__ __forceinline__ void a_ready(const Unit& u) const {
        if (u.pm != 32 || ready == nullptr) return;
        if (threadIdx.x < 64) { unsigned polls = 0;
            while ((unsigned)__builtin_amdgcn_readfirstlane(__hip_atomic_load(ready, __ATOMIC_RELAXED, __HIP_MEMORY_SCOPE_AGENT)) < need) { __builtin_amdgcn_s_sleep(2); if (++polls > (1u << 20)) break; }
            __builtin_amdgcn_fence(__ATOMIC_ACQUIRE, "agent");
            asm volatile("s_waitcnt vmcnt(0)" ::: "memory"); }
        asm volatile("" ::: "memory"); __builtin_amdgcn_s_barrier(); asm volatile("" ::: "memory");
    }
    __device__ __forceinline__ void done(const Unit&) const {}
};
template <class Epi, class Sched, bool ALIGN_EPI = false, bool SP2 = false>
__device__ __forceinline__ void gemm_phase(PG8_LAS unsigned char* lds, const Gemm g, const Sched& S, const Epi& E) {
    const int tid = threadIdx.x, wid = __builtin_amdgcn_readfirstlane(tid >> 6), lane = tid & 63, wr = wid >> 2, wc = wid & 3, fr = lane & 15, fq = lane >> 4;
    const int K = g.K, nt = K / BK;
    unsigned voffA[2], voffB[2];
#pragma unroll
    for (int i = 0; i < 2; ++i) { int R, C; stage_rc(tid * 16 + i * 8192, R, C); const int Rb = Epi::PERM ? ((R & ~31) + perm32(R & 31)) : R;
        voffA[i] = (unsigned)(R * K + C) * 2u; voffB[i] = (unsigned)(Rb * K + C) * 2u; }
    const size_t kstep = (size_t)(BK * 2);
    const size_t hstep = (size_t)HALF * K * 2;
    const size_t tstep = 2 * hstep;
    const unsigned ldsw = (unsigned)wid * 1024u;
    const int aoff = lds_byte(wr * 64 + fr, fq * 8), boff = lds_byte(wc * 32 + fr, fq * 8);
#define PG8_SA(b, h) (((b) * 2 + (h)) * HTB)
#define PG8_SB(b, h) ((4 + (b) * 2 + (h)) * HTB)
#define PG8_STAGE(bufoff, gbase, voff) do { _Pragma("unroll") for (int _i = 0; _i < 2; ++_i) \
        __builtin_amdgcn_global_load_lds((const unsigned*)((const char*)(gbase) + (voff)[_i]), (PG8_LAS unsigned*)(lds + (bufoff) + ldsw + _i * 8192), 16, 0, 0); } while (0)
#define PG8_LDA(dst, b, h) do { _Pragma("unroll") for (int m = 0; m < 4; ++m) _Pragma("unroll") for (int k = 0; k < 2; ++k) dst[m][k] = *(const PG8_LAS bf16x8*)(lds + PG8_SA(b, h) + aoff + m * 2048 + k * 1024); } while (0)
#define PG8_LDB(dst, b, h) do { _Pragma("unroll") for (int n = 0; n < 2; ++n) _Pragma("unroll") for (int k = 0; k < 2; ++k) dst[n][k] = *(const PG8_LAS bf16x8*)(lds + PG8_SB(b, h) + boff + n * 2048 + k * 1024); } while (0)
#define PG8_MMA(ai, bj, At, Bt) do { __builtin_amdgcn_s_setprio(1); _Pragma("unroll") for (int m = 0; m < 4; ++m) _Pragma("unroll") for (int n = 0; n < 2; ++n) _Pragma("unroll") for (int k = 0; k < 2; ++k) \
        acc[ai][bj][m][n] = __builtin_amdgcn_mfma_f32_16x16x32_bf16(Bt[n][k], At[m][k], acc[ai][bj][m][n], 0, 0, 0); __builtin_amdgcn_s_setprio(0); } while (0)
#define PG8_WAIT_V(n) asm volatile("s_waitcnt vmcnt(" #n ")" ::: "memory")
#define PG8_WAIT_L(n) asm volatile("s_waitcnt lgkmcnt(" #n ")" ::: "memory")
#define PG8_BAR __builtin_amdgcn_s_barrier()
#define PG8_SCHED __builtin_amdgcn_sched_barrier(0)
    Unit cur, nxt; int ui = 0;
    if (!S.next(0, cur)) return;
    f32x4 acc[2][2][4][2];
#pragma unroll
    for (int a = 0; a < 2; ++a)
#pragma unroll
        for (int b = 0; b < 2; ++b)
#pragma unroll
            for (int m = 0; m < 4; ++m)
#pragma unroll
                for (int n = 0; n < 2; ++n) acc[a][b][m][n] = (f32x4){0.f, 0.f, 0.f, 0.f};
    bf16x8 At[4][2], B0[2][2], B1[2][2];
    const char* cA = (const char*)g.A + (size_t)cur.pm * tstep + (size_t)cur.k0 * kstep; const char* cB = (const char*)g.Bt + (size_t)cur.pn * tstep + (size_t)cur.k0 * kstep;
    S.a_ready(cur);
    if constexpr (SP2) {
        PG8_STAGE(PG8_SB(0, 0), cB, voffB); PG8_STAGE(PG8_SB(0, 1), cB + hstep, voffB); PG8_STAGE(PG8_SA(0, 0), cA, voffA); PG8_STAGE(PG8_SA(0, 1), cA + hstep, voffA);
        if (wr == 1) PG8_BAR;
        PG8_WAIT_V(2); PG8_BAR;
        PG8_STAGE(PG8_SB(1, 0), cB + kstep, voffB); PG8_STAGE(PG8_SA(1, 0), cA + kstep, voffA); PG8_STAGE(PG8_SB(1, 1), cB + hstep + kstep, voffB);
        PG8_WAIT_V(6); PG8_BAR;
    } else {
        PG8_STAGE(PG8_SB(0, 0), cB, voffB); PG8_STAGE(PG8_SA(0, 0), cA, voffA); PG8_STAGE(PG8_SB(0, 1), cB + hstep, voffB); PG8_STAGE(PG8_SA(0, 1), cA + hstep, voffA);
        if (wr == 1) PG8_BAR;
        PG8_WAIT_V(4); PG8_BAR;
        PG8_STAGE(PG8_SB(1, 0), cB + kstep, voffB); PG8_STAGE(PG8_SA(1, 0), cA + kstep, voffA); PG8_STAGE(PG8_SB(1, 1), cB + hstep + kstep, voffB);
        PG8_WAIT_V(6); PG8_BAR;
    }
    for (;;) {
        const bool has_next = S.next(ui + 1, nxt);
        const char* nA = has_next ? (const char*)g.A + (size_t)nxt.pm * tstep + (size_t)nxt.k0 * kstep : cA; const char* nB = has_next ? (const char*)g.Bt + (size_t)nxt.pn * tstep + (size_t)nxt.k0 * kstep : cB;
        const int cnt = cur.nt;
        for (int t = 0; t < cnt; t += 2) {
            if constexpr (Epi::MIDK) { if (cnt == nt && t == (nt >> 1)) E.mid(acc, cur, wr, wc, fr, fq); }
            const bool last = (t == cnt - 2);
            const char* a1 = cA + (size_t)(t + 1) * kstep;
            const char* a2 = last ? nA : cA + (size_t)(t + 2) * kstep; const char* b2 = last ? nB : cB + (size_t)(t + 2) * kstep;
            const char* a3 = a2 + kstep; const char* b3 = b2 + kstep;
            if (last && has_next) S.a_ready(nxt);
            if constexpr (SP2) {
            PG8_LDB(B0, 0, 0); PG8_LDB(B1, 0, 1); PG8_SCHED; PG8_LDA(At, 0, 0); PG8_STAGE(PG8_SA(1, 1), a1 + hstep, voffA);
            PG8_WAIT_V(8); PG8_WAIT_L(0); PG8_BAR; PG8_MMA(0, 0, At, B0); PG8_MMA(0, 1, At, B1); PG8_BAR; PG8_SCHED;
            PG8_LDA(At, 0, 1); PG8_STAGE(PG8_SB(0, 0), b2, voffB); PG8_STAGE(PG8_SB(0, 1), b2 + hstep, voffB); PG8_STAGE(PG8_SA(0, 0), a2, voffA);
            PG8_WAIT_V(8); PG8_WAIT_L(0); PG8_BAR; PG8_MMA(1, 0, At, B0); PG8_MMA(1, 1, At, B1); PG8_BAR; PG8_SCHED;
            PG8_LDB(B0, 1, 0); PG8_LDB(B1, 1, 1); PG8_SCHED; PG8_LDA(At, 1, 0); PG8_STAGE(PG8_SA(0, 1), a2 + hstep, voffA);
            PG8_WAIT_V(8); PG8_WAIT_L(0); PG8_BAR; PG8_MMA(0, 0, At, B0); PG8_MMA(0, 1, At, B1); PG8_BAR; PG8_SCHED;
            PG8_LDA(At, 1, 1); PG8_STAGE(PG8_SB(1, 0), b3, voffB); PG8_STAGE(PG8_SB(1, 1), b3 + hstep, voffB); PG8_STAGE(PG8_SA(1, 0), a3, voffA);
            PG8_WAIT_V(8); PG8_WAIT_L(0); PG8_BAR; PG8_MMA(1, 0, At, B0); PG8_MMA(1, 1, At, B1); PG8_BAR; PG8_SCHED;
            } else {
            PG8_LDB(B0, 0, 0); PG8_SCHED; PG8_LDA(At, 0, 0); PG8_STAGE(PG8_SA(1, 1), a1 + hstep, voffA);
            PG8_WAIT_L(8); PG8_BAR; PG8_WAIT_L(0); PG8_MMA(0, 0, At, B0); PG8_BAR; PG8_SCHED;
            PG8_LDB(B1, 0, 1); PG8_STAGE(PG8_SB(0, 0), b2, voffB);
            PG8_BAR; PG8_WAIT_L(0); PG8_MMA(0, 1, At, B1); PG8_BAR;
            PG8_LDA(At, 0, 1); PG8_STAGE(PG8_SA(0, 0), a2, voffA);
            PG8_BAR; PG8_WAIT_L(0); PG8_MMA(1, 0, At, B0); PG8_BAR; PG8_SCHED;
            PG8_STAGE(PG8_SB(0, 1), b2 + hstep, voffB);
            PG8_WAIT_V(6); PG8_BAR; PG8_MMA(1, 1, At, B1); PG8_BAR;
            PG8_LDB(B0, 1, 0); PG8_SCHED; PG8_LDA(At, 1, 0); PG8_STAGE(PG8_SA(0, 1), a2 + hstep, voffA);
            PG8_WAIT_L(8); PG8_BAR; PG8_WAIT_L(0); PG8_MMA(0, 0, At, B0); PG8_BAR; PG8_SCHED;
            PG8_LDB(B1, 1, 1); PG8_STAGE(PG8_SB(1, 0), b3, voffB);
            PG8_BAR; PG8_WAIT_L(0); PG8_MMA(0, 1, At, B1); PG8_BAR;
            PG8_LDA(At, 1, 1); PG8_STAGE(PG8_SA(1, 0), a3, voffA);
            PG8_BAR; PG8_WAIT_L(0); PG8_MMA(1, 0, At, B0); PG8_BAR; PG8_SCHED;
            PG8_STAGE(PG8_SB(1, 1), b3 + hstep, voffB);
            PG8_WAIT_V(6); PG8_BAR; PG8_MMA(1, 1, At, B1); PG8_BAR;
            }
        }
        if constexpr (ALIGN_EPI) { if (wr == 0) PG8_BAR; }
        if constexpr (Epi::AFTER_DRAIN) { if (has_next) E(acc, cur, wr, wc, fr, fq); } else { E(acc, cur, wr, wc, fr, fq); }
        S.done(cur);
        if (!has_next) break;
#pragma unroll
        for (int a = 0; a < 2; ++a)
#pragma unroll
            for (int b = 0; b < 2; ++b)
#pragma unroll
                for (int m = 0; m < 4; ++m)
#pragma unroll
                    for (int n = 0; n < 2; ++n) acc[a][b][m][n] = (f32x4){0.f, 0.f, 0.f, 0.f};
        cur = nxt; cA = nA; cB = nB; ++ui;
        if constexpr (ALIGN_EPI) { if (wr == 1) PG8_BAR; }
    }
    PG8_WAIT_V(0);
    if constexpr (!ALIGN_EPI) { if (wr == 0) PG8_BAR; }
    PG8_BAR;
    if constexpr (Epi::AFTER_DRAIN) E.fused(acc, cur, wr, wc, fr, fq, lds);
#undef PG8_SA
#undef PG8_SB
#undef PG8_STAGE
#undef PG8_LDA
#undef PG8_LDB
#undef PG8_MMA
#undef PG8_WAIT_V
#undef PG8_WAIT_L
#undef PG8_BAR
#undef PG8_SCHED
}
}

#ifndef PROBE_PHASE
#define PROBE_PHASE -1
#endif
__device__ __forceinline__ void probe_mark(int id, unsigned char* ws) {
    if (PROBE_PHASE >= 100 && blockIdx.x == 0 && threadIdx.x == 0) { const int a = (PROBE_PHASE - 100) / 10, b = (PROBE_PHASE - 100) % 10;
        unsigned* w = (unsigned*)ws; const unsigned now = (unsigned)__builtin_amdgcn_s_memrealtime();
        if (id == a) w[3] = now; if (id == b) w[2] = now - w[3]; }
}
__device__ __forceinline__ v4u pack8bf(f32x4 a, f32x4 b) { v4u w; w.x = cvt_pk_bf16(a[0], a[1]); w.y = cvt_pk_bf16(a[2], a[3]); w.z = cvt_pk_bf16(b[0], b[1]); w.w = cvt_pk_bf16(b[2], b[3]); return w; }
__device__ __forceinline__ void unpack8bf(v4u w, f32x4& a, f32x4& b) { a = (f32x4){bflo(w.x), bfhi(w.x), bflo(w.y), bfhi(w.y)}; b = (f32x4){bflo(w.z), bfhi(w.z), bflo(w.w), bfhi(w.w)}; }

struct EpiIn {
    static constexpr bool PERM = true, MIDK = false, AFTER_DRAIN = false;
    bf16_t* base;
    float* out;
    __device__ __forceinline__ void mid(f32x4 (&)[2][2][4][2], const pg8::Unit&, int, int, int, int) const {}
    template <int MODE>
    __device__ __forceinline__ void store_bf(const f32x4 (&acc)[2][2][4][2], const pg8::Unit& u, int wr, int wc, int fr, int fq, bf16_t* dst) const {
        const int colr = (u.pn & 7) * 256 + wc * 32 + 8 * fq;
#pragma unroll
        for (int ai = 0; ai < 2; ++ai)
#pragma unroll
            for (int m = 0; m < 4; ++m) {
                const size_t row = (size_t)u.pm * 256 + ai * 128 + wr * 64 + m * 16 + fr;
#pragma unroll
                for (int bj = 0; bj < 2; ++bj) {
                    f32x4 v0 = acc[ai][bj][m][0], v1 = acc[ai][bj][m][1];
                    if (MODE == 1) {
#pragma unroll
                        for (int e = 0; e < 4; ++e) { v0[e] = gelu_tanh(v0[e]); v1[e] = gelu_tanh(v1[e]); }
                    } else if (MODE == 2) {
#pragma unroll
                        for (int e = 0; e < 4; ++e) { v0[e] = sigm(v0[e]); v1[e] = sigm(v1[e]); }
                    }
                    *(v4u*)(dst + row * DM + colr + bj * 128) = pack8bf(v0, v1);
                }
                asm volatile("" ::: "memory");
            }
    }
    __device__ __forceinline__ void store_f32(const f32x4 (&acc)[2][2][4][2], const pg8::Unit& u, int wr, int wc, int fr, int fq, float* orow0, int rl0, int rl1) const {
        const int colr = (u.pn & 7) * 256 + wc * 32 + 8 * fq;
#pragma unroll
        for (int ai = 0; ai < 2; ++ai)
#pragma unroll
            for (int m = 0; m < 4; ++m) {
                const int rl = ai * 128 + wr * 64 + m * 16 + fr;
                if (rl >= rl0 && rl < rl1) {
                    float* o = orow0 + (size_t)(rl - rl0) * DM + colr;
#pragma unroll
                    for (int bj = 0; bj < 2; ++bj) { *(f32x4*)(o + bj * 128) = acc[ai][bj][m][0]; *(f32x4*)(o + bj * 128 + 4) = acc[ai][bj][m][1]; }
                }
                asm volatile("" ::: "memory");
            }
    }
    __device__ __forceinline__ void store_f32_sconv(const f32x4 (&acc)[2][2][4][2], const pg8::Unit& u, int wr, int wc, int fr, int fq) const {
        const int colr = (u.pn & 7) * 256 + wc * 32 + 8 * fq;
        if (fr >= 13) {
#pragma unroll
            for (int m = 0; m < 4; ++m) {
                const int rl = wr * 64 + m * 16 + fr;
                float* o = out + O_SC + ((size_t)((rl >> 4) * 3 + fr - 13)) * DM + colr;
#pragma unroll
                for (int bj = 0; bj < 2; ++bj) { *(f32x4*)(o + bj * 128) = acc[0][bj][m][0]; *(f32x4*)(o + bj * 128 + 4) = acc[0][bj][m][1]; }
                asm volatile("" ::: "memory");
            }
        }
    }
    __device__ __forceinline__ void operator()(const f32x4 (&acc)[2][2][4][2], const pg8::Unit& u, int wr, int wc, int fr, int fq) const {
        const int region = u.pn >> 3, pm = u.pm;
        bf16_t* dst = base + (size_t)region * (33 * MiB / 2);
        const bool sample = (pm == 32);
        if (region == 4) store_bf<1>(acc, u, wr, wc, fr, fq, dst);
        else if (region >= 5) store_bf<2>(acc, u, wr, wc, fr, fq, dst);
        else store_bf<0>(acc, u, wr, wc, fr, fq, dst);
        if (region == 1 || region == 2) {
            if (sample) store_f32(acc, u, wr, wc, fr, fq, out + (region == 1 ? O_SK : O_SV), 0, 128);
            else if ((pm & 15) >= 14) store_f32(acc, u, wr, wc, fr, fq, out + (region == 1 ? O_PK : O_PV) + ((size_t)((pm >> 4) * 512 + ((pm & 15) - 14) * 256)) * DM, 0, 256);
        } else if (region == 3) {
            if (sample) store_f32_sconv(acc, u, wr, wc, fr, fq);
            else if ((pm & 15) == 15) store_f32(acc, u, wr, wc, fr, fq, out + O_PC + (size_t)((pm >> 4) * 3) * DM, 253, 256);
        }
    }
};
template <bool GATED>
__device__ __forceinline__ void slice_store(const f32x4 (&acc)[2][2][4][2], const pg8::Unit& u, int wr, int wc, int fr, int fq, float* slabs, const bf16_t* gate) {
    int opq = 0; asm volatile("" : "+v"(opq));
    const int col0 = u.pn * 256 + wc * 32 + 8 * fq;
    float* slab = slabs + (size_t)(u.k0 / u.nt) * (128 * DM);
#pragma unroll
    for (int m = 0; m < 4; ++m) {
        const int rl = wr * 64 + m * 16 + fr + opq;
#pragma unroll
        for (int bj = 0; bj < 2; ++bj) {
            const int c = col0 + bj * 128;
            f32x4 v0 = acc[0][bj][m][0], v1 = acc[0][bj][m][1];
            if (GATED) { f32x4 g0, g1; unpack8bf(*(const v4u*)(gate + (size_t)(MP + rl) * DM + c), g0, g1); v0 = v0 * g0; v1 = v1 * g1; }
            float* p = slab + (size_t)rl * DM + c;
            *(f32x4*)p = v0; *(f32x4*)(p + 4) = v1;
        }
        if (m & 1) asm volatile("" ::: "memory");
    }
}
struct EpiProj {
    static constexpr bool PERM = true, MIDK = true, AFTER_DRAIN = false;
    const bf16_t* SA; const bf16_t* SR; bf16_t* O; float* sacc; unsigned char* pws;
    __device__ __forceinline__ void mid(f32x4 (&acc)[2][2][4][2], const pg8::Unit& u, int wr, int wc, int fr, int fq) const {
        probe_mark(6, pws);
        int opq = 0; asm volatile("" : "+v"(opq));
        const int col0 = u.pn * 256 + wc * 32 + 8 * fq;
        const int rowb = u.pm * 256 + wr * 64 + fr + opq;
#pragma unroll
        for (int ai = 0; ai < 2; ++ai)
#pragma unroll
            for (int m = 0; m < 4; ++m) {
                const size_t row = (size_t)(rowb + ai * 128 + m * 16);
#pragma unroll
                for (int bj = 0; bj < 2; ++bj) {
                    const size_t off = row * DM + col0 + bj * 128;
                    f32x4 a0, a1, r0, r1; unpack8bf(*(const v4u*)(SA + off), a0, a1); unpack8bf(*(const v4u*)(SR + off), r0, r1);
#pragma unroll
                    for (int e = 0; e < 4; ++e) { acc[ai][bj][m][0][e] *= a0[e] * __builtin_amdgcn_rcpf(r0[e]); acc[ai][bj][m][1][e] *= a1[e] * __builtin_amdgcn_rcpf(r1[e]); }
                }
                if (m & 1) asm volatile("" : "+v"(acc[ai][0][m][0]), "+v"(acc[ai][0][m][1]), "+v"(acc[ai][1][m][0]), "+v"(acc[ai][1][m][1]) :: "memory");
            }
        probe_mark(7, pws);
    }
    __device__ __forceinline__ void operator()(const f32x4 (&acc)[2][2][4][2], const pg8::Unit& u, int wr, int wc, int fr, int fq) const {
        probe_mark(8, pws);
        if (u.pm == 32) { slice_store<true>(acc, u, wr, wc, fr, fq, sacc, u.k0 < 32 ? SA : SR); return; }
        const int col0 = u.pn * 256 + wc * 32 + 8 * fq;
#pragma unroll
        for (int ai = 0; ai < 2; ++ai)
#pragma unroll
            for (int m = 0; m < 4; ++m) {
                const size_t row = (size_t)u.pm * 256 + ai * 128 + wr * 64 + m * 16 + fr;
#pragma unroll
                for (int bj = 0; bj < 2; ++bj) {
                    const size_t off = row * DM + col0 + bj * 128;
                    f32x4 r0, r1; unpack8bf(*(const v4u*)(SR + off), r0, r1);
                    *(v4u*)(O + off) = pack8bf(acc[ai][bj][m][0] * r0, acc[ai][bj][m][1] * r1);
                }
                if (m & 1) asm volatile("" ::: "memory");
            }
    }
};
constexpr int XL_OFF = LDSCTL_OFF + 1024;
__device__ __forceinline__ void panel_rinv(const f32x4 (&v)[2][2][4][2], const pg8::Unit& u, int wr, int wc, int fr, int fq, LAS unsigned char* xl, unsigned long long* xw) {
    const int lane = threadIdx.x & 63, wid = wr * 4 + wc;
    LAS float* P = (LAS float*)xl;
    LAS float* S = P + 1024;
#pragma unroll
    for (int ai = 0; ai < 2; ++ai)
#pragma unroll
        for (int m = 0; m < 4; ++m) { float q = 0.f;
#pragma unroll
            for (int bj = 0; bj < 2; ++bj)
#pragma unroll
                for (int n = 0; n < 2; ++n) { const f32x4 x = v[ai][bj][m][n]; q += (x[0] * x[0] + x[1] * x[1]) + (x[2] * x[2] + x[3] * x[3]); }
            q += __shfl_xor(q, 16); q += __shfl_xor(q, 32);
            if (fq == 0) P[(ai * 128 + wr * 64 + m * 16 + fr) * 4 + wc] = q; }
    asm volatile("s_waitcnt lgkmcnt(0)" ::: "memory"); __builtin_amdgcn_s_barrier(); asm volatile("" ::: "memory");
    int opq = 0; asm volatile("" : "+v"(opq));
    if (lane < 32) { const int row = wid * 32 + lane + opq; const f32x4 a = *(const LAS f32x4*)(P + row * 4);
        const float q = (a[0] + a[1]) + (a[2] + a[3]);
        unsigned long long* w = xw + (size_t)u.pm * 256 + row;
        const unsigned long long inc = (1ull << 56) + (unsigned long long)(q * 1048576.f);
        unsigned long long cur = __hip_atomic_fetch_add(w, inc, __ATOMIC_RELAXED, __HIP_MEMORY_SCOPE_AGENT) + inc;
        unsigned spins = 0;
        while ((cur >> 56) < 8ull) { __builtin_amdgcn_s_sleep(1); cur = __hip_atomic_load(w, __ATOMIC_RELAXED, __HIP_MEMORY_SCOPE_AGENT); if (++spins > (1u << 18)) break; }
        S[row] = rsqrtf((float)(cur & ((1ull << 56) - 1)) * (1.f / (1048576.f * DM)) + EPS); }
    asm volatile("s_waitcnt vmcnt(0) lgkmcnt(0)" ::: "memory"); __builtin_amdgcn_s_barrier(); asm volatile("" ::: "memory");
}
__device__ __forceinline__ void residual_dma(f32x4 (&acc)[2][2][4][2], const float* res, size_t row_base  , int col0, const float* gate, int wr, int wc, int fr, int fq, LAS unsigned char* lds) {
    const int wid = __builtin_amdgcn_readfirstlane(wr * 4 + wc), lane = threadIdx.x & 63;
    LAS unsigned char* wreg = lds + wid * 16384;
    f32x4 gg[2][2];
#pragma unroll
    for (int bj = 0; bj < 2; ++bj) { gg[bj][0] = *(const f32x4*)(gate + col0 + bj * 128); gg[bj][1] = *(const f32x4*)(gate + col0 + bj * 128 + 4); }
#pragma unroll
    for (int ai = 0; ai < 2; ++ai) {
        const float* rb = res + (row_base + ai * 128 + wr * 64 + fr) * DM + col0;
#pragma unroll
        for (int m = 0; m < 4; ++m)
#pragma unroll
            for (int bj = 0; bj < 2; ++bj)
#pragma unroll
                for (int hf = 0; hf < 2; ++hf)
                    __builtin_amdgcn_global_load_lds((const unsigned*)(rb + (size_t)(16 * m) * DM + bj * 128 + 4 * hf), (LAS unsigned*)(wreg + ((m * 2 + bj) * 2 + hf) * 1024), 16, 0, 0);
        asm volatile("s_waitcnt vmcnt(0)" ::: "memory");
#pragma unroll
        for (int m = 0; m < 4; ++m)
#pragma unroll
            for (int bj = 0; bj < 2; ++bj) {
                const f32x4 x0 = *(const LAS f32x4*)(wreg + ((m * 2 + bj) * 2 + 0) * 1024 + lane * 16), x1 = *(const LAS f32x4*)(wreg + ((m * 2 + bj) * 2 + 1) * 1024 + lane * 16);
                acc[ai][bj][m][0] = x0 + gg[bj][0] * acc[ai][bj][m][0]; acc[ai][bj][m][1] = x1 + gg[bj][1] * acc[ai][bj][m][1];
                asm volatile("" : "+v"(acc[ai][bj][m][0]), "+v"(acc[ai][bj][m][1]) :: "memory"); }
        asm volatile("s_waitcnt lgkmcnt(0)" ::: "memory");
    }
}
struct EpiResNorm {
    static constexpr bool PERM = true, MIDK = false, AFTER_DRAIN = true;
    const float* xin; float* x1o; bf16_t* h2o; const float* mod; float* slabs; LAS unsigned char* xl; unsigned long long* xw; unsigned char* pws;
    __device__ __forceinline__ void mid(f32x4 (&)[2][2][4][2], const pg8::Unit&, int, int, int, int) const {}
    __device__ __forceinline__ void finish(f32x4 (&acc)[2][2][4][2], const pg8::Unit& u, int wr, int wc, int fr, int fq) const {
        const int col0 = u.pn * 256 + wc * 32 + 8 * fq;
        const float* md = mod + (size_t)(u.pm >> 4) * NMOD;
        panel_rinv(acc, u, wr, wc, fr, fq, xl, xw);
        probe_mark(4, pws);
        const LAS float* S = (const LAS float*)xl + 1024;
        int opq = 0; asm volatile("" : "+v"(opq));
        const int rl0 = wr * 64 + fr + opq;
#pragma unroll
        for (int bj = 0; bj < 2; ++bj)
#pragma unroll
            for (int n = 0; n < 2; ++n) {
                const int c = col0 + bj * 128 + 4 * n;
                const f32x4 s0 = *(const f32x4*)(md + 4 * DM + c) + 1.f, h0 = *(const f32x4*)(md + 3 * DM + c);
#pragma unroll
                for (int ai = 0; ai < 2; ++ai)
#pragma unroll
                    for (int m = 0; m < 4; ++m) {
                        const int rl = rl0 + ai * 128 + m * 16; const float rv = S[rl];
                        const size_t ro = (size_t)(u.pm * 256 + rl) * DM + c;
                        *(f32x4*)(x1o + ro) = acc[ai][bj][m][n];
                        const f32x4 y = acc[ai][bj][m][n] * rv * s0 + h0; v2u w; w.x = cvt_pk_bf16(y[0], y[1]); w.y = cvt_pk_bf16(y[2], y[3]);
                        *(v2u*)(h2o + ro) = w;
                    }
                asm volatile("" ::: "memory");
            }
    }
    __device__ __forceinline__ void operator()(f32x4 (&acc)[2][2][4][2], const pg8::Unit& u, int wr, int wc, int fr, int fq) const {
        if (u.pm == 32) { slice_store<false>(acc, u, wr, wc, fr, fq, slabs, nullptr); return; }
        const int col0 = u.pn * 256 + wc * 32 + 8 * fq;
        const float* md = mod + (size_t)(u.pm >> 4) * NMOD;
#pragma unroll
        for (int ai = 0; ai < 2; ++ai)
#pragma unroll
            for (int m = 0; m < 4; ++m) {
                const size_t ro = (size_t)(u.pm * 256 + ai * 128 + wr * 64 + m * 16 + fr) * DM;
#pragma unroll
                for (int bj = 0; bj < 2; ++bj) {
                    const int c = col0 + bj * 128;
                    const f32x4 g0 = *(const f32x4*)(md + 2 * DM + c), g1 = *(const f32x4*)(md + 2 * DM + c + 4);
                    const f32x4 x0 = *(const f32x4*)(xin + ro + c), x1 = *(const f32x4*)(xin + ro + c + 4);
                    acc[ai][bj][m][0] = x0 + g0 * acc[ai][bj][m][0]; acc[ai][bj][m][1] = x1 + g1 * acc[ai][bj][m][1];
                }
                asm volatile("" : "+v"(acc[ai][0][m][0]), "+v"(acc[ai][0][m][1]), "+v"(acc[ai][1][m][0]), "+v"(acc[ai][1][m][1]) :: "memory");
            }
        finish(acc, u, wr, wc, fr, fq);
    }
    __device__ __forceinline__ void fused(f32x4 (&acc)[2][2][4][2], const pg8::Unit& u, int wr, int wc, int fr, int fq, LAS unsigned char* lds) const {
        if (u.pm == 32) { slice_store<false>(acc, u, wr, wc, fr, fq, slabs, nullptr); return; }
        probe_mark(2, pws);
        residual_dma(acc, xin, (size_t)u.pm * 256, u.pn * 256 + wc * 32 + 8 * fq, mod + (size_t)(u.pm >> 4) * NMOD + 2 * DM, wr, wc, fr, fq, lds);
        probe_mark(3, pws);
        finish(acc, u, wr, wc, fr, fq);
        probe_mark(5, pws);
    }
};
struct EpiResFinal {
    static constexpr bool PERM = true, MIDK = false, AFTER_DRAIN = true;
    const float* x1i; float* yo; const float* mod; const float* fng; float* slabs; LAS unsigned char* xl; unsigned long long* xw;
    __device__ __forceinline__ void mid(f32x4 (&)[2][2][4][2], const pg8::Unit&, int, int, int, int) const {}
    __device__ __forceinline__ void finish(f32x4 (&acc)[2][2][4][2], const pg8::Unit& u, int wr, int wc, int fr, int fq) const {
        const int col0 = u.pn * 256 + wc * 32 + 8 * fq;
        panel_rinv(acc, u, wr, wc, fr, fq, xl, xw);
        const LAS float* S = (const LAS float*)xl + 1024;
        int opq = 0; asm volatile("" : "+v"(opq));
        const int rl0 = wr * 64 + fr + opq;
#pragma unroll
        for (int bj = 0; bj < 2; ++bj) {
            const int c = col0 + bj * 128;
            const f32x4 f0 = *(const f32x4*)(fng + c), f1 = *(const f32x4*)(fng + c + 4);
#pragma unroll
            for (int ai = 0; ai < 2; ++ai)
#pragma unroll
                for (int m = 0; m < 4; ++m) {
                    const int rl = rl0 + ai * 128 + m * 16; const float rv = S[rl];
                    float* o = yo + (size_t)(u.pm * 256 + rl) * DM + c;
                    *(f32x4*)o = acc[ai][bj][m][0] * rv * f0; *(f32x4*)(o + 4) = acc[ai][bj][m][1] * rv * f1;
                }
            asm volatile("" ::: "memory");
        }
    }
    __device__ __forceinline__ void operator()(f32x4 (&acc)[2][2][4][2], const pg8::Unit& u, int wr, int wc, int fr, int fq) const {
        if (u.pm == 32) { slice_store<false>(acc, u, wr, wc, fr, fq, slabs, nullptr); return; }
        const int col0 = u.pn * 256 + wc * 32 + 8 * fq;
        const float* gp = mod + (size_t)(u.pm >> 4) * NMOD + 5 * DM;
#pragma unroll
        for (int ai = 0; ai < 2; ++ai)
#pragma unroll
            for (int m = 0; m < 4; ++m) {
                const size_t ro = (size_t)(u.pm * 256 + ai * 128 + wr * 64 + m * 16 + fr) * DM;
#pragma unroll
                for (int bj = 0; bj < 2; ++bj) {
                    const int c = col0 + bj * 128;
                    const f32x4 g0 = *(const f32x4*)(gp + c), g1 = *(const f32x4*)(gp + c + 4);
                    const f32x4 x0 = *(const f32x4*)(x1i + ro + c), x1 = *(const f32x4*)(x1i + ro + c + 4);
                    acc[ai][bj][m][0] = x0 + g0 * acc[ai][bj][m][0]; acc[ai][bj][m][1] = x1 + g1 * acc[ai][bj][m][1];
                }
                asm volatile("" : "+v"(acc[ai][0][m][0]), "+v"(acc[ai][0][m][1]), "+v"(acc[ai][1][m][0]), "+v"(acc[ai][1][m][1]) :: "memory");
            }
        finish(acc, u, wr, wc, fr, fq);
    }
    __device__ __forceinline__ void fused(f32x4 (&acc)[2][2][4][2], const pg8::Unit& u, int wr, int wc, int fr, int fq, LAS unsigned char* lds) const {
        if (u.pm == 32) { slice_store<false>(acc, u, wr, wc, fr, fq, slabs, nullptr); return; }
        residual_dma(acc, x1i, (size_t)u.pm * 256, u.pn * 256 + wc * 32 + 8 * fq, mod + (size_t)(u.pm >> 4) * NMOD + 5 * DM, wr, wc, fr, fq, lds);
        finish(acc, u, wr, wc, fr, fq);
    }
};
struct EpiGU {
    static constexpr bool PERM = true, MIDK = false, AFTER_DRAIN = false;
    bf16_t* O;
    __device__ __forceinline__ void mid(f32x4 (&)[2][2][4][2], const pg8::Unit&, int, int, int, int) const {}
    __device__ __forceinline__ void operator()(const f32x4 (&acc)[2][2][4][2], const pg8::Unit& u, int wr, int wc, int fr, int fq) const {
        const int col0 = u.pn * 128 + wc * 32 + 8 * fq;
#pragma unroll
        for (int ai = 0; ai < 2; ++ai)
#pragma unroll
            for (int m = 0; m < 4; ++m) {
                const size_t row = (size_t)u.pm * 256 + ai * 128 + wr * 64 + m * 16 + fr;
                f32x4 o0, o1;
#pragma unroll
                for (int e = 0; e < 4; ++e) { const float g0 = acc[ai][0][m][0][e], g1 = acc[ai][0][m][1][e];
                    o0[e] = g0 * sigm(g0) * acc[ai][1][m][0][e]; o1[e] = g1 * sigm(g1) * acc[ai][1][m][1][e]; }
                *(v4u*)(O + row * DFF + col0) = pack8bf(o0, o1);
            }
    }
};

namespace att {
constexpr int NW = 8, QBLK = 32, KVBLK = 64, QB = NW * QBLK, D = 128, LDQ = 2048, LDO = 4096;
constexpr int SHM_V = KVBLK * D * 2, SHM_K = KVBLK * D * 2;
constexpr int LDS_BYTES = 2 * SHM_V + 2 * SHM_K + NW * 64 * 4;
constexpr int BIAS_OFF = LDS_BYTES;
constexpr float THR = 8.f;
constexpr float LOG2E = 1.4426950408889634f;
#define KSWZ(row, colB) ((row) * 256 + ((colB) ^ (((row) & 7) << 4)))
#define SBAR() __builtin_amdgcn_sched_barrier(0)
__device__ __forceinline__ int v_st(int k, int c) { const int kk = (k & ~0xC) | ((k & 4) << 1) | ((k & 8) >> 1); return ((kk >> 3) * 4 + (c >> 5)) * 512 + ((kk & 7) * 32 + (c & 31)) * 2; }
__device__ __forceinline__ int v_rd_base(int lane) { return ((lane & 3) << 3) | (((lane >> 2) & 3) << 6) | (((lane >> 4) & 1) << 5) | (((lane >> 5) & 1) << 8); }
constexpr int v_rd_off(int d0, int ks, int half) { return d0 * 512 + ks * 4096 + half * 2048; }
__device__ __forceinline__ int crow(int r, int hi) { return (r & 3) + 8 * (r >> 2) + 4 * hi; }
__device__ __forceinline__ unsigned cvtpk(float lo, float hi) { return cvt_pk_bf16(lo, hi); }
__device__ __forceinline__ bf16x8 load8(const bf16_t* p) { return *reinterpret_cast<const bf16x8*>(p); }
__device__ __forceinline__ int jlo(int qb) { const int j = 4 * qb - 8; return j > 0 ? j : 0; }
__device__ __forceinline__ void bias_tile(f32x16& p0, f32x16& p1, int dq, int dlo, const float* bl) {
    if (dlo - 63 >= 256) { const float bf = bl[319];
#pragma unroll
        for (int r = 0; r < 16; ++r) { p0[r] = fmaf(p0[r], ATT_SCALE, bf); p1[r] = fmaf(p1[r], ATT_SCALE, bf); }
    } else if (dlo + 31 <= 256) {
        const float* bq = bl + dq;
#pragma unroll
        for (int r = 0; r < 16; ++r) { const int c = (r & 3) + 8 * (r >> 2);
            p0[r] = fmaf(p0[r], ATT_SCALE, bq[63 - c]); p1[r] = fmaf(p1[r], ATT_SCALE, bq[31 - c]); }
    } else {
#pragma unroll
        for (int r = 0; r < 16; ++r) { const int c = (r & 3) + 8 * (r >> 2);
            int d0 = dq - c; d0 = d0 > 256 ? 256 : d0; int d1 = dq - c - 32; d1 = d1 > 256 ? 256 : d1;
            p0[r] = fmaf(p0[r], ATT_SCALE, bl[d0 + 63]); p1[r] = fmaf(p1[r], ATT_SCALE, bl[d1 + 63]); }
    }
}
__device__ __forceinline__ void partialSM(f32x16& p0, f32x16& p1, float& m_reg, float& mn, float& alpha) {
    float pmax = p0[0];
#pragma unroll
    for (int r = 1; r < 16; ++r) pmax = fmaxf(pmax, p0[r]);
#pragma unroll
    for (int r = 0; r < 16; ++r) pmax = fmaxf(pmax, p1[r]);
    { auto rr = __builtin_amdgcn_permlane32_swap(__float_as_uint(pmax), __float_as_uint(pmax), false, false);
      pmax = fmaxf(__uint_as_float(rr[0]), __uint_as_float(rr[1])); }
    if (__builtin_expect(__all((pmax - m_reg) <= THR), 1)) { mn = m_reg; alpha = 1.f; }
    else { mn = fmaxf(m_reg, pmax); alpha = __builtin_amdgcn_exp2f((m_reg - mn) * LOG2E); m_reg = mn; }
    const float mnL = -mn * LOG2E;
#pragma unroll
    for (int r = 0; r < 16; ++r) p0[r] = fmaf(p0[r], LOG2E, mnL);
#pragma unroll
    for (int r = 0; r < 16; ++r) p1[r] = fmaf(p1[r], LOG2E, mnL);
#pragma unroll
    for (int r = 0; r < 16; ++r) p0[r] = __builtin_amdgcn_exp2f(p0[r]);
}
__device__ __forceinline__ void finishSM(f32x16& p0, f32x16& p1, float alpha, float& l_reg, bf16x8& pa0, bf16x8& pa1, bf16x8& pa2, bf16x8& pa3) {
#pragma unroll
    for (int r = 0; r < 16; ++r) p1[r] = __builtin_amdgcn_exp2f(p1[r]);
    float ps = 0;
#pragma unroll
    for (int r = 0; r < 16; ++r) ps += p0[r];
#pragma unroll
    for (int r = 0; r < 16; ++r) ps += p1[r];
    { auto rr = __builtin_amdgcn_permlane32_swap(__float_as_uint(ps), __float_as_uint(ps), false, false);
      ps = __uint_as_float(rr[0]) + __uint_as_float(rr[1]); }
    l_reg = l_reg * alpha + ps;
#define PK4(P, B_, OUT) do { unsigned a0 = cvtpk(P[B_+0], P[B_+1]), a1 = cvtpk(P[B_+2], P[B_+3]);                          \
        unsigned b0 = cvtpk(P[B_+4], P[B_+5]), b1 = cvtpk(P[B_+6], P[B_+7]);                                             \
        auto r0 = __builtin_amdgcn_permlane32_swap(a0, b0, false, false); auto r1 = __builtin_amdgcn_permlane32_swap(a1, b1, false, false); \
        v4u w = {r0[0], r1[0], r0[1], r1[1]}; OUT = *reinterpret_cast<bf16x8*>(&w); } while (0)
    PK4(p0, 0, pa0); PK4(p0, 8, pa1); PK4(p1, 0, pa2); PK4(p1, 8, pa3);
#undef PK4
}
template <int KB>
__device__ __forceinline__ void qkt(f32x16& p0, f32x16& p1, const char* K_lds, int r32, int hi, const bf16x8* qr, bool act) {
    if (!act) { const float NEG = -__builtin_inff();
#pragma unroll
        for (int r = 0; r < 16; ++r) { p0[r] = NEG; p1[r] = NEG; } return; }
    p0 = f32x16{}; p1 = f32x16{};
    const char* kb[4];
#pragma unroll
    for (int dd = 0; dd < 4; ++dd) kb[dd] = K_lds + KB * SHM_K + KSWZ(r32, (dd * 16 + hi * 8) * 2);
#pragma unroll
    for (int d0 = 0; d0 < 8; ++d0) { const char* a = kb[d0 & 3] + (d0 >> 2) * 128;
        bf16x8 b0 = *reinterpret_cast<const bf16x8*>(a);
        bf16x8 b1 = *reinterpret_cast<const bf16x8*>(a + 32 * 256);
        p0 = __builtin_amdgcn_mfma_f32_32x32x16_bf16(b0, qr[d0], p0, 0, 0, 0);
        p1 = __builtin_amdgcn_mfma_f32_32x32x16_bf16(b1, qr[d0], p1, 0, 0, 0); }
}
template <int VB>
__device__ __forceinline__ void pv_tile(f32x16* o, int vb0, bf16x8 pa0, bf16x8 pa1, bf16x8 pa2, bf16x8 pa3, bool act) {
    if (!act) return;
#define TRRD(dst, off) asm volatile("ds_read_b64_tr_b16 %0, %1 offset:%2" : "=&v"(dst) : "v"(vb0), "i"(off) : "memory")
#define PV_D0(d0) do { s16x4 l0, l1, l2, l3, h0, h1, h2, h3; constexpr int b_ = VB * SHM_V + v_rd_off(d0, 0, 0); \
        TRRD(l0, b_); TRRD(h0, b_ + 2048); TRRD(l1, b_ + 4096); TRRD(h1, b_ + 6144); TRRD(l2, b_ + 8192); TRRD(h2, b_ + 10240); TRRD(l3, b_ + 12288); TRRD(h3, b_ + 14336); \
        asm volatile("s_waitcnt lgkmcnt(0)" ::: "memory"); SBAR();   \
        o[d0] = __builtin_amdgcn_mfma_f32_32x32x16_bf16(pa0, (bf16x8){l0[0], l0[1], l0[2], l0[3], h0[0], h0[1], h0[2], h0[3]}, o[d0], 0, 0, 0);   \
        o[d0] = __builtin_amdgcn_mfma_f32_32x32x16_bf16(pa1, (bf16x8){l1[0], l1[1], l1[2], l1[3], h1[0], h1[1], h1[2], h1[3]}, o[d0], 0, 0, 0);   \
        o[d0] = __builtin_amdgcn_mfma_f32_32x32x16_bf16(pa2, (bf16x8){l2[0], l2[1], l2[2], l2[3], h2[0], h2[1], h2[2], h2[3]}, o[d0], 0, 0, 0);   \
        o[d0] = __builtin_amdgcn_mfma_f32_32x32x16_bf16(pa3, (bf16x8){l3[0], l3[1], l3[2], l3[3], h3[0], h3[1], h3[2], h3[3]}, o[d0], 0, 0, 0); } while (0)
    PV_D0(0); PV_D0(1); PV_D0(2); PV_D0(3);
#undef PV_D0
#undef TRRD
}
struct BlockRef { const bf16_t* Q; const bf16_t* K; const bf16_t* V; bf16_t* O; int qb; int h; };
struct Seam { bf16x8 qr[8]; bf16x8 st_v0, st_v1, st_k0, st_k1; };
#define ROW(p, k0, rr) ((p) + (size_t)((k0) + (rr)) * LDQ + sc)
#define VMW() asm volatile("s_waitcnt vmcnt(0)" ::: "memory")
#define VMWN(n) asm volatile("s_waitcnt vmcnt(%0)" :: "i"(n) : "memory")
#define SLOAD_H(Kp, Vp, k0) do { S.st_v0 = load8(ROW(Vp, k0, sr)); S.st_v1 = load8(ROW(Vp, k0, 32 + sr));              \
                         S.st_k0 = load8(ROW(Kp, k0, sr)); S.st_k1 = load8(ROW(Kp, k0, 32 + sr)); } while (0)
#define SWRITE_HK(bf) do { *(bf16x8*)(K_lds + (bf) * SHM_K + kws) = S.st_k0; *(bf16x8*)(K_lds + (bf) * SHM_K + kws + 32 * 256) = S.st_k1; } while (0)
#define SWRITE_HV(bf) do { *(bf16x8*)(V_lds + (bf) * SHM_V + vst0) = S.st_v0; *(bf16x8*)(V_lds + (bf) * SHM_V + vst1) = S.st_v1; } while (0)
#define SWRITE_H(bf) do { SWRITE_HV(bf); SWRITE_HK(bf); } while (0)
__device__ __forceinline__ void att_prime(const BlockRef& cur, char* lds, Seam& S) {
    const int tid = threadIdx.x, wid = __builtin_amdgcn_readfirstlane(tid >> 6), lane = tid & 63, r32 = lane & 31, hi = lane >> 5;
    const int sr = tid >> 4, sc = (tid & 15) * 8, kws = KSWZ(sr, sc * 2); char* K_lds = lds + 2 * SHM_V;
    const int kb0 = jlo(cur.qb) * KVBLK;
#pragma unroll
    for (int d0 = 0; d0 < 8; ++d0) S.qr[d0] = load8(cur.Q + (size_t)(wid * QBLK + r32) * LDQ + d0 * 16 + hi * 8);
    SLOAD_H(cur.K, cur.V, kb0); VMW(); SWRITE_HK(0);
    __syncthreads();
}
__device__ __forceinline__ void att_block(const BlockRef& cur, const BlockRef& nxt, char* lds, Seam& S) {
    const int tid = threadIdx.x, wid = __builtin_amdgcn_readfirstlane(tid >> 6), lane = tid & 63, r32 = lane & 31, hi = lane >> 5;
    const int j_lo = jlo(cur.qb), j_hi = 4 * cur.qb + 4;
    const int NT = j_hi - j_lo;
    const int kbn = jlo(nxt.qb) * KVBLK;
    const int cq = 4 * cur.qb + (wid >> 1);
    const int qlo = cur.qb * QB + wid * QBLK, qpos = qlo + r32;
    const float* bl = (const float*)(lds + BIAS_OFF) + cur.h * 320;
    char* V_lds = lds; char* K_lds = lds + 2 * SHM_V;
    float* ws = (float*)(lds + 2 * SHM_V + 2 * SHM_K) + wid * 64; float* li_l = ws, * al_l = ws + 32;
    float m_reg = -1e30f, l_reg = 0; f32x16 o[4] = {};
    const int sr = tid >> 4, sc = (tid & 15) * 8, vst0 = v_st(sr, sc), vst1 = v_st(32 + sr, sc), kws = KSWZ(sr, sc * 2);
    const int vb0 = (int)(uintptr_t)V_lds + v_rd_base(lane);
    const bf16_t* Kh = cur.K; const bf16_t* Vh = cur.V;
#define RESC(a) do { if (__any((a) < 1.f)) { if (hi == 0) al_l[r32] = (a); asm volatile("s_waitcnt lgkmcnt(0)" ::: "memory");              \
                     for (int d_ = 0; d_ < 4; ++d_) for (int r = 0; r < 16; ++r) o[d_][r] *= al_l[crow(r, hi)]; } } while (0)
#define KBASE(t) ((j_lo + (t)) * KVBLK)
#define ACT(t) ((j_lo + (t)) <= cq && (j_lo + (t)) + 8 >= cq)
#define BIAST(P0_, P1_, t) do { if (ACT(t)) bias_tile(P0_, P1_, qpos - KBASE(t) - 4 * hi, qlo - KBASE(t), bl); } while (0)
    constexpr int NQL = 8;
#define SEAM_K0() do { VMWN(NQL); SWRITE_HK(0); SBAR(); } while (0)
    f32x16 pA0, pA1, pB0, pB1; float mnA, mnB, alA, alB; bf16x8 pa0, pa1, pa2, pa3;
    SWRITE_HV(0); SBAR();
    if (NT > 1) { SLOAD_H(Kh, Vh, KBASE(1)); }
    SBAR(); qkt<0>(pA0, pA1, K_lds, r32, hi, S.qr, ACT(0));
    BIAST(pA0, pA1, 0); partialSM(pA0, pA1, m_reg, mnA, alA);
    if (NT > 1) { VMW(); SWRITE_H(1); }
    __syncthreads();
#define HALF_STEP(PX0, PX1, mnX, alX, PY0, PY1, alY, t, KB, VB, SB) do {                                                      \
        SBAR(); qkt<KB>(PX0, PX1, K_lds, r32, hi, S.qr, ACT(t));                                             \
        finishSM(PY0, PY1, alY, l_reg, pa0, pa1, pa2, pa3); SBAR();                                                           \
        if ((t) + 1 < NT) { SLOAD_H(Kh, Vh, KBASE((t) + 1)); SBAR(); }                                               \
        pv_tile<VB>(o, vb0, pa0, pa1, pa2, pa3, ACT((t) - 1)); BIAST(PX0, PX1, (t)); partialSM(PX0, PX1, m_reg, mnX, alX);                                        \
        __syncthreads();                                                                                                      \
        if ((t) + 1 < NT) { VMW(); SWRITE_H(SB); }                                                                          \
        RESC(alX); __syncthreads(); } while (0)
    for (int t = 1; t + 1 < NT; t += 2) {
        HALF_STEP(pB0, pB1, mnB, alB, pA0, pA1, alA, t, 1, 0, 0);
        HALF_STEP(pA0, pA1, mnA, alA, pB0, pB1, alB, t + 1, 0, 1, 1);
    }
    const bool even = (NT & 1) == 0;
    if (even) { SBAR(); qkt<1>(pB0, pB1, K_lds, r32, hi, S.qr, ACT(NT - 1)); SBAR(); }
    SLOAD_H(nxt.K, nxt.V, kbn); SBAR();
#pragma unroll
    for (int d0 = 0; d0 < 8; ++d0) S.qr[d0] = load8(nxt.Q + (size_t)(wid * QBLK + r32) * LDQ + d0 * 16 + hi * 8);
    SBAR();
    finishSM(pA0, pA1, alA, l_reg, pa0, pa1, pa2, pa3); SBAR();
    pv_tile<0>(o, vb0, pa0, pa1, pa2, pa3, ACT(even ? NT - 2 : NT - 1));
    if (even) { BIAST(pB0, pB1, NT - 1); partialSM(pB0, pB1, m_reg, mnB, alB); __syncthreads(); RESC(alB);
        finishSM(pB0, pB1, alB, l_reg, pa0, pa1, pa2, pa3); SBAR(); pv_tile<1>(o, vb0, pa0, pa1, pa2, pa3, ACT(NT - 1)); }
    SBAR(); SEAM_K0();
    if (hi == 0) li_l[r32] = l_reg; asm volatile("s_waitcnt lgkmcnt(0)" ::: "memory");
    float rli[16];
#pragma unroll
    for (int r = 0; r < 16; ++r) rli[r] = __builtin_amdgcn_rcpf(li_l[crow(r, hi)]);
    bf16_t* Ow = cur.O + (size_t)(wid * QBLK) * LDO;
#pragma unroll
    for (int r = 0; r < 16; ++r) { const int orow = crow(r, hi);
#pragma unroll
        for (int d0 = 0; d0 < 4; ++d0) { const float v = o[d0][r] * rli[r];
            const float vn = __shfl_xor(v, 1);
            if ((r32 & 1) == 0) *(unsigned*)(Ow + (size_t)orow * LDO + d0 * 32 + r32) = cvtpk(v, vn); } }
    __syncthreads();
#undef RESC
#undef KBASE
#undef ACT
#undef BIAST
#undef SEAM_K0
#undef HALF_STEP
}
#undef ROW
#undef VMW
#undef VMWN
#undef SLOAD_H
#undef SWRITE_HK
#undef SWRITE_HV
#undef SWRITE_H
#undef SBAR
#undef KSWZ
}

#define XB_TMO      128
#define XB_XCNT(j)  (256  + 64 * (j))
#define XB_XSUB(j)  (1280 + 64 * (j))
#define XB_XGEN(j)  (2304 + 64 * (j))
#define XB_TOP      3328
#define XB_TOPGEN   3392
#define XCD_BAR_WORDS 3456
#define XB_SPIN_CAP (1u << 18)
__device__ __forceinline__ unsigned xb_ld(unsigned* p)              { return __hip_atomic_load(p, __ATOMIC_RELAXED, __HIP_MEMORY_SCOPE_AGENT); }
__device__ __forceinline__ unsigned xb_add(unsigned* p, unsigned v) { return __hip_atomic_fetch_add(p, v, __ATOMIC_RELAXED, __HIP_MEMORY_SCOPE_AGENT); }
__device__ __forceinline__ unsigned xb_xcc_id() { return (unsigned)__builtin_amdgcn_s_getreg((3 << 11) | 20) & 0xFu; }
#define XB_SPIN(cond, bar) do { unsigned _sp = 0; while (cond) { __builtin_amdgcn_s_sleep(1); \
    if ((++_sp & 255u) == 0u) { if (xb_ld(&(bar)[XB_TMO])) break; if (_sp > XB_SPIN_CAP) { atomicAdd(&(bar)[XB_TMO], 1u); break; } } } } while (0)
struct XcdBarrier { unsigned* bar; unsigned x; volatile LAS unsigned* st; };
__device__ __forceinline__ XcdBarrier xcd_barrier_post(unsigned* bar, volatile LAS unsigned* st) {
    XcdBarrier b; b.bar = bar; b.x = xb_xcc_id(); b.st = st;
    if (threadIdx.x == 0) (void)xb_add(&bar[XB_XCNT(b.x)], 1u);
    return b;
}
__device__ __forceinline__ void xcd_barrier_complete(unsigned* bar, unsigned x, unsigned& nloc, unsigned& nx) {
    const unsigned G = gridDim.x * gridDim.y * gridDim.z;
    unsigned sum, cnt, mine, sp = 0u;
    for (;;) {
        sum = 0u; cnt = 0u; mine = 0u;
#pragma unroll
        for (unsigned j = 0; j < 16; ++j) { const unsigned c = xb_ld(&bar[XB_XCNT(j)]); sum += c; cnt += (c > 0u) ? 1u : 0u; mine = (j == x) ? c : mine; }
        if (sum == G) break;
        __builtin_amdgcn_s_sleep(1);
        if ((++sp & 255u) == 0u) { if (xb_ld(&bar[XB_TMO])) break; if (sp > XB_SPIN_CAP) { atomicAdd(&bar[XB_TMO], 1u); break; } }
    }
    nloc = mine > 0u ? mine : 1u; nx = cnt > 0u ? cnt : 1u;
}
__device__ __forceinline__ void xcd_barrier(const XcdBarrier& b) {
    asm volatile("s_waitcnt vmcnt(0)" ::: "memory");
    __syncthreads();
    if (threadIdx.x == 0) {
        unsigned* bar = b.bar;
        __builtin_amdgcn_s_waitcnt(0);
        unsigned nloc = b.st[0], nx = b.st[1];
        if (nloc == 0u) { xcd_barrier_complete(bar, b.x, nloc, nx); b.st[0] = nloc; b.st[1] = nx; }
        const unsigned old = xb_add(&bar[XB_XSUB(b.x)], 1u);
        const unsigned gen = old / nloc;
        if (old + 1u == (gen + 1u) * nloc) {
            __builtin_amdgcn_fence(__ATOMIC_RELEASE, "agent");
            asm volatile("s_waitcnt vmcnt(0)" ::: "memory");
            const unsigned og = xb_add(&bar[XB_TOP], 1u);
            const unsigned tg = og / nx;
            if (og + 1u == (tg + 1u) * nx) xb_add(&bar[XB_TOPGEN], 1u);
            else XB_SPIN(xb_ld(&bar[XB_TOPGEN]) == tg, bar);
            __builtin_amdgcn_fence(__ATOMIC_ACQUIRE, "agent");
            xb_add(&bar[XB_XGEN(b.x)], 1u);
            asm volatile("s_waitcnt vmcnt(0)" ::: "memory");
        } else {
            XB_SPIN(xb_ld(&bar[XB_XGEN(b.x)]) == gen, bar);
            __builtin_amdgcn_fence(__ATOMIC_ACQUIRE, "agent");
            asm volatile("s_waitcnt vmcnt(0)" ::: "memory");
        }
    }
    __syncthreads();
}

struct Args { const float* in[26]; float* out; unsigned char* ws; int ph_lo, ph_hi; };
__device__ __forceinline__ const float* arg_ptr(int k) { int o = k * 8; asm volatile("" : "+s"(o)); return *(const float* const*)((const char*)__builtin_amdgcn_kernarg_segment_ptr() + o); }
struct Frame {
    LAS unsigned char* lds;
    int tid, lane, wave, vcu, G;
    float* out; unsigned char* ws;
    __device__ __forceinline__ const float* x_prompt() const { return arg_ptr(0); }
    __device__ __forceinline__ const float* x_sample() const { return arg_ptr(1); }
    __device__ __forceinline__ const float* c_prompt() const { return arg_ptr(2); }
    __device__ __forceinline__ const float* c_sample() const { return arg_ptr(3); }
    __device__ __forceinline__ const float* cache_k() const { return arg_ptr(4); }
    __device__ __forceinline__ const float* cache_v() const { return arg_ptr(5); }
    __device__ __forceinline__ const float* st_h() const { return arg_ptr(6); }
    __device__ __forceinline__ const float* st_conv() const { return arg_ptr(7); }
    __device__ __forceinline__ const float* w_mod() const { return arg_ptr(8); }
    __device__ __forceinline__ const float* b_mod() const { return arg_ptr(9); }
    __device__ __forceinline__ const float* w_in() const { return arg_ptr(10); }
    __device__ __forceinline__ const float* rel_bias() const { return arg_ptr(11); }
    __device__ __forceinline__ const float* conv_w() const { return arg_ptr(12); }
    __device__ __forceinline__ const float* conv_b() const { return arg_ptr(13); }
    __device__ __forceinline__ const float* w_rg_a() const { return arg_ptr(14); }
    __device__ __forceinline__ const float* b_rg_a() const { return arg_ptr(15); }
    __device__ __forceinline__ const float* w_rg_x() const { return arg_ptr(16); }
    __device__ __forceinline__ const float* b_rg_x() const { return arg_ptr(17); }
    __device__ __forceinline__ const float* rg_lambda() const { return arg_ptr(18); }
    __device__ __forceinline__ const float* w_pa() const { return arg_ptr(19); }
    __device__ __forceinline__ const float* w_pr() const { return arg_ptr(20); }
    __device__ __forceinline__ const float* w_out() const { return arg_ptr(21); }
    __device__ __forceinline__ const float* w_gate() const { return arg_ptr(22); }
    __device__ __forceinline__ const float* w_up() const { return arg_ptr(23); }
    __device__ __forceinline__ const float* w_down() const { return arg_ptr(24); }
    __device__ __forceinline__ const float* fng() const { return arg_ptr(25); }
    __device__ __forceinline__ float* mod() const { return (float*)(ws + WS_MOD); }
    __device__ __forceinline__ float* x1() const { return (float*)(ws + WS_OY); }
    __device__ __forceinline__ float* slab4() const { return (float*)(ws + WS_SLAB4); }
    __device__ __forceinline__ float* slab6() const { return (float*)(ws + WS_SLAB6); }
    __device__ __forceinline__ float* slab9() const { return (float*)(ws + WS_SLAB9); }
    __device__ __forceinline__ bf16_t* Win_t() const { return (bf16_t*)(ws + WS_WIN); }
    __device__ __forceinline__ bf16_t* Wproj_t() const { return (bf16_t*)(ws + WS_WPROJ); }
    __device__ __forceinline__ bf16_t* Wout_t() const { return (bf16_t*)(ws + WS_WOUT); }
    __device__ __forceinline__ bf16_t* Wgu_t() const { return (bf16_t*)(ws + WS_WGU); }
    __device__ __forceinline__ bf16_t* Wdn_t() const { return (bf16_t*)(ws + WS_WDN); }
    __device__ __forceinline__ bf16_t* Wrg_t() const { return (bf16_t*)(ws + WS_WRG); }
    __device__ __forceinline__ bf16_t* H1() const { return (bf16_t*)(ws + WS_H1); }
    __device__ __forceinline__ bf16_t* Qb() const { return (bf16_t*)(ws + WS_Q); }
    __device__ __forceinline__ bf16_t* Kb() const { return (bf16_t*)(ws + WS_K); }
    __device__ __forceinline__ bf16_t* Vb() const { return (bf16_t*)(ws + WS_V); }
    __device__ __forceinline__ bf16_t* Ub() const { return (bf16_t*)(ws + WS_U); }
    __device__ __forceinline__ bf16_t* Gb() const { return (bf16_t*)(ws + WS_G); }
    __device__ __forceinline__ bf16_t* SAb() const { return (bf16_t*)(ws + WS_SA); }
    __device__ __forceinline__ bf16_t* SRb() const { return (bf16_t*)(ws + WS_SR); }
    __device__ __forceinline__ bf16_t* OY() const { return (bf16_t*)(ws + WS_OY); }
    __device__ __forceinline__ bf16_t* MG() const { return (bf16_t*)(ws + WS_MERGED); }
    __device__ __forceinline__ bf16_t* ACT() const { return (bf16_t*)(ws + WS_ACT); }
    __device__ __forceinline__ gu64* gran() const { return (gu64*)(ws + WS_GRAN); }
    __device__ __forceinline__ void refresh() { int t = threadIdx.x; asm volatile("" : "+v"(t)); tid = t; lane = t & 63; wave = __builtin_amdgcn_readfirstlane(t >> 6); }
};

__device__ __forceinline__ void xpose_item(const float* W, int N, bf16_t* WT, size_t ldo, int k0, int n0, int drow0, int dcol0, LAS float* scr, int lane) {
#pragma unroll 8
    for (int i = 0; i < 32; ++i) { const int kk = 2 * i + (lane >> 5); scr[kk * 33 + (lane & 31)] = W[(size_t)(k0 + kk) * N + n0 + (lane & 31)]; }
    LDS_WAIT(); asm volatile("" ::: "memory");
    const int c = lane & 7;
#pragma unroll
    for (int j = 0; j < 4; ++j) { const int n = (lane >> 3) + 8 * j; const LAS float* s = scr + (8 * c) * 33 + n;
        v4u o; o.x = pk2(s[0 * 33], s[1 * 33]); o.y = pk2(s[2 * 33], s[3 * 33]); o.z = pk2(s[4 * 33], s[5 * 33]); o.w = pk2(s[6 * 33], s[7 * 33]);
        *(GAS v4u*)(WT + (size_t)(drow0 + n) * ldo + dcol0 + 8 * c) = o; }
    LDS_WAIT(); asm volatile("" ::: "memory");
}
__device__ __forceinline__ void norm_regs_bf16(const f32x4 (&v)[8], const float* shift, const float* scale, bf16_t* orow, int lane) {
    f32x4 sc[8], sh[8];
#pragma unroll
    for (int j = 0; j < 8; ++j) { sc[j] = *((const GAS f32x4*)scale + lane + 64 * j); sh[j] = *((const GAS f32x4*)shift + lane + 64 * j); }
    float s = 0.f;
#pragma unroll
    for (int j = 0; j < 8; ++j) s += (v[j].x * v[j].x + v[j].y * v[j].y) + (v[j].z * v[j].z + v[j].w * v[j].w);
    const float rinv = rsqrtf(wave_sum(s) * (1.f / DM) + EPS);
    GAS v2u* o8 = (GAS v2u*)orow + lane;
#pragma unroll
    for (int j = 0; j < 8; ++j) { const f32x4 y = v[j] * rinv * (sc[j] + 1.f) + sh[j]; v2u w; w.x = pk2(y.x, y.y); w.y = pk2(y.z, y.w); o8[64 * j] = w; }
}
__device__ __forceinline__ void load_row(f32x4 (&v)[8], const float* row, int lane) {
    const GAS f32x4* xr = (const GAS f32x4*)row + lane;
#pragma unroll
    for (int j = 0; j < 8; ++j) v[j] = xr[64 * j];
}
__device__ __forceinline__ void phase0(Frame& F, bool dry = false) {
    const float* p_cp = F.c_prompt(); const float* p_cs = F.c_sample(); const float* p_wm = F.w_mod(); const float* p_bm = F.b_mod(); float* p_mod = F.mod(); const float* p_win = F.w_in(); bf16_t* p_wint = F.Win_t();
    { gu64* g = F.gran(); for (size_t i = (size_t)F.vcu * 512 + F.tid; i < 3 * 131072; i += (size_t)F.G * 512) g[i] = 0ull; }
    LAS float* sc = (LAS float*)(F.lds);
    LAS float* red = (LAS float*)(F.lds + 8192);
    for (int it = F.vcu; it < 768; it += F.G) {
        const int nc = it % 48, ks = it / 48;
        for (int i = F.tid; i < 1280; i += 512) { const int b = i >> 7, k = ks * 128 + (i & 127);
            const float cv = b < 2 ? p_cp[b * DM + k] : p_cs[(b - 2) * DM + k];
            sc[i] = cv * sigm(cv); }
        __syncthreads();
        f32x4 acc[10];
#pragma unroll
        for (int b = 0; b < 10; ++b) acc[b] = (f32x4){0.f, 0.f, 0.f, 0.f};
        const float* wp = p_wm + (size_t)(ks * 128 + F.wave * 16) * NMOD + nc * 256 + 4 * F.lane;
#pragma unroll 4
        for (int kk = 0; kk < 16; ++kk) { const f32x4 w = *(const GAS f32x4*)(wp + (size_t)kk * NMOD);
#pragma unroll
            for (int b = 0; b < 10; ++b) { const float s = sc[b * 128 + F.wave * 16 + kk]; acc[b] += w * s; } }
#pragma unroll
        for (int b = 0; b < 10; ++b) *(LAS f32x4*)(red + (F.wave * 10 + b) * 256 + 4 * F.lane) = acc[b];
        __syncthreads();
        for (int o = F.tid; o < 2560; o += 512) { const int b = o >> 8, col = o & 255; float s = 0.f;
#pragma unroll
            for (int w = 0; w < 8; ++w) s += red[(w * 10 + b) * 256 + col];
            if (ks == 0) s += p_bm[nc * 256 + col];
            if (!dry) atomicAdd(p_mod + (size_t)b * NMOD + nc * 256 + col, s); }
        __syncthreads();
    }
    LAS float* scr = (LAS float*)(F.lds + F.wave * 16384);
    const int gw = F.vcu * NWAVES + F.wave, NGW = F.G * NWAVES;
    for (int it = gw; it < 32 * 448; it += NGW) { const int kb = it / 448, nb = it % 448;
        xpose_item(p_win, NIN, p_wint, DM, kb * 64, nb * 32, nb * 32, kb * 64, scr, F.lane); }
}
constexpr int I_P = 32 * 64, I_G = 32 * 176, I_D = 88 * 64, I_R = 256;
constexpr int NITEMS_A = 3 * I_P + I_R, NITEMS_B = 2 * I_G + I_D;
__device__ __forceinline__ void conv_item_a(Frame& F, int r, LAS float* scr) {
    if (r < I_P) { const int kb = r / 64, nb = r % 64; xpose_item(F.w_pa(), DM, F.Wproj_t(), 4096, kb * 64, nb * 32, nb * 32, kb * 64, scr, F.lane); return; } r -= I_P;
    if (r < I_P) { const int kb = r / 64, nb = r % 64; xpose_item(F.w_pr(), DM, F.Wproj_t(), 4096, kb * 64, nb * 32, nb * 32, 2048 + kb * 64, scr, F.lane); return; } r -= I_P;
    if (r < I_P) { const int kb = r / 64, nb = r % 64; xpose_item(F.w_out(), DM, F.Wout_t(), DM, kb * 64, nb * 32, nb * 32, kb * 64, scr, F.lane); return; } r -= I_P;
    { const int mat = r >> 3, sub = r & 7, kb = sub >> 2, nb = sub & 3;
      const float* src = (mat < 16 ? F.w_rg_a() : F.w_rg_x()) + (size_t)(mat & 15) * 16384;
      xpose_item(src, 128, F.Wrg_t() + (size_t)mat * 16384, 128, kb * 64, nb * 32, nb * 32, kb * 64, scr, F.lane); }
}
__device__ __forceinline__ void conv_item_b(Frame& F, int r, LAS float* scr) {
    if (r < I_G) { const int kb = r / 176, nb = r % 176, n0 = nb * 32; xpose_item(F.w_gate(), DFF, F.Wgu_t(), DM, kb * 64, n0, (n0 >> 7) * 256 + (n0 & 127), kb * 64, scr, F.lane); return; } r -= I_G;
    if (r < I_G) { const int kb = r / 176, nb = r % 176, n0 = nb * 32; xpose_item(F.w_up(), DFF, F.Wgu_t(), DM, kb * 64, n0, (n0 >> 7) * 256 + 128 + (n0 & 127), kb * 64, scr, F.lane); return; } r -= I_G;
    { const int kb = r / 64, nb = r % 64; xpose_item(F.w_down(), DM, F.Wdn_t(), DFF, kb * 64, nb * 32, nb * 32, kb * 64, scr, F.lane); }
}
__device__ __forceinline__ void phase1(Frame& F) {
    const float* p_xp = F.x_prompt(); const float* p_xs = F.x_sample(); const float* p_mod = F.mod(); bf16_t* p_H1 = F.H1(); const float* p_sl6 = F.slab6(); const float* p_sl9 = F.slab9(); float* p_x1 = F.x1(); const float* p_fng = F.fng();
    LAS float* scr = (LAS float*)(F.lds + F.wave * 16384);
    const int gw = F.vcu * NWAVES + F.wave, NGW = F.G * NWAVES;
    for (int it = gw; it < NITEMS_A; it += NGW) conv_item_a(F, it, scr);
    for (int m = gw; m < MPAD; m += NGW) {
        bf16_t* orow = p_H1 + (size_t)m * DM;
        if (m >= MV) { GAS v2u* o8 = (GAS v2u*)orow + F.lane;
#pragma unroll
            for (int j = 0; j < 8; ++j) o8[64 * j] = (v2u){0u, 0u};
            continue; }
        const float* xrow = m < MP ? p_xp + (size_t)m * DM : p_xs + (size_t)(m - MP) * DM;
        const int seq = m < MP ? (m >> 12) : 2 + ((m - MP) >> 4);
        const float* md = p_mod + (size_t)seq * NMOD;
        f32x4 v[8]; load_row(v, xrow, F.lane);
        norm_regs_bf16(v, md, md + DM, orow, F.lane);
    }
}
__device__ __forceinline__ void phase_norm2s(Frame& F, int gw, int NGW, unsigned* ready) {
    const float* p_xs = F.x_sample(); const float* p_mod = F.mod(); bf16_t* p_H1 = F.H1(); const float* p_sl6 = F.slab6(); float* p_x1 = F.x1();
    for (int r = gw; r < MS; r += NGW) { const int m = MP + r;
        const float* md = p_mod + (size_t)(2 + (r >> 4)) * NMOD;
        f32x4 v[8], a[8]; load_row(v, p_xs + (size_t)r * DM, F.lane); load_row(a, p_sl6 + (size_t)r * DM, F.lane);
#pragma unroll 5
        for (int k = 1; k < NSL6; ++k) { f32x4 t[8]; load_row(t, p_sl6 + (size_t)(k * 128 + r) * DM, F.lane);
#pragma unroll
            for (int j = 0; j < 8; ++j) a[j] += t[j]; }
        GAS f32x4* xo = (GAS f32x4*)(p_x1 + (size_t)m * DM) + F.lane;
#pragma unroll
        for (int j = 0; j < 8; ++j) { const f32x4 g = *((const GAS f32x4*)(md + 2 * DM) + F.lane + 64 * j); v[j] = v[j] + g * a[j]; xo[64 * j] = v[j]; }
        norm_regs_bf16(v, md + 3 * DM, md + 4 * DM, p_H1 + (size_t)m * DM, F.lane);
        asm volatile("s_waitcnt vmcnt(0)" ::: "memory");
        __builtin_amdgcn_fence(__ATOMIC_RELEASE, "agent");
        asm volatile("s_waitcnt vmcnt(0)" ::: "memory");
        if (F.lane == 0) __hip_atomic_fetch_add(ready, 1u, __ATOMIC_RELAXED, __HIP_MEMORY_SCOPE_AGENT);
    }
}
__device__ __forceinline__ void phase_finals(Frame& F) {
    const float* p_mod = F.mod(); const float* p_sl9 = F.slab9(); const float* p_x1 = F.x1(); const float* p_fng = F.fng();
    LAS float* part = (LAS float*)F.lds;
    LAS float* red = part + 8 * DM;
    for (int r = F.vcu; r < MS; r += F.G) { const int m = MP + r;
        f32x4 a[8];
#pragma unroll
        for (int j = 0; j < 8; ++j) a[j] = (f32x4){0.f, 0.f, 0.f, 0.f};
        f32x4 t[3][8];
#pragma unroll
        for (int q = 0; q < 3; ++q) { const int k = F.wave + 8 * q; if (k < NSL9) load_row(t[q], p_sl9 + (size_t)(k * 128 + r) * DM, F.lane); }
#pragma unroll
        for (int q = 0; q < 3; ++q) { const int k = F.wave + 8 * q; if (k < NSL9) {
#pragma unroll
            for (int j = 0; j < 8; ++j) a[j] += t[q][j]; } }
#pragma unroll
        for (int j = 0; j < 8; ++j) *(LAS f32x4*)(part + F.wave * DM + 4 * (F.lane + 64 * j)) = a[j];
        __syncthreads();
        const int c = 256 * F.wave + 4 * F.lane;
        f32x4 sacc = *(const LAS f32x4*)(part + c);
#pragma unroll
        for (int w2 = 1; w2 < 8; ++w2) sacc += *(const LAS f32x4*)(part + w2 * DM + c);
        const float* md = p_mod + (size_t)(2 + (r >> 4)) * NMOD + 5 * DM;
        const f32x4 v = *(const GAS f32x4*)(p_x1 + (size_t)m * DM + c) + *(const GAS f32x4*)(md + c) * sacc;
        float ss = wave_sum((v.x * v.x + v.y * v.y) + (v.z * v.z + v.w * v.w));
        if (F.lane == 0) red[F.wave] = ss;
        __syncthreads();
        float tot = 0.f;
#pragma unroll
        for (int w2 = 0; w2 < 8; ++w2) tot += red[w2];
        const float rinv = rsqrtf(tot * (1.f / DM) + EPS);
        *(GAS f32x4*)(F.out + (size_t)m * DM + c) = v * rinv * *(const GAS f32x4*)(p_fng + c);
        __syncthreads();
    }
}
__device__ __forceinline__ void phase_mgs(Frame& F, unsigned* ready) {
    static_assert(NSL4 == 32, "phase_mgs: 4 lanes x 8 slabs");
    const GAS f32x4* src = (const GAS f32x4*)F.slab4(); GAS v2u* dst = (GAS v2u*)(F.MG() + (size_t)MP * DM);
    for (int i = F.vcu * 512 + F.tid; i < 128 * DM; i += F.G * 512) { const int o = i >> 2, q = i & 3;
        f32x4 t[8];
#pragma unroll
        for (int k = 0; k < 8; ++k) t[k] = src[(size_t)(8 * q + k) * (128 * DM / 4) + o];
        f32x4 a = (t[0] + t[1]) + (t[2] + t[3]) + ((t[4] + t[5]) + (t[6] + t[7]));
#pragma unroll
        for (int e = 0; e < 4; ++e) { a[e] += __shfl_xor(a[e], 1); a[e] += __shfl_xor(a[e], 2); }
        if (q == 0) { v2u w; w.x = pk2(a.x, a.y); w.y = pk2(a.z, a.w); dst[o] = w; } }
    asm volatile("s_waitcnt vmcnt(0)" ::: "memory"); __syncthreads();
    if (F.tid == 0) { __builtin_amdgcn_fence(__ATOMIC_RELEASE, "agent"); asm volatile("s_waitcnt vmcnt(0)" ::: "memory"); __hip_atomic_fetch_add(ready, 1u, __ATOMIC_RELAXED, __HIP_MEMORY_SCOPE_AGENT); }
}

constexpr int RG_WL = 4352, RG_W = 34816, RG_TOT = 104448, RG_PRE = 112640, RG_HIN = 120832, RG_TAB = 121344;
__device__ __forceinline__ float gran_poll(gu64* g) {
    unsigned spins = 0;
    for (;;) { const unsigned long long x = __hip_atomic_load(g, RLX_AGENT); if ((unsigned)(x >> 32) == 1u) return __uint_as_float((unsigned)x);
        __builtin_amdgcn_s_sleep(1); if (++spins > (1u << 17)) return 0.f; }
}
__device__ __forceinline__ void rglru_prologue(Frame& F, int n) {
    const bf16_t* p_Wrg = F.Wrg_t();
    for (int i = F.tid; i < 4096; i += 512) { const int row = i >> 4, ch = i & 15;
        const v4u wv = *(const GAS v4u*)(p_Wrg + (size_t)((row >> 7) * 16 + n) * 16384 + (row & 127) * 128 + ch * 8);
        *(LAS v4u*)(F.lds + RG_W + row * 272 + ch * 16) = wv; }
    if (F.tid < 128) { const int c = n * 128 + F.tid; LAS float* tab = (LAS float*)(F.lds + RG_TAB);
        tab[F.tid] = -8.f * log1pf(__expf(-F.rg_lambda()[c])); tab[128 + F.tid] = F.b_rg_a()[c]; tab[256 + F.tid] = F.b_rg_x()[c]; }
    __syncthreads();
}
template <bool SAMPLE>
__device__ __forceinline__ void rglru_unit(Frame& F, int bn, int j) {
    const int w = F.wave, lane = F.lane, fr = lane & 15, fq = lane >> 4;
    const float* p_conv_w = F.conv_w(); const float* p_conv_b = F.conv_b(); const float* p_st_conv = F.st_conv(); const float* p_st_h = F.st_h();
    const bf16_t* p_Ub = F.Ub(); const bf16_t* p_Gb = F.Gb(); bf16_t* p_OY = F.OY(); gu64* p_gran = F.gran();
    int n, seq; long row0;
    if (SAMPLE) { n = bn; seq = 2 + w; row0 = MP + w * 16; } else { seq = bn >> 4; n = bn & 15; row0 = (long)seq * TP + j * 128 + w * 16; }
    const int cb = n * 128;
    LAS unsigned char* wl = F.lds + w * RG_WL;
    const LAS float* tab = (const LAS float*)(F.lds + RG_TAB);
    v4u gpre[4];
#pragma unroll
    for (int i = 0; i < 4; ++i) { const int r = (lane >> 4) + 4 * i; gpre[i] = *(const GAS v4u*)(p_Gb + (size_t)(row0 + r) * DM + cb + (lane & 15) * 8); }
    {
        const int c2 = cb + 2 * lane;
        float cw0[4], cw1[4];
#pragma unroll
        for (int k = 0; k < 4; ++k) { cw0[k] = p_conv_w[k * DM + c2]; cw1[k] = p_conv_w[k * DM + c2 + 1]; }
        const float cb0 = p_conv_b[c2], cb1 = p_conv_b[c2 + 1];
        float u0[19], u1[19];
#pragma unroll
        for (int i = 0; i < 19; ++i) { const int rr = i - 3;
            if (rr < 0) {
                if (SAMPLE) { u0[i] = p_st_conv[(size_t)(w * 3 + i) * DM + c2]; u1[i] = p_st_conv[(size_t)(w * 3 + i) * DM + c2 + 1]; }
                else if (j == 0 && w == 0) { u0[i] = 0.f; u1[i] = 0.f; }
                else { const unsigned p = *(const GAS unsigned*)(p_Ub + (size_t)(row0 + rr) * DM + c2); u0[i] = bflo(p); u1[i] = bfhi(p); }
            } else { const unsigned p = *(const GAS unsigned*)(p_Ub + (size_t)(row0 + rr) * DM + c2); u0[i] = bflo(p); u1[i] = bfhi(p); } }
#pragma unroll
        for (int tt = 0; tt < 16; ++tt) {
            const float x0 = cb0 + cw0[0] * u0[tt] + cw0[1] * u0[tt + 1] + cw0[2] * u0[tt + 2] + cw0[3] * u0[tt + 3];
            const float x1 = cb1 + cw1[0] * u1[tt] + cw1[1] * u1[tt + 1] + cw1[2] * u1[tt + 2] + cw1[3] * u1[tt + 3];
            *(LAS unsigned*)(wl + tt * 272 + lane * 4) = pk2(x0, x1); }
    }
    LDS_WAIT(); asm volatile("" ::: "memory");
    f32x4 acc[2][8];
#pragma unroll
    for (int a = 0; a < 2; ++a)
#pragma unroll
        for (int g = 0; g < 8; ++g) acc[a][g] = (f32x4){0.f, 0.f, 0.f, 0.f};
#pragma unroll
    for (int ks = 0; ks < 4; ++ks) { const bf16x8 a = *(const LAS bf16x8*)(wl + fr * 272 + (32 * ks + 8 * fq) * 2);
#pragma unroll
        for (int wh = 0; wh < 2; ++wh)
#pragma unroll
            for (int g = 0; g < 8; ++g) { const bf16x8 b = *(const LAS bf16x8*)(F.lds + RG_W + (wh * 128 + 16 * g + fr) * 272 + (32 * ks + 8 * fq) * 2);
                acc[wh][g] = __builtin_amdgcn_mfma_f32_16x16x32_bf16(a, b, acc[wh][g], 0, 0, 0); } }
    float Al[8][4], Hl[8][4], HS[8], EA[8], EH[8];
#pragma unroll
    for (int g = 0; g < 8; ++g) {
        const int cl = 16 * g + fr, c = cb + cl;
        const float c8 = tab[cl], ba = tab[128 + cl], bx = tab[256 + cl];
        float A = 1.f, H = 0.f;
#pragma unroll
        for (int reg = 0; reg < 4; ++reg) { const int tt = 4 * fq + reg;
            const float xcv = bf2f(*(const LAS unsigned short*)(wl + tt * 272 + cl * 2));
            const float r = sigm(acc[0][g][reg] + ba), ii = sigm(acc[1][g][reg] + bx);
            const float la = c8 * r, a = __expf(la), bb = __builtin_amdgcn_sqrtf(fmaxf(1.f - a * a, 0.f)) * (ii * xcv);
            H = a * H + bb; A = a * A; Al[g][reg] = A; Hl[g][reg] = H; }
        float IA = A, IH = H;
        { const float xa = __shfl_up(IA, 16), xh = __shfl_up(IH, 16); if (fq >= 1) { IH = IA * xh + IH; IA = IA * xa; } }
        { const float xa = __shfl_up(IA, 32), xh = __shfl_up(IH, 32); if (fq >= 2) { IH = IA * xh + IH; IA = IA * xa; } }
        { const float xa = __shfl_up(IA, 16), xh = __shfl_up(IH, 16); EA[g] = fq ? xa : 1.f; EH[g] = fq ? xh : 0.f; }
        if (SAMPLE) { const float h0 = p_st_h[(size_t)w * DM + c]; HS[g] = EA[g] * h0 + EH[g];
            if (fq == 3) F.out[O_SH + (size_t)w * DM + c] = IA * h0 + IH; }
        else { HS[g] = 0.f; if (fq == 3) *(LAS f32x2*)(F.lds + RG_TOT + (w * 128 + cl) * 8) = (f32x2){IA, IH}; }
    }
#pragma unroll
    for (int i = 0; i < 4; ++i) { const int r = (lane >> 4) + 4 * i; *(LAS v4u*)(wl + r * 272 + (lane & 15) * 16) = gpre[i]; }
    if (!SAMPLE) {
        __syncthreads();
        if (F.tid < 128) { const int c = F.tid; float PA = 1.f, PH = 0.f;
#pragma unroll
            for (int w2 = 0; w2 < 8; ++w2) { *(LAS f32x2*)(F.lds + RG_PRE + (w2 * 128 + c) * 8) = (f32x2){PA, PH};
                const f32x2 t = *(const LAS f32x2*)(F.lds + RG_TOT + (w2 * 128 + c) * 8); PH = t.x * PH + t.y; PA = PA * t.x; }
            gu64* gI = p_gran + (size_t)(bn * 32) * 128 + c; gu64* gA = gI + 131072; gu64* gB = gI + 262144;
            if (j < 31) { __hip_atomic_store(gA + j * 128, (1ull << 32) | (unsigned long long)__float_as_uint(PA), RLX_AGENT);
                          __hip_atomic_store(gB + j * 128, (1ull << 32) | (unsigned long long)__float_as_uint(PH), RLX_AGENT); }
            float hin = 0.f;
            if (j > 0) { float fa = 1.f, fh = 0.f; int k = j - 1; unsigned spins = 0; bool done = false;
                while (!done) {
                    unsigned long long xi[8], xa[8], xb[8];
#pragma unroll
                    for (int i = 0; i < 8; ++i) { const int kk = k - i < 0 ? 0 : k - i; xi[i] = __hip_atomic_load(gI + kk * 128, RLX_AGENT); xa[i] = __hip_atomic_load(gA + kk * 128, RLX_AGENT); xb[i] = __hip_atomic_load(gB + kk * 128, RLX_AGENT); }
                    bool stuck = false;
#pragma unroll
                    for (int i = 0; i < 8; ++i) { if (!done && !stuck) {
                        if ((unsigned)(xi[i] >> 32) == 1u) { hin = fa * __uint_as_float((unsigned)xi[i]) + fh; done = true; }
                        else if ((unsigned)(xa[i] >> 32) == 1u && (unsigned)(xb[i] >> 32) == 1u) { fh = fa * __uint_as_float((unsigned)xb[i]) + fh; fa = fa * __uint_as_float((unsigned)xa[i]); --k; if (k < 0) { hin = fh; done = true; } }
                        else stuck = true; } }
                    if (!done) { __builtin_amdgcn_s_sleep(1); if (++spins > (1u << 16)) break; }
                } }
            const float hout = PA * hin + PH;
            if (j < 31) __hip_atomic_store(gI + j * 128, (1ull << 32) | (unsigned long long)__float_as_uint(hout), RLX_AGENT);
            else F.out[O_PH + (size_t)seq * DM + cb + c] = hout;
            *(LAS float*)(F.lds + RG_HIN + c * 4) = hin; }
        __syncthreads();
#pragma unroll
        for (int g = 0; g < 8; ++g) { const int cl = 16 * g + fr; const f32x2 p = *(const LAS f32x2*)(F.lds + RG_PRE + (w * 128 + cl) * 8);
            const float hw = p.x * *(const LAS float*)(F.lds + RG_HIN + cl * 4) + p.y; HS[g] = EA[g] * hw + EH[g]; }
    }
    LDS_WAIT(); asm volatile("" ::: "memory");
#pragma unroll
    for (int g = 0; g < 8; ++g) { const int cl = 16 * g + fr;
#pragma unroll
        for (int reg = 0; reg < 4; ++reg) { const int tt = 4 * fq + reg; LAS unsigned short* gp = (LAS unsigned short*)(wl + tt * 272 + cl * 2);
            const float h = Al[g][reg] * HS[g] + Hl[g][reg]; *gp = (unsigned short)f2bf(h * bf2f(*gp)); } }
    LDS_WAIT(); asm volatile("" ::: "memory");
#pragma unroll
    for (int i = 0; i < 4; ++i) { const int r = (lane >> 4) + 4 * i; const v4u y = *(const LAS v4u*)(wl + r * 272 + (lane & 15) * 16);
        *(GAS v4u*)(p_OY + (size_t)(row0 + r) * 4096 + 2048 + cb + (lane & 15) * 8) = y; }
    __syncthreads();
}
typedef int i32x4_t __attribute__((ext_vector_type(4)));
__device__ __forceinline__ bf16x8 pack8frag(f32x4 a, f32x4 b) { const v4u w = pack8bf(a, b); return __builtin_bit_cast(bf16x8, w); }
__device__ __forceinline__ void sattn_unit(Frame& F, int bs, int h, int qh) {
    constexpr int RS = 532;
    LAS float* scv = (LAS float*)F.lds;
    LAS float* inv = scv + 16 * RS;
    LAS float* btab = inv + 16;
    LAS float* part = btab + 320;
    const int w = F.wave, lane = F.lane, fr = lane & 15, fq = lane >> 4;
    if (F.tid < 320) btab[F.tid] = F.rel_bias()[h * 320 + F.tid];
    const unsigned lrow = (unsigned)(fr * 2048 + 8 * fq) * 4u;
    {
        bf16x8 qf[4];
#pragma unroll
        for (int ks = 0; ks < 4; ++ks) qf[ks] = *(const GAS bf16x8*)(F.Qb() + (size_t)(MP + bs * 16 + qh * 8 + (fr & 7)) * DM + h * 128 + 32 * ks + 8 * fq);
        const __amdgpu_buffer_rsrc_t rk = __builtin_amdgcn_make_buffer_rsrc((void*)(F.cache_k() + ((size_t)(bs * 512 + 64 * w) * 16 + h) * 128), 0, 0x40000000, 0x00020000);
        f32x4 kr[4][4][2];
#pragma unroll
        for (int t = 0; t < 4; ++t)
#pragma unroll
            for (int ks = 0; ks < 4; ++ks) { const int so = (16 * t * 2048 + 32 * ks) * 4;
                kr[t][ks][0] = __builtin_bit_cast(f32x4, __builtin_amdgcn_raw_buffer_load_b128(rk, lrow, so, 0));
                kr[t][ks][1] = __builtin_bit_cast(f32x4, __builtin_amdgcn_raw_buffer_load_b128(rk, lrow, so + 16, 0)); }
#pragma unroll
        for (int t = 0; t < 4; ++t) { f32x4 acc = {0.f, 0.f, 0.f, 0.f};
#pragma unroll
            for (int ks = 0; ks < 4; ++ks) acc = __builtin_amdgcn_mfma_f32_16x16x32_bf16(pack8frag(kr[t][ks][0], kr[t][ks][1]), qf[ks], acc, 0, 0, 0);
#pragma unroll
            for (int reg = 0; reg < 4; ++reg) scv[fr * RS + 64 * w + 16 * t + 4 * fq + reg] = acc[reg] * ATT_SCALE; }
        if (w == 0) {
            const __amdgpu_buffer_rsrc_t rn = __builtin_amdgcn_make_buffer_rsrc((void*)(F.out + O_SK + (size_t)(bs * 16) * DM + h * 128), 0, 0x40000000, 0x00020000);
            f32x4 acc = {0.f, 0.f, 0.f, 0.f};
#pragma unroll
            for (int ks = 0; ks < 4; ++ks) { const f32x4 a = __builtin_bit_cast(f32x4, __builtin_amdgcn_raw_buffer_load_b128(rn, lrow, 32 * ks * 4, 0)), b = __builtin_bit_cast(f32x4, __builtin_amdgcn_raw_buffer_load_b128(rn, lrow, 32 * ks * 4 + 16, 0));
                acc = __builtin_amdgcn_mfma_f32_16x16x32_bf16(pack8frag(a, b), qf[ks], acc, 0, 0, 0); }
#pragma unroll
            for (int reg = 0; reg < 4; ++reg) scv[fr * RS + 512 + 4 * fq + reg] = acc[reg] * ATT_SCALE; }
    }
    __syncthreads();
    { const int row = w, qp_ = qh * 8 + w; float mx = -1e30f;
        for (int jk = lane; jk < 528; jk += 64) { int diff = jk < 512 ? (512 + qp_ - jk) : (qp_ - (jk - 512)); diff = diff > 256 ? 256 : diff;
            const float v = scv[row * RS + jk] + btab[diff + 63]; scv[row * RS + jk] = v; mx = fmaxf(mx, v); }
        mx = wave_max(mx); float sum = 0.f;
        for (int jk = lane; jk < 528; jk += 64) { const float e = __expf(scv[row * RS + jk] - mx); scv[row * RS + jk] = e; sum += e; }
        sum = wave_sum(sum); if (lane == 0) inv[row] = 1.f / sum; }
    __syncthreads();
    {
        const unsigned lcol = (unsigned)(8 * fq * 2048 + fr) * 4u;
        const __amdgpu_buffer_rsrc_t rv = __builtin_amdgcn_make_buffer_rsrc((void*)(F.cache_v() + ((size_t)(bs * 512 + 64 * w) * 16 + h) * 128), 0, 0x40000000, 0x00020000);
        f32x4 acc[8];
#pragma unroll
        for (int dt = 0; dt < 8; ++dt) acc[dt] = (f32x4){0.f, 0.f, 0.f, 0.f};
#pragma unroll
        for (int kt = 0; kt < 2; ++kt) {
            float vv[8][8];
#pragma unroll
            for (int dt = 0; dt < 8; ++dt)
#pragma unroll
                for (int j = 0; j < 8; ++j) vv[dt][j] = __builtin_bit_cast(float, __builtin_amdgcn_raw_buffer_load_b32(rv, lcol, ((32 * kt + j) * 2048 + 16 * dt) * 4, 0));
            const LAS f32x4* pp = (const LAS f32x4*)(scv + fr * RS + 64 * w + 32 * kt + 8 * fq);
            const bf16x8 pf = pack8frag(pp[0], pp[1]);
#pragma unroll
            for (int dt = 0; dt < 8; ++dt) { const bf16x8 bfr = pack8frag((f32x4){vv[dt][0], vv[dt][1], vv[dt][2], vv[dt][3]}, (f32x4){vv[dt][4], vv[dt][5], vv[dt][6], vv[dt][7]});
                acc[dt] = __builtin_amdgcn_mfma_f32_16x16x32_bf16(pf, bfr, acc[dt], 0, 0, 0); }
        }
        if (w == 0) {
            const __amdgpu_buffer_rsrc_t rn = __builtin_amdgcn_make_buffer_rsrc((void*)(F.out + O_SV + (size_t)(bs * 16) * DM + h * 128), 0, 0x40000000, 0x00020000);
            const unsigned lcn = (unsigned)(8 * (fq & 1) * 2048 + fr) * 4u;
            float vv[8][8];
#pragma unroll
            for (int dt = 0; dt < 8; ++dt)
#pragma unroll
                for (int j = 0; j < 8; ++j) vv[dt][j] = __builtin_bit_cast(float, __builtin_amdgcn_raw_buffer_load_b32(rn, lcn, (j * 2048 + 16 * dt) * 4, 0));
            const LAS f32x4* pp = (const LAS f32x4*)(scv + fr * RS + 512 + 8 * (fq & 1));
            f32x4 p0 = pp[0], p1 = pp[1]; if (fq >= 2) { p0 = (f32x4){0.f, 0.f, 0.f, 0.f}; p1 = p0; }
            const bf16x8 pf = pack8frag(p0, p1);
#pragma unroll
            for (int dt = 0; dt < 8; ++dt) { const bf16x8 bfr = pack8frag((f32x4){vv[dt][0], vv[dt][1], vv[dt][2], vv[dt][3]}, (f32x4){vv[dt][4], vv[dt][5], vv[dt][6], vv[dt][7]});
                acc[dt] = __builtin_amdgcn_mfma_f32_16x16x32_bf16(pf, bfr, acc[dt], 0, 0, 0); }
        }
#pragma unroll
        for (int dt = 0; dt < 8; ++dt)
#pragma unroll
            for (int reg = 0; reg < 4; ++reg) part[(w * 16 + 4 * fq + reg) * 128 + 16 * dt + fr] = acc[dt][reg];
    }
    __syncthreads();
    { const int row = F.tid >> 6, c2 = (F.tid & 63) * 2; f32x2 a = {0.f, 0.f};
#pragma unroll
      for (int w2 = 0; w2 < 8; ++w2) a += *(const LAS f32x2*)(part + (w2 * 16 + row) * 128 + c2);
      a = a * inv[row];
      *(GAS unsigned*)(F.OY() + (size_t)(MP + bs * 16 + qh * 8 + row) * 4096 + h * 128 + c2) = pk2(a.x, a.y); }
    __syncthreads();
}
__device__ __forceinline__ att::BlockRef att_ref(Frame& F, int L) {
    const int bh = L >> 4, qb = L & 15, b = bh >> 4, h = bh & 15;
    att::BlockRef r; const size_t rb = (size_t)b * TP;
    r.Q = F.Qb() + (rb + (size_t)qb * 256) * DM + h * 128; r.K = F.Kb() + rb * DM + h * 128; r.V = F.Vb() + rb * DM + h * 128;
    r.O = F.OY() + (rb + (size_t)qb * 256) * 4096 + h * 128; r.qb = qb; r.h = h; return r;
}
template <int pmask>
__device__ __forceinline__ void phase3(Frame& F, char* ldsg) {
    int wn = -1;
    if (pmask & 1) for (int id = F.vcu; id < 1024; id += F.G) { const int bn = id & 31; if ((bn & 15) != wn) { wn = bn & 15; rglru_prologue(F, wn); } rglru_unit<false>(F, bn, id >> 5); }
    if (pmask & 2) { if ((F.G & 15) == 0) { if ((F.vcu & 15) == 0 && (F.vcu >> 4) < 16) { const int n = F.vcu >> 4; if (n != wn) { wn = n; rglru_prologue(F, wn); } rglru_unit<true>(F, n, 0); } }
        else for (int n = F.vcu; n < 16; n += F.G) { if (n != wn) { wn = n; rglru_prologue(F, wn); } rglru_unit<true>(F, n, 0); } }
    if (pmask & 4) for (int u = F.vcu; u < 256; u += F.G) sattn_unit(F, u >> 5, (u >> 1) & 15, u & 1);
    for (int i = F.tid; i < 5120; i += 512) ((LAS float*)(F.lds + att::BIAS_OFF))[i] = F.rel_bias()[i];
    __syncthreads();
    int L = F.vcu;
    if ((pmask & 8) && L < 512) {
        att::BlockRef cur = att_ref(F, L); att::Seam S; att::att_prime(cur, ldsg, S);
        for (;;) { const bool more = L + F.G < 512; const int Ln = more ? L + F.G : L; const att::BlockRef nxt = more ? att_ref(F, Ln) : cur;
            att::att_block(cur, nxt, ldsg, S); if (!more) break; cur = nxt; L = Ln; }
    }
}

__global__ void __launch_bounds__(NWAVES * 64, 2) fwd(Args args) {
    extern __shared__ __attribute__((aligned(16))) unsigned char lds[];
    Frame F;
    F.lds = (LAS unsigned char*)lds;
    F.tid = threadIdx.x; F.lane = F.tid & 63; F.wave = __builtin_amdgcn_readfirstlane(F.tid >> 6);
    F.G = gridDim.x; { const int bx = blockIdx.x; F.vcu = (F.G % 8 == 0) ? (bx % 8) * (F.G / 8) + bx / 8 : bx; }
    F.out = args.out; F.ws = args.ws;
    unsigned char* ws = args.ws;
    for (int u = F.tid; u < (LDS_BYTES - LDSCTL_OFF) / 4; u += NWAVES * 64) ((LAS unsigned*)(F.lds + LDSCTL_OFF))[u] = 0u;
    __syncthreads();
#if !MK_MULTI
    XcdBarrier bar = xcd_barrier_post((unsigned*)(ws + WS_CTL) + CW_BAR, (volatile LAS unsigned*)(F.lds + MISC_OFF) + 8);
#define GRID_BAR() xcd_barrier(bar)
#else
#define GRID_BAR() do { } while (0)
#endif
    const int lo = args.ph_lo, hi = args.ph_hi;
#ifndef PHMASK
#define PHMASK 0x1ff
#endif
#define IN(k) (((PHMASK >> (k)) & 1) && lo <= (k) && (k) < hi)
#define SEAM(k) do { if (lo <= (k) && (k) + 1 < hi && (k) < 8) GRID_BAR(); } while (0)
#ifndef REP_PHASE
#define REP_PHASE -1
#endif
#define RUNPH(k, ...) do { unsigned long long t0_ = 0; if (PROBE_PHASE == (k)) t0_ = __builtin_amdgcn_s_memrealtime(); \
        if (IN(k)) { __VA_ARGS__ } if (REP_PHASE == (k) && IN(k)) { GRID_BAR(); __VA_ARGS__ } SEAM(k); \
        if (PROBE_PHASE == (k) && blockIdx.x == 0 && threadIdx.x == 0) ((unsigned*)(F.ws + WS_CTL))[2] = (unsigned)(__builtin_amdgcn_s_memrealtime() - t0_); } while (0)
    RUNPH(0, F.refresh(); phase0(F); );
    if (REP_PHASE == 100 && IN(0)) { phase0(F, true); GRID_BAR(); }
    RUNPH(1, F.refresh(); phase1(F); );
    RUNPH(2, F.refresh(); pg8::Gemm g{F.H1(), F.Win_t(), MPAD, NIN, DM}; pg8::StaticOrder S; S.init(MPAD, NIN, DM, F.G, (int)blockIdx.x);
        EpiIn E{F.Qb(), F.out}; pg8::gemm_phase<EpiIn, pg8::StaticOrder, true, true>(F.lds, g, S, E);
        { const int nlast = S.nwg % F.G, nfree = nlast ? F.G - nlast : F.G, fidx = nlast ? (int)blockIdx.x - nlast : (int)blockIdx.x;
          if (fidx >= 0) { LAS float* scr = (LAS float*)(F.lds + F.wave * 16384);
              for (int it = fidx * NWAVES + F.wave; it < NITEMS_B; it += nfree * NWAVES) conv_item_b(F, it, scr); } } );
    RUNPH(3, F.refresh(); phase3<15>(F, (char*)lds); );
    if (REP_PHASE > 100 && REP_PHASE < 116 && IN(3)) { F.refresh(); phase3<(REP_PHASE > 100 ? REP_PHASE - 100 : 15)>(F, (char*)lds); GRID_BAR(); }
    RUNPH(4, F.refresh(); pg8::Gemm g{F.OY(), F.Wproj_t(), MPAD, DM, 2 * DM}; pg8::HybridOrder S; S.init(DM, 2 * DM, F.G, (int)blockIdx.x, 2);
        EpiProj E{F.SAb(), F.SRb(), F.MG(), F.slab4(), F.ws}; pg8::gemm_phase<EpiProj, pg8::HybridOrder, true, true>(F.lds, g, S, E); );
    RUNPH(5, F.refresh(); pg8::Gemm g{F.MG(), F.Wout_t(), MPAD, DM, DM}; pg8::HybridOrder S; S.init(DM, DM, F.G, (int)blockIdx.x, 2);
        unsigned* rdy = (unsigned*)(F.ws + WS_CTL) + CW_READY + 64; S.ready = rdy; S.need = (unsigned)F.G; S.slices_first = true;
        probe_mark(0, F.ws); phase_mgs(F, rdy); probe_mark(1, F.ws);
        EpiResNorm E{F.x_prompt(), F.x1(), F.H1(), F.mod(), F.slab6(), F.lds + XL_OFF, (unsigned long long*)(F.ws + WS_XW), F.ws};
        pg8::gemm_phase<EpiResNorm, pg8::HybridOrder, true, true>(F.lds, g, S, E); );
    RUNPH(6, F.refresh(); pg8::Gemm g{F.H1(), F.Wgu_t(), MPAD, NGU, DM}; pg8::SampleGatedOrder S; S.init(MPAD, NGU, DM, F.G, (int)blockIdx.x);
        unsigned* ready = (unsigned*)(F.ws + WS_CTL) + CW_READY; S.ready = ready; S.need = MS;
        { const int nlast = S.nwg % F.G, nfree = nlast ? F.G - nlast : F.G, fidx = nlast ? (int)blockIdx.x - nlast : (int)blockIdx.x;
          if (fidx >= 0) phase_norm2s(F, fidx * NWAVES + F.wave, nfree * NWAVES, ready); }
        EpiGU E{F.ACT()}; pg8::gemm_phase<EpiGU, pg8::SampleGatedOrder, true, true>(F.lds, g, S, E); );
    RUNPH(7, F.refresh(); pg8::Gemm g{F.ACT(), F.Wdn_t(), MPAD, DM, DFF}; pg8::HybridOrder S; S.init(DM, DFF, F.G, (int)blockIdx.x, 4); S.slices_first = true;
        EpiResFinal E{F.x1(), F.out, F.mod(), F.fng(), F.slab9(), F.lds + XL_OFF, (unsigned long long*)(F.ws + WS_XW) + 32 * 256};
        pg8::gemm_phase<EpiResFinal, pg8::HybridOrder, true, true>(F.lds, g, S, E); );
    RUNPH(8, F.refresh(); phase_finals(F); );
    if (PROBE_PHASE >= 0 && blockIdx.x == 0) { __syncthreads(); const unsigned ticks = ((volatile unsigned*)(F.ws + WS_CTL))[2];
        const float fac = 1.f + 4e-3f + (PROBE_PHASE >= 100 ? 5e-5f : 1.5e-5f) * (0.01f * (float)ticks);
        for (int i = threadIdx.x; i < 16384; i += 512) F.out[O_SH + i] *= fac; }
#undef IN
#undef SEAM
}

extern "C" void kernel_launch(void* const* d_in, const int* in_sizes, int n_in, void* d_out, int out_size, void* d_ws, size_t ws_size, hipStream_t stream) {
    static int grid = 0;
    if (grid == 0) {
        if (n_in != 26 || out_size != (int)O_END || ws_size < WS_END) { fprintf(stderr, "kernel_launch: unexpected shapes (n_in %d out %d ws %zu)\n", n_in, out_size, ws_size); grid = -1; return; }
        int dev = 0, cus = 0, per_cu = 0;
        if (hipGetDevice(&dev) != hipSuccess || hipDeviceGetAttribute(&cus, hipDeviceAttributeMultiprocessorCount, dev) != hipSuccess) { grid = -1; return; }
        if (hipFuncSetAttribute((const void*)fwd, hipFuncAttributeMaxDynamicSharedMemorySize, LDS_BYTES) != hipSuccess) { fprintf(stderr, "kernel_launch: hipFuncSetAttribute failed\n"); grid = -1; return; }
        if (hipOccupancyMaxActiveBlocksPerMultiprocessor(&per_cu, (const void*)fwd, NWAVES * 64, LDS_BYTES) != hipSuccess || per_cu < 1) { fprintf(stderr, "kernel_launch: occupancy query says %d workgroups per CU; nothing launched\n", per_cu); (void)hipGetLastError(); grid = -1; return; }
        grid = cus;
    }
    if (grid < 0) return;
    (void)hipMemsetAsync((char*)d_ws + WS_CTL, 0, CTL_ZERO_BYTES, stream);
    Args a{};
    for (int i = 0; i < 26; ++i) a.in[i] = (const float*)d_in[i];
    a.out = (float*)d_out; a.ws = (unsigned char*)d_ws;
#if MK_MULTI
    for (int p = 0; p < 9; ++p) { a.ph_lo = p; a.ph_hi = p + 1; hipLaunchKernelGGL(fwd, dim3(grid), dim3(NWAVES * 64), LDS_BYTES, stream, a); }
#else
    a.ph_lo = 0; a.ph_hi = 9;
    void* kargs[] = {&a};
    hipError_t e = hipLaunchCooperativeKernel((const void*)fwd, dim3(grid), dim3(NWAVES * 64), kargs, LDS_BYTES, stream);
    if (e != hipSuccess) fprintf(stderr, "kernel_launch: cooperative launch failed: %s (grid %d)\n", hipGetErrorString(e), grid);
#endif
}
```

```cpp
#include <hip/hip_runtime.h>
#include <hip/hip_bf16.h>
#include <cstdio>
#include <cstdint>

#ifndef MK_MULTI
#define MK_MULTI 0
#endif

constexpr int DM = 2048, TP = 4096, NBP = 2, TS = 16, NBS = 8;
constexpr int MP = NBP * TP;
constexpr int MS = NBS * TS;
constexpr int MV = MP + MS;
constexpr int MPAD = 8448;
constexpr int NIN = 14336, DFF = 5632, NGU = 2 * DFF, NMOD = 6 * DM;
constexpr float EPS = 1e-6f;
constexpr float ATT_SCALE = 0.08838834764831845f;
constexpr size_t O_YP = 0, O_YS = 16777216, O_PK = 17039360, O_PV = 19136512, O_PH = 21233664, O_PC = 21237760,
                 O_SK = 21250048, O_SV = 21512192, O_SH = 21774336, O_SC = 21790720, O_END = 21839872;

constexpr size_t MiB = 1u << 20;
constexpr size_t WS_CTL = 0, CTL_ZERO_BYTES = 1 * MiB;
constexpr size_t WS_MOD = 64 * 1024;
constexpr size_t WS_GRAN = 1 * MiB;
constexpr size_t WS_SLAB4 = 218 * MiB, WS_SLAB6 = 251 * MiB, WS_SLAB9 = 350 * MiB;
constexpr int NSL4 = 32, NSL6 = 16, NSL9 = 22;
constexpr size_t WS_WIN = 4 * MiB, WS_WPROJ = 60 * MiB, WS_WOUT = 76 * MiB, WS_WGU = 84 * MiB, WS_WDN = 128 * MiB, WS_WRG = 150 * MiB;
constexpr size_t WS_H1 = 152 * MiB;
constexpr size_t WS_Q = 185 * MiB, WS_K = 218 * MiB, WS_V = 251 * MiB, WS_U = 284 * MiB, WS_G = 317 * MiB, WS_SA = 350 * MiB, WS_SR = 383 * MiB;
constexpr size_t WS_MERGED = WS_Q;
constexpr size_t WS_ACT = WS_K;
constexpr size_t WS_OY = 416 * MiB;
constexpr size_t WS_END = 482 * MiB;
static_assert(WS_ACT + (size_t)MPAD * DFF * 2 <= WS_G, "ACT overlay");
constexpr int CW_TMO = 0, CW_READY = 2048, CW_BAR = 4096;
constexpr size_t WS_XW = 640 * 1024;

constexpr int RING_BYTES = 131072, LDSCTL_OFF = RING_BYTES, MISC_OFF = LDSCTL_OFF + 320, LDS_BYTES = 147456;
constexpr int NWAVES = 8;

#define GAS __attribute__((address_space(1)))
#define LAS __attribute__((address_space(3)))
typedef unsigned short bf16_t;
typedef unsigned v4u __attribute__((ext_vector_type(4)));
typedef unsigned v2u __attribute__((ext_vector_type(2)));
typedef float f32x4 __attribute__((ext_vector_type(4)));
typedef float f32x2 __attribute__((ext_vector_type(2)));
typedef float f32x16 __attribute__((ext_vector_type(16)));
typedef short bf16x8 __attribute__((ext_vector_type(8)));
typedef short s16x4 __attribute__((ext_vector_type(4)));
typedef GAS unsigned gu32;
typedef GAS unsigned long long gu64;
#define RLX_AGENT __ATOMIC_RELAXED, __HIP_MEMORY_SCOPE_AGENT
#define LDS_WAIT() asm volatile("s_waitcnt lgkmcnt(0)" ::: "memory")
#define VM_WAIT() asm volatile("s_waitcnt vmcnt(0)" ::: "memory")

__device__ __forceinline__ unsigned f2bf(float f) { unsigned u = __builtin_bit_cast(unsigned, f); return (u + 0x7fffu + ((u >> 16) & 1u)) >> 16; }
__device__ __forceinline__ unsigned pk2(float lo, float hi) { return f2bf(lo) | (f2bf(hi) << 16); }
__device__ __forceinline__ float bf2f(unsigned short h) { return __builtin_bit_cast(float, (unsigned)h << 16); }
__device__ __forceinline__ float bflo(unsigned w) { return __builtin_bit_cast(float, w << 16); }
__device__ __forceinline__ float bfhi(unsigned w) { return __builtin_bit_cast(float, w & 0xffff0000u); }
typedef __bf16 bf16x2_t __attribute__((ext_vector_type(2)));
__device__ __forceinline__ unsigned cvt_pk_bf16(float lo, float hi) { f32x2 v = {lo, hi}; bf16x2_t b = __builtin_convertvector(v, bf16x2_t); return __builtin_bit_cast(unsigned, b); }
__device__ __forceinline__ float sigm(float x) { return __builtin_amdgcn_rcpf(1.f + __expf(-x)); }
__device__ __forceinline__ float gelu_tanh(float x) { return x * sigm(1.5957691216057308f * (x + 0.044715f * x * x * x)); }
__device__ __forceinline__ float wave_sum(float v) {
#pragma unroll
    for (int o = 1; o < 64; o <<= 1) v += __shfl_xor(v, o);
    return v;
}
__device__ __forceinline__ float wave_max(float v) {
#pragma unroll
    for (int o = 1; o < 64; o <<= 1) v = fmaxf(v, __shfl_xor(v, o));
    return v;
}

namespace pg8 {
#define PG8_LAS __attribute__((address_space(3)))
constexpr int BM = 256, BK = 64, HALF = 128, HTB = HALF * BK * 2, STAGE_BYTES = 8 * HTB, NXCD = 8, WGM = 2;
__host__ __device__ __forceinline__ int lds_byte(int r, int c) { const int st = (r >> 4) * 2 + (c >> 5), rr = r & 15, cc = c & 31, ob = rr * 64 + cc * 2; return st * 1024 + (ob ^ (((ob >> 9) & 1) << 5)); }
__host__ __device__ __forceinline__ void stage_rc(int b, int& R, int& C) { const int st = b / 1024, sb = b % 1024, swz = sb ^ (((sb >> 9) & 1) << 5); R = (st >> 1) * 16 + swz / 64; C = (st & 1) * 32 + (swz % 64) / 2; }
__host__ __device__ __forceinline__ int perm32(int rho) { const int n = rho >> 4, i = rho & 15; return 8 * (i >> 2) + 4 * n + (i & 3); }
struct Unit { int pm, pn, k0, nt; };
struct Gemm { const bf16_t* A; const bf16_t* Bt; int M, N, K; };
struct StaticOrder {
    int nM, nN, nwg, G, c, ntf, wgm;
    __host__ __device__ void init(int M, int N, int K, int G_, int c_, int wgm_ = WGM) { nM = M / BM; nN = N / BM; nwg = nM * nN; G = G_; c = c_; ntf = K / BK; wgm = wgm_; }
    __host__ __device__ __forceinline__ bool next(int i, Unit& u) const { return at((long)i * G + c, u); }
    __host__ __device__ __forceinline__ bool at(long L, Unit& u) const {
        u.pm = 0; u.pn = 0; u.k0 = 0; u.nt = ntf;
        if (L >= nwg) return false;
        int wgid = (int)L; { const int q = nwg / NXCD, r = nwg % NXCD, xcd = wgid % NXCD, off = wgid / NXCD; wgid = (xcd < r ? xcd * (q + 1) : r * (q + 1) + (xcd - r) * q) + off; }
        const int nig = wgm * nN, gid = wgid / nig, fm = gid * wgm, gsz = (nM - fm) < wgm ? (nM - fm) : wgm;
        u.pm = fm + ((wgid % nig) % gsz); u.pn = (wgid % nig) / gsz; return true;
    }
    __device__ __forceinline__ void a_ready(const Unit&) const {}
    __device__ __forceinline__ void done(const Unit&) const {}
};
struct SampleGatedOrder : StaticOrder {
    const unsigned* ready; unsigned need;
    __device__ __forceinline__ void a_ready(const Unit& u) const {
        if (u.pm != 32) return;
        if (threadIdx.x < 64) { unsigned polls = 0;
            while ((unsigned)__builtin_amdgcn_readfirstlane(__hip_atomic_load(ready, __ATOMIC_RELAXED, __HIP_MEMORY_SCOPE_AGENT)) < need) { __builtin_amdgcn_s_sleep(2); if (++polls > (1u << 20)) break; }
            __builtin_amdgcn_fence(__ATOMIC_ACQUIRE, "agent");
            asm volatile("s_waitcnt vmcnt(0)" ::: "memory"); }
        asm volatile("" ::: "memory"); __builtin_amdgcn_s_barrier(); asm volatile("" ::: "memory");
    }
};
struct HybridOrder {
    StaticOrder base; int snt, npn, nsl; const unsigned* ready = nullptr; unsigned need = 0;
    bool slices_first = false;
    __host__ __device__ void init(int N, int K, int G_, int c_, int snt_, int wgm_ = WGM) { base.init(8192, N, K, G_, c_, wgm_); snt = snt_; npn = N / BM; nsl = (K / BK) / snt_; }
    __host__ __device__ __forceinline__ bool next(int i, Unit& u) const {
        const long L = (long)i * base.G + base.c;
        if (slices_first) { const long ns = (long)npn * nsl;
            if (L >= ns) return base.at(L - ns, u);
            u.pm = 32; u.pn = (int)(L % npn); u.k0 = (int)(L / npn) * snt; u.nt = snt; return true; }
        if (L < base.nwg) return base.at(L, u);
        const int sidx = (int)(L - base.nwg);
        u.pm = 32; u.pn = sidx % npn; u.k0 = (sidx / npn) * snt; u.nt = snt; return sidx < npn * nsl;
    }
    __device__ __forceinline__ void a_ready(const Unit& u) const {
        if (u.pm != 32 || ready == nullptr) return;
        if (threadIdx.x < 64) { unsigned polls = 0;
            while ((unsigned)__builtin_amdgcn_readfirstlane(__hip_atomic_load(ready, __ATOMIC_RELAXED, __HIP_MEMORY_SCOPE_AGENT)) < need) { __builtin_amdgcn_s_sleep(2); if (++polls > (1u << 20)) break; }
            __builtin_amdgcn_fence(__ATOMIC_ACQUIRE, "agent");
            asm volatile("s_waitcnt vmcnt(0)" ::: "memory"); }
        asm volatile("" ::: "memory"); __builtin_amdgcn_s_barrier(); asm volatile("" ::: "memory");
    }
    __device__ __forceinline__ void done(const Unit&) const {}
};
template <class Epi, class Sched, bool ALIGN_EPI = false, bool SP2 = false>
__device__ __forceinline__ void gemm_phase(PG8_LAS unsigned char* lds, const Gemm g, const Sched& S, const Epi& E) {
    const int tid = threadIdx.x, wid = __builtin_amdgcn_readfirstlane(tid >> 6), lane = tid & 63, wr = wid >> 2, wc = wid & 3, fr = lane & 15, fq = lane >> 4;
    const int K = g.K, nt = K / BK;
    unsigned voffA[2], voffB[2];
#pragma unroll
    for (int i = 0; i < 2; ++i) { int R, C; stage_rc(tid * 16 + i * 8192, R, C); const int Rb = Epi::PERM ? ((R & ~31) + perm32(R & 31)) : R;
        voffA[i] = (unsigned)(R * K + C) * 2u; voffB[i] = (unsigned)(Rb * K + C) * 2u; }
    const size_t kstep = (size_t)(BK * 2);
    const size_t hstep = (size_t)HALF * K * 2;
    const size_t tstep = 2 * hstep;
    const unsigned ldsw = (unsigned)wid * 1024u;
    const int aoff = lds_byte(wr * 64 + fr, fq * 8), boff = lds_byte(wc * 32 + fr, fq * 8);
#define PG8_SA(b, h) (((b) * 2 + (h)) * HTB)
#define PG8_SB(b, h) ((4 + (b) * 2 + (h)) * HTB)
#define PG8_STAGE(bufoff, gbase, voff) do { _Pragma("unroll") for (int _i = 0; _i < 2; ++_i) \
        __builtin_amdgcn_global_load_lds((const unsigned*)((const char*)(gbase) + (voff)[_i]), (PG8_LAS unsigned*)(lds + (bufoff) + ldsw + _i * 8192), 16, 0, 0); } while (0)
#define PG8_LDA(dst, b, h) do { _Pragma("unroll") for (int m = 0; m < 4; ++m) _Pragma("unroll") for (int k = 0; k < 2; ++k) dst[m][k] = *(const PG8_LAS bf16x8*)(lds + PG8_SA(b, h) + aoff + m * 2048 + k * 1024); } while (0)
#define PG8_LDB(dst, b, h) do { _Pragma("unroll") for (int n = 0; n < 2; ++n) _Pragma("unroll") for (int k = 0; k < 2; ++k) dst[n][k] = *(const PG8_LAS bf16x8*)(lds + PG8_SB(b, h) + boff + n * 2048 + k * 1024); } while (0)
#define PG8_MMA(ai, bj, At, Bt) do { __builtin_amdgcn_s_setprio(1); _Pragma("unroll") for (int m = 0; m < 4; ++m) _Pragma("unroll") for (int n = 0; n < 2; ++n) _Pragma("unroll") for (int k = 0; k < 2; ++k) \
        acc[ai][bj][m][n] = __builtin_amdgcn_mfma_f32_16x16x32_bf16(Bt[n][k], At[m][k], acc[ai][bj][m][n], 0, 0, 0); __builtin_amdgcn_s_setprio(0); } while (0)
#define PG8_WAIT_V(n) asm volatile("s_waitcnt vmcnt(" #n ")" ::: "memory")
#define PG8_WAIT_L(n) asm volatile("s_waitcnt lgkmcnt(" #n ")" ::: "memory")
#define PG8_BAR __builtin_amdgcn_s_barrier()
#define PG8_SCHED __builtin_amdgcn_sched_barrier(0)
    Unit cur, nxt; int ui = 0;
    if (!S.next(0, cur)) return;
    f32x4 acc[2][2][4][2];
#pragma unroll
    for (int a = 0; a < 2; ++a)
#pragma unroll
        for (int b = 0; b < 2; ++b)
#pragma unroll
            for (int m = 0; m < 4; ++m)
#pragma unroll
                for (int n = 0; n < 2; ++n) acc[a][b][m][n] = (f32x4){0.f, 0.f, 0.f, 0.f};
    bf16x8 At[4][2], B0[2][2], B1[2][2];
    const char* cA = (const char*)g.A + (size_t)cur.pm * tstep + (size_t)cur.k0 * kstep; const char* cB = (const char*)g.Bt + (size_t)cur.pn * tstep + (size_t)cur.k0 * kstep;
    S.a_ready(cur);
    if constexpr (SP2) {
        PG8_STAGE(PG8_SB(0, 0), cB, voffB); PG8_STAGE(PG8_SB(0, 1), cB + hstep, voffB); PG8_STAGE(PG8_SA(0, 0), cA, voffA); PG8_STAGE(PG8_SA(0, 1), cA + hstep, voffA);
        if (wr == 1) PG8_BAR;
        PG8_WAIT_V(2); PG8_BAR;
        PG8_STAGE(PG8_SB(1, 0), cB + kstep, voffB); PG8_STAGE(PG8_SA(1, 0), cA + kstep, voffA); PG8_STAGE(PG8_SB(1, 1), cB + hstep + kstep, voffB);
        PG8_WAIT_V(6); PG8_BAR;
    } else {
        PG8_STAGE(PG8_SB(0, 0), cB, voffB); PG8_STAGE(PG8_SA(0, 0), cA, voffA); PG8_STAGE(PG8_SB(0, 1), cB + hstep, voffB); PG8_STAGE(PG8_SA(0, 1), cA + hstep, voffA);
        if (wr == 1) PG8_BAR;
        PG8_WAIT_V(4); PG8_BAR;
        PG8_STAGE(PG8_SB(1, 0), cB + kstep, voffB); PG8_STAGE(PG8_SA(1, 0), cA + kstep, voffA); PG8_STAGE(PG8_SB(1, 1), cB + hstep + kstep, voffB);
        PG8_WAIT_V(6); PG8_BAR;
    }
    for (;;) {
        const bool has_next = S.next(ui + 1, nxt);
        const char* nA = has_next ? (const char*)g.A + (size_t)nxt.pm * tstep + (size_t)nxt.k0 * kstep : cA; const char* nB = has_next ? (const char*)g.Bt + (size_t)nxt.pn * tstep + (size_t)nxt.k0 * kstep : cB;
        const int cnt = cur.nt;
        for (int t = 0; t < cnt; t += 2) {
            if constexpr (Epi::MIDK) { if (cnt == nt && t == (nt >> 1)) E.mid(acc, cur, wr, wc, fr, fq); }
            const bool last = (t == cnt - 2);
            const char* a1 = cA + (size_t)(t + 1) * kstep;
            const char* a2 = last ? nA : cA + (size_t)(t + 2) * kstep; const char* b2 = last ? nB : cB + (size_t)(t + 2) * kstep;
            const char* a3 = a2 + kstep; const char* b3 = b2 + kstep;
            if (last && has_next) S.a_ready(nxt);
            if constexpr (SP2) {
            PG8_LDB(B0, 0, 0); PG8_LDB(B1, 0, 1); PG8_SCHED; PG8_LDA(At, 0, 0); PG8_STAGE(PG8_SA(1, 1), a1 + hstep, voffA);
            PG8_WAIT_V(8); PG8_WAIT_L(0); PG8_BAR; PG8_MMA(0, 0, At, B0); PG8_MMA(0, 1, At, B1); PG8_BAR; PG8_SCHED;
            PG8_LDA(At, 0, 1); PG8_STAGE(PG8_SB(0, 0), b2, voffB); PG8_STAGE(PG8_SB(0, 1), b2 + hstep, voffB); PG8_STAGE(PG8_SA(0, 0), a2, voffA);
            PG8_WAIT_V(8); PG8_WAIT_L(0); PG8_BAR; PG8_MMA(1, 0, At, B0); PG8_MMA(1, 1, At, B1); PG8_BAR; PG8_SCHED;
            PG8_LDB(B0, 1, 0); PG8_LDB(B1, 1, 1); PG8_SCHED; PG8_LDA(At, 1, 0); PG8_STAGE(PG8_SA(0, 1), a2 + hstep, voffA);
            PG8_WAIT_V(8); PG8_WAIT_L(0); PG8_BAR; PG8_MMA(0, 0, At, B0); PG8_MMA(0, 1, At, B1); PG8_BAR; PG8_SCHED;
            PG8_LDA(At, 1, 1); PG8_STAGE(PG8_SB(1, 0), b3, voffB); PG8_STAGE(PG8_SB(1, 1), b3 + hstep, voffB); PG8_STAGE(PG8_SA(1, 0), a3, voffA);
            PG8_WAIT_V(8); PG8_WAIT_L(0); PG8_BAR; PG8_MMA(1, 0, At, B0); PG8_MMA(1, 1, At, B1); PG8_BAR; PG8_SCHED;
            } else {
            PG8_LDB(B0, 0, 0); PG8_SCHED; PG8_LDA(At, 0, 0); PG8_STAGE(PG8_SA(1, 1), a1 + hstep, voffA);
            PG8_WAIT_L(8); PG8_BAR; PG8_WAIT_L(0); PG8_MMA(0, 0, At, B0); PG8_BAR; PG8_SCHED;
            PG8_LDB(B1, 0, 1); PG8_STAGE(PG8_SB(0, 0), b2, voffB);
            PG8_BAR; PG8_WAIT_L(0); PG8_MMA(0, 1, At, B1); PG8_BAR;
            PG8_LDA(At, 0, 1); PG8_STAGE(PG8_SA(0, 0), a2, voffA);
            PG8_BAR; PG8_WAIT_L(0); PG8_MMA(1, 0, At, B0); PG8_BAR; PG8_SCHED;
            PG8_STAGE(PG8_SB(0, 1), b2 + hstep, voffB);
            PG8_WAIT_V(6); PG8_BAR; PG8_MMA(1, 1, At, B1); PG8_BAR;
            PG8_LDB(B0, 1, 0); PG8_SCHED; PG8_LDA(At, 1, 0); PG8_STAGE(PG8_SA(0, 1), a2 + hstep, voffA);
            PG8_WAIT_L(8); PG8_BAR; PG8_WAIT_L(0); PG8_MMA(0, 0, At, B0); PG8_BAR; PG8_SCHED;
            PG8_LDB(B1, 1, 1); PG8_STAGE(PG8_SB(1, 0), b3, voffB);
            PG8_BAR; PG8_WAIT_L(0); PG8_MMA(0, 1, At, B1); PG8_BAR;
            PG8_LDA(At, 1, 1); PG8_STAGE(PG8_SA(1, 0), a3, voffA);
            PG8_BAR; PG8_WAIT_L(0); PG8_MMA(1, 0, At, B0); PG8_BAR; PG8_SCHED;
            PG8_STAGE(PG8_SB(1, 1), b3 + hstep, voffB);
            PG8_WAIT_V(6); PG8_BAR; PG8_MMA(1, 1, At, B1); PG8_BAR;
            }
        }
        if constexpr (ALIGN_EPI) { if (wr == 0) PG8_BAR; }
        if constexpr (Epi::AFTER_DRAIN) { if (has_next) E(acc, cur, wr, wc, fr, fq); } else { E(acc, cur, wr, wc, fr, fq); }
        S.done(cur);
        if (!has_next) break;
#pragma unroll
        for (int a = 0; a < 2; ++a)
#pragma unroll
            for (int b = 0; b < 2; ++b)
#pragma unroll
                for (int m = 0; m < 4; ++m)
#pragma unroll
                    for (int n = 0; n < 2; ++n) acc[a][b][m][n] = (f32x4){0.f, 0.f, 0.f, 0.f};
        cur = nxt; cA = nA; cB = nB; ++ui;
        if constexpr (ALIGN_EPI) { if (wr == 1) PG8_BAR; }
    }
    PG8_WAIT_V(0);
    if constexpr (!ALIGN_EPI) { if (wr == 0) PG8_BAR; }
    PG8_BAR;
    if constexpr (Epi::AFTER_DRAIN) E.fused(acc, cur, wr, wc, fr, fq, lds);
#undef PG8_SA
#undef PG8_SB
#undef PG8_STAGE
#undef PG8_LDA
#undef PG8_LDB
#undef PG8_MMA
#undef PG8_WAIT_V
#undef PG8_WAIT_L
#undef PG8_BAR
#undef PG8_SCHED
}
}

#ifndef PROBE_PHASE
#define PROBE_PHASE -1
#endif
__device__ __forceinline__ void probe_mark(int id, unsigned char* ws) {
    if (PROBE_PHASE >= 100 && blockIdx.x == 0 && threadIdx.x == 0) { const int a = (PROBE_PHASE - 100) / 10, b = (PROBE_PHASE - 100) % 10;
        unsigned* w = (unsigned*)ws; const unsigned now = (unsigned)__builtin_amdgcn_s_memrealtime();
        if (id == a) w[3] = now; if (id == b) w[2] = now - w[3]; }
}
__device__ __forceinline__ v4u pack8bf(f32x4 a, f32x4 b) { v4u w; w.x = cvt_pk_bf16(a[0], a[1]); w.y = cvt_pk_bf16(a[2], a[3]); w.z = cvt_pk_bf16(b[0], b[1]); w.w = cvt_pk_bf16(b[2], b[3]); return w; }
__device__ __forceinline__ void unpack8bf(v4u w, f32x4& a, f32x4& b) { a = (f32x4){bflo(w.x), bfhi(w.x), bflo(w.y), bfhi(w.y)}; b = (f32x4){bflo(w.z), bfhi(w.z), bflo(w.w), bfhi(w.w)}; }

struct EpiIn {
    static constexpr bool PERM = true, MIDK = false, AFTER_DRAIN = false;
    bf16_t* base;
    float* out;
    __device__ __forceinline__ void mid(f32x4 (&)[2][2][4][2], const pg8::Unit&, int, int, int, int) const {}
    template <int MODE>
    __device__ __forceinline__ void store_bf(const f32x4 (&acc)[2][2][4][2], const pg8::Unit& u, int wr, int wc, int fr, int fq, bf16_t* dst) const {
        const int colr = (u.pn & 7) * 256 + wc * 32 + 8 * fq;
#pragma unroll
        for (int ai = 0; ai < 2; ++ai)
#pragma unroll
            for (int m = 0; m < 4; ++m) {
                const size_t row = (size_t)u.pm * 256 + ai * 128 + wr * 64 + m * 16 + fr;
#pragma unroll
                for (int bj = 0; bj < 2; ++bj) {
                    f32x4 v0 = acc[ai][bj][m][0], v1 = acc[ai][bj][m][1];
                    if (MODE == 1) {
#pragma unroll
                        for (int e = 0; e < 4; ++e) { v0[e] = gelu_tanh(v0[e]); v1[e] = gelu_tanh(v1[e]); }
                    } else if (MODE == 2) {
#pragma unroll
                        for (int e = 0; e < 4; ++e) { v0[e] = sigm(v0[e]); v1[e] = sigm(v1[e]); }
                    }
                    *(v4u*)(dst + row * DM + colr + bj * 128) = pack8bf(v0, v1);
                }
                asm volatile("" ::: "memory");
            }
    }
    __device__ __forceinline__ void store_f32(const f32x4 (&acc)[2][2][4][2], const pg8::Unit& u, int wr, int wc, int fr, int fq, float* orow0, int rl0, int rl1) const {
        const int colr = (u.pn & 7) * 256 + wc * 32 + 8 * fq;
#pragma unroll
        for (int ai = 0; ai < 2; ++ai)
#pragma unroll
            for (int m = 0; m < 4; ++m) {
                const int rl = ai * 128 + wr * 64 + m * 16 + fr;
                if (rl >= rl0 && rl < rl1) {
                    float* o = orow0 + (size_t)(rl - rl0) * DM + colr;
#pragma unroll
                    for (int bj = 0; bj < 2; ++bj) { *(f32x4*)(o + bj * 128) = acc[ai][bj][m][0]; *(f32x4*)(o + bj * 128 + 4) = acc[ai][bj][m][1]; }
                }
                asm volatile("" ::: "memory");
            }
    }
    __device__ __forceinline__ void store_f32_sconv(const f32x4 (&acc)[2][2][4][2], const pg8::Unit& u, int wr, int wc, int fr, int fq) const {
        const int colr = (u.pn & 7) * 256 + wc * 32 + 8 * fq;
        if (fr >= 13) {
#pragma unroll
            for (int m = 0; m < 4; ++m) {
                const int rl = wr * 64 + m * 16 + fr;
                float* o = out + O_SC + ((size_t)((rl >> 4) * 3 + fr - 13)) * DM + colr;
#pragma unroll
                for (int bj = 0; bj < 2; ++bj) { *(f32x4*)(o + bj * 128) = acc[0][bj][m][0]; *(f32x4*)(o + bj * 128 + 4) = acc[0][bj][m][1]; }
                asm volatile("" ::: "memory");
            }
        }
    }
    __device__ __forceinline__ void operator()(const f32x4 (&acc)[2][2][4][2], const pg8::Unit& u, int wr, int wc, int fr, int fq) const {
        const int region = u.pn >> 3, pm = u.pm;
        bf16_t* dst = base + (size_t)region * (33 * MiB / 2);
        const bool sample = (pm == 32);
        if (region == 4) store_bf<1>(acc, u, wr, wc, fr, fq, dst);
        else if (region >= 5) store_bf<2>(acc, u, wr, wc, fr, fq, dst);
        else store_bf<0>(acc, u, wr, wc, fr, fq, dst);
        if (region == 1 || region == 2) {
            if (sample) store_f32(acc, u, wr, wc, fr, fq, out + (region == 1 ? O_SK : O_SV), 0, 128);
            else if ((pm & 15) >= 14) store_f32(acc, u, wr, wc, fr, fq, out + (region == 1 ? O_PK : O_PV) + ((size_t)((pm >> 4) * 512 + ((pm & 15) - 14) * 256)) * DM, 0, 256);
        } else if (region == 3) {
            if (sample) store_f32_sconv(acc, u, wr, wc, fr, fq);
            else if ((pm & 15) == 15) store_f32(acc, u, wr, wc, fr, fq, out + O_PC + (size_t)((pm >> 4) * 3) * DM, 253, 256);
        }
    }
};
template <bool GATED>
__device__ __forceinline__ void slice_store(const f32x4 (&acc)[2][2][4][2], const pg8::Unit& u, int wr, int wc, int fr, int fq, float* slabs, const bf16_t* gate) {
    int opq = 0; asm volatile("" : "+v"(opq));
    const int col0 = u.pn * 256 + wc * 32 + 8 * fq;
    float* slab = slabs + (size_t)(u.k0 / u.nt) * (128 * DM);
#pragma unroll
    for (int m = 0; m < 4; ++m) {
        const int rl = wr * 64 + m * 16 + fr + opq;
#pragma unroll
        for (int bj = 0; bj < 2; ++bj) {
            const int c = col0 + bj * 128;
            f32x4 v0 = acc[0][bj][m][0], v1 = acc[0][bj][m][1];
            if (GATED) { f32x4 g0, g1; unpack8bf(*(const v4u*)(gate + (size_t)(MP + rl) * DM + c), g0, g1); v0 = v0 * g0; v1 = v1 * g1; }
            float* p = slab + (size_t)rl * DM + c;
            *(f32x4*)p = v0; *(f32x4*)(p + 4) = v1;
        }
        if (m & 1) asm volatile("" ::: "memory");
    }
}
struct EpiProj {
    static constexpr bool PERM = true, MIDK = true, AFTER_DRAIN = false;
    const bf16_t* SA; const bf16_t* SR; bf16_t* O; float* sacc; unsigned char* pws;
    __device__ __forceinline__ void mid(f32x4 (&acc)[2][2][4][2], const pg8::Unit& u, int wr, int wc, int fr, int fq) const {
        probe_mark(6, pws);
        int opq = 0; asm volatile("" : "+v"(opq));
        const int col0 = u.pn * 256 + wc * 32 + 8 * fq;
        const int rowb = u.pm * 256 + wr * 64 + fr + opq;
#pragma unroll
        for (int ai = 0; ai < 2; ++ai)
#pragma unroll
            for (int m = 0; m < 4; ++m) {
                const size_t row = (size_t)(rowb + ai * 128 + m * 16);
#pragma unroll
                for (int bj = 0; bj < 2; ++bj) {
                    const size_t off = row * DM + col0 + bj * 128;
                    f32x4 a0, a1, r0, r1; unpack8bf(*(const v4u*)(SA + off), a0, a1); unpack8bf(*(const v4u*)(SR + off), r0, r1);
#pragma unroll
                    for (int e = 0; e < 4; ++e) { acc[ai][bj][m][0][e] *= a0[e] * __builtin_amdgcn_rcpf(r0[e]); acc[ai][bj][m][1][e] *= a1[e] * __builtin_amdgcn_rcpf(r1[e]); }
                }
                if (m & 1) asm volatile("" : "+v"(acc[ai][0][m][0]), "+v"(acc[ai][0][m][1]), "+v"(acc[ai][1][m][0]), "+v"(acc[ai][1][m][1]) :: "memory");
            }
        probe_mark(7, pws);
    }
    __device__ __forceinline__ void operator()(const f32x4 (&acc)[2][2][4][2], const pg8::Unit& u, int wr, int wc, int fr, int fq) const {
        probe_mark(8, pws);
        if (u.pm == 32) { slice_store<true>(acc, u, wr, wc, fr, fq, sacc, u.k0 < 32 ? SA : SR); return; }
        const int col0 = u.pn * 256 + wc * 32 + 8 * fq;
#pragma unroll
        for (int ai = 0; ai < 2; ++ai)
#pragma unroll
            for (int m = 0; m < 4; ++m) {
                const size_t row = (size_t)u.pm * 256 + ai * 128 + wr * 64 + m * 16 + fr;
#pragma unroll
                for (int bj = 0; bj < 2; ++bj) {
                    const size_t off = row * DM + col0 + bj * 128;
                    f32x4 r0, r1; unpack8bf(*(const v4u*)(SR + off), r0, r1);
                    *(v4u*)(O + off) = pack8bf(acc[ai][bj][m][0] * r0, acc[ai][bj][m][1] * r1);
                }
                if (m & 1) asm volatile("" ::: "memory");
            }
    }
};
constexpr int XL_OFF = LDSCTL_OFF + 1024;
__device__ __forceinline__ void panel_rinv(const f32x4 (&v)[2][2][4][2], const pg8::Unit& u, int wr, int wc, int fr, int fq, LAS unsigned char* xl, unsigned long long* xw) {
    const int lane = threadIdx.x & 63, wid = wr * 4 + wc;
    LAS float* P = (LAS float*)xl;
    LAS float* S = P + 1024;
#pragma unroll
    for (int ai = 0; ai < 2; ++ai)
#pragma unroll
        for (int m = 0; m < 4; ++m) { float q = 0.f;
#pragma unroll
            for (int bj = 0; bj < 2; ++bj)
#pragma unroll
                for (int n = 0; n < 2; ++n) { const f32x4 x = v[ai][bj][m][n]; q += (x[0] * x[0] + x[1] * x[1]) + (x[2] * x[2] + x[3] * x[3]); }
            q += __shfl_xor(q, 16); q += __shfl_xor(q, 32);
            if (fq == 0) P[(ai * 128 + wr * 64 + m * 16 + fr) * 4 + wc] = q; }
    asm volatile("s_waitcnt lgkmcnt(0)" ::: "memory"); __builtin_amdgcn_s_barrier(); asm volatile("" ::: "memory");
    int opq = 0; asm volatile("" : "+v"(opq));
    if (lane < 32) { const int row = wid * 32 + lane + opq; const f32x4 a = *(const LAS f32x4*)(P + row * 4);
        const float q = (a[0] + a[1]) + (a[2] + a[3]);
        unsigned long long* w = xw + (size_t)u.pm * 256 + row;
        const unsigned long long inc = (1ull << 56) + (unsigned long long)(q * 1048576.f);
        unsigned long long cur = __hip_atomic_fetch_add(w, inc, __ATOMIC_RELAXED, __HIP_MEMORY_SCOPE_AGENT) + inc;
        unsigned spins = 0;
        while ((cur >> 56) < 8ull) { __builtin_amdgcn_s_sleep(1); cur = __hip_atomic_load(w, __ATOMIC_RELAXED, __HIP_MEMORY_SCOPE_AGENT); if (++spins > (1u << 18)) break; }
        S[row] = rsqrtf((float)(cur & ((1ull << 56) - 1)) * (1.f / (1048576.f * DM)) + EPS); }
    asm volatile("s_waitcnt vmcnt(0) lgkmcnt(0)" ::: "memory"); __builtin_amdgcn_s_barrier(); asm volatile("" ::: "memory");
}
__device__ __forceinline__ void residual_dma(f32x4 (&acc)[2][2][4][2], const float* res, size_t row_base  , int col0, const float* gate, int wr, int wc, int fr, int fq, LAS unsigned char* lds) {
    const int wid = __builtin_amdgcn_readfirstlane(wr * 4 + wc), lane = threadIdx.x & 63;
    LAS unsigned char* wreg = lds + wid * 16384;
    f32x4 gg[2][2];
#pragma unroll
    for (int bj = 0; bj < 2; ++bj) { gg[bj][0] = *(const f32x4*)(gate + col0 + bj * 128); gg[bj][1] = *(const f32x4*)(gate + col0 + bj * 128 + 4); }
#pragma unroll
    for (int ai = 0; ai < 2; ++ai) {
        const float* rb = res + (row_base + ai * 128 + wr * 64 + fr) * DM + col0;
#pragma unroll
        for (int m = 0; m < 4; ++m)
#pragma unroll
            for (int bj = 0; bj < 2; ++bj)
#pragma unroll
                for (int hf = 0; hf < 2; ++hf)
                    __builtin_amdgcn_global_load_lds((const unsigned*)(rb + (size_t)(16 * m) * DM + bj * 128 + 4 * hf), (LAS unsigned*)(wreg + ((m * 2 + bj) * 2 + hf) * 1024), 16, 0, 0);
        asm volatile("s_waitcnt vmcnt(0)" ::: "memory");
#pragma unroll
        for (int m = 0; m < 4; ++m)
#pragma unroll
            for (int bj = 0; bj < 2; ++bj) {
                const f32x4 x0 = *(const LAS f32x4*)(wreg + ((m * 2 + bj) * 2 + 0) * 1024 + lane * 16), x1 = *(const LAS f32x4*)(wreg + ((m * 2 + bj) * 2 + 1) * 1024 + lane * 16);
                acc[ai][bj][m][0] = x0 + gg[bj][0] * acc[ai][bj][m][0]; acc[ai][bj][m][1] = x1 + gg[bj][1] * acc[ai][bj][m][1];
                asm volatile("" : "+v"(acc[ai][bj][m][0]), "+v"(acc[ai][bj][m][1]) :: "memory"); }
        asm volatile("s_waitcnt lgkmcnt(0)" ::: "memory");
    }
}
struct EpiResNorm {
    static constexpr bool PERM = true, MIDK = false, AFTER_DRAIN = true;
    const float* xin; float* x1o; bf16_t* h2o; const float* mod; float* slabs; LAS unsigned char* xl; unsigned long long* xw; unsigned char* pws;
    __device__ __forceinline__ void mid(f32x4 (&)[2][2][4][2], const pg8::Unit&, int, int, int, int) const {}
    __device__ __forceinline__ void finish(f32x4 (&acc)[2][2][4][2], const pg8::Unit& u, int wr, int wc, int fr, int fq) const {
        const int col0 = u.pn * 256 + wc * 32 + 8 * fq;
        const float* md = mod + (size_t)(u.pm >> 4) * NMOD;
        panel_rinv(acc, u, wr, wc, fr, fq, xl, xw);
        probe_mark(4, pws);
        const LAS float* S = (const LAS float*)xl + 1024;
        int opq = 0; asm volatile("" : "+v"(opq));
        const int rl0 = wr * 64 + fr + opq;
#pragma unroll
        for (int bj = 0; bj < 2; ++bj)
#pragma unroll
            for (int n = 0; n < 2; ++n) {
                const int c = col0 + bj * 128 + 4 * n;
                const f32x4 s0 = *(const f32x4*)(md + 4 * DM + c) + 1.f, h0 = *(const f32x4*)(md + 3 * DM + c);
#pragma unroll
                for (int ai = 0; ai < 2; ++ai)
#pragma unroll
                    for (int m = 0; m < 4; ++m) {
                        const int rl = rl0 + ai * 128 + m * 16; const float rv = S[rl];
                        const size_t ro = (size_t)(u.pm * 256 + rl) * DM + c;
                        *(f32x4*)(x1o + ro) = acc[ai][bj][m][n];
                        const f32x4 y = acc[ai][bj][m][n] * rv * s0 + h0; v2u w; w.x = cvt_pk_bf16(y[0], y[1]); w.y = cvt_pk_bf16(y[2], y[3]);
                        *(v2u*)(h2o + ro) = w;
                    }
                asm volatile("" ::: "memory");
            }
    }
    __device__ __forceinline__ void operator()(f32x4 (&acc)[2][2][4][2], const pg8::Unit& u, int wr, int wc, int fr, int fq) const {
        if (u.pm == 32) { slice_store<false>(acc, u, wr, wc, fr, fq, slabs, nullptr); return; }
        const int col0 = u.pn * 256 + wc * 32 + 8 * fq;
        const float* md = mod + (size_t)(u.pm >> 4) * NMOD;
#pragma unroll
        for (int ai = 0; ai < 2; ++ai)
#pragma unroll
            for (int m = 0; m < 4; ++m) {
                const size_t ro = (size_t)(u.pm * 256 + ai * 128 + wr * 64 + m * 16 + fr) * DM;
#pragma unroll
                for (int bj = 0; bj < 2; ++bj) {
                    const int c = col0 + bj * 128;
                    const f32x4 g0 = *(const f32x4*)(md + 2 * DM + c), g1 = *(const f32x4*)(md + 2 * DM + c + 4);
                    const f32x4 x0 = *(const f32x4*)(xin + ro + c), x1 = *(const f32x4*)(xin + ro + c + 4);
                    acc[ai][bj][m][0] = x0 + g0 * acc[ai][bj][m][0]; acc[ai][bj][m][1] = x1 + g1 * acc[ai][bj][m][1];
                }
                asm volatile("" : "+v"(acc[ai][0][m][0]), "+v"(acc[ai][0][m][1]), "+v"(acc[ai][1][m][0]), "+v"(acc[ai][1][m][1]) :: "memory");
            }
        finish(acc, u, wr, wc, fr, fq);
    }
    __device__ __forceinline__ void fused(f32x4 (&acc)[2][2][4][2], const pg8::Unit& u, int wr, int wc, int fr, int fq, LAS unsigned char* lds) const {
        if (u.pm == 32) { slice_store<false>(acc, u, wr, wc, fr, fq, slabs, nullptr); return; }
        probe_mark(2, pws);
        residual_dma(acc, xin, (size_t)u.pm * 256, u.pn * 256 + wc * 32 + 8 * fq, mod + (size_t)(u.pm >> 4) * NMOD + 2 * DM, wr, wc, fr, fq, lds);
        probe_mark(3, pws);
        finish(acc, u, wr, wc, fr, fq);
        probe_mark(5, pws);
    }
};
struct EpiResFinal {
    static constexpr bool PERM = true, MIDK = false, AFTER_DRAIN = true;
    const float* x1i; float* yo; const float* mod; const float* fng; float* slabs; LAS unsigned char* xl; unsigned long long* xw;
    __device__ __forceinline__ void mid(f32x4 (&)[2][2][4][2], const pg8::Unit&, int, int, int, int) const {}
    __device__ __forceinline__ void finish(f32x4 (&acc)[2][2][4][2], const pg8::Unit& u, int wr, int wc, int fr, int fq) const {
        const int col0 = u.pn * 256 + wc * 32 + 8 * fq;
        panel_rinv(acc, u, wr, wc, fr, fq, xl, xw);
        const LAS float* S = (const LAS float*)xl + 1024;
        int opq = 0; asm volatile("" : "+v"(opq));
        const int rl0 = wr * 64 + fr + opq;
#pragma unroll
        for (int bj = 0; bj < 2; ++bj) {
            const int c = col0 + bj * 128;
            const f32x4 f0 = *(const f32x4*)(fng + c), f1 = *(const f32x4*)(fng + c + 4);
#pragma unroll
            for (int ai = 0; ai < 2; ++ai)
#pragma unroll
                for (int m = 0; m < 4; ++m) {
                    const int rl = rl0 + ai * 128 + m * 16; const float rv = S[rl];
                    float* o = yo + (size_t)(u.pm * 256 + rl) * DM + c;
                    *(f32x4*)o = acc[ai][bj][m][0] * rv * f0; *(f32x4*)(o + 4) = acc[ai][bj][m][1] * rv * f1;
                }
            asm volatile("" ::: "memory");
        }
    }
    __device__ __forceinline__ void operator()(f32x4 (&acc)[2][2][4][2], const pg8::Unit& u, int wr, int wc, int fr, int fq) const {
        if (u.pm == 32) { slice_store<false>(acc, u, wr, wc, fr, fq, slabs, nullptr); return; }
        const int col0 = u.pn * 256 + wc * 32 + 8 * fq;
        const float* gp = mod + (size_t)(u.pm >> 4) * NMOD + 5 * DM;
#pragma unroll
        for (int ai = 0; ai < 2; ++ai)
#pragma unroll
            for (int m = 0; m < 4; ++m) {
                const size_t ro = (size_t)(u.pm * 256 + ai * 128 + wr * 64 + m * 16 + fr) * DM;
#pragma unroll
                for (int bj = 0; bj < 2; ++bj) {
                    const int c = col0 + bj * 128;
                    const f32x4 g0 = *(const f32x4*)(gp + c), g1 = *(const f32x4*)(gp + c + 4);
                    const f32x4 x0 = *(const f32x4*)(x1i + ro + c), x1 = *(const f32x4*)(x1i + ro + c + 4);
                    acc[ai][bj][m][0] = x0 + g0 * acc[ai][bj][m][0]; acc[ai][bj][m][1] = x1 + g1 * acc[ai][bj][m][1];
                }
                asm volatile("" : "+v"(acc[ai][0][m][0]), "+v"(acc[ai][0][m][1]), "+v"(acc[ai][1][m][0]), "+v"(acc[ai][1][m][1]) :: "memory");
            }
        finish(acc, u, wr, wc, fr, fq);
    }
    __device__ __forceinline__ void fused(f32x4 (&acc)[2][2][4][2], const pg8::Unit& u, int wr, int wc, int fr, int fq, LAS unsigned char* lds) const {
        if (u.pm == 32) { slice_store<false>(acc, u, wr, wc, fr, fq, slabs, nullptr); return; }
        residual_dma(acc, x1i, (size_t)u.pm * 256, u.pn * 256 + wc * 32 + 8 * fq, mod + (size_t)(u.pm >> 4) * NMOD + 5 * DM, wr, wc, fr, fq, lds);
        finish(acc, u, wr, wc, fr, fq);
    }
};
struct EpiGU {
    static constexpr bool PERM = true, MIDK = false, AFTER_DRAIN = false;
    bf16_t* O;
    __device__ __forceinline__ void mid(f32x4 (&)[2][2][4][2], const pg8::Unit&, int, int, int, int) const {}
    __device__ __forceinline__ void operator()(const f32x4 (&acc)[2][2][4][2], const pg8::Unit& u, int wr, int wc, int fr, int fq) const {
        const int col0 = u.pn * 128 + wc * 32 + 8 * fq;
#pragma unroll
        for (int ai = 0; ai < 2; ++ai)
#pragma unroll
            for (int m = 0; m < 4; ++m) {
                const size_t row = (size_t)u.pm * 256 + ai * 128 + wr * 64 + m * 16 + fr;
                f32x4 o0, o1;
#pragma unroll
                for (int e = 0; e < 4; ++e) { const float g0 = acc[ai][0][m][0][e], g1 = acc[ai][0][m][1][e];
                    o0[e] = g0 * sigm(g0) * acc[ai][1][m][0][e]; o1[e] = g1 * sigm(g1) * acc[ai][1][m][1][e]; }
                *(v4u*)(O + row * DFF + col0) = pack8bf(o0, o1);
            }
    }
};

namespace att {
constexpr int NW = 8, QBLK = 32, KVBLK = 64, QB = NW * QBLK, D = 128, LDQ = 2048, LDO = 4096;
constexpr int SHM_V = KVBLK * D * 2, SHM_K = KVBLK * D * 2;
constexpr int LDS_BYTES = 2 * SHM_V + 2 * SHM_K + NW * 64 * 4;
constexpr int BIAS_OFF = LDS_BYTES;
constexpr float THR = 8.f;
constexpr float LOG2E = 1.4426950408889634f;
#define KSWZ(row, colB) ((row) * 256 + ((colB) ^ (((row) & 7) << 4)))
#define SBAR() __builtin_amdgcn_sched_barrier(0)
__device__ __forceinline__ int v_st(int k, int c) { const int kk = (k & ~0xC) | ((k & 4) << 1) | ((k & 8) >> 1); return ((kk >> 3) * 4 + (c >> 5)) * 512 + ((kk & 7) * 32 + (c & 31)) * 2; }
__device__ __forceinline__ int v_rd_base(int lane) { return ((lane & 3) << 3) | (((lane >> 2) & 3) << 6) | (((lane >> 4) & 1) << 5) | (((lane >> 5) & 1) << 8); }
constexpr int v_rd_off(int d0, int ks, int half) { return d0 * 512 + ks * 4096 + half * 2048; }
__device__ __forceinline__ int crow(int r, int hi) { return (r & 3) + 8 * (r >> 2) + 4 * hi; }
__device__ __forceinline__ unsigned cvtpk(float lo, float hi) { return cvt_pk_bf16(lo, hi); }
__device__ __forceinline__ bf16x8 load8(const bf16_t* p) { return *reinterpret_cast<const bf16x8*>(p); }
__device__ __forceinline__ int jlo(int qb) { const int j = 4 * qb - 8; return j > 0 ? j : 0; }
__device__ __forceinline__ void bias_tile(f32x16& p0, f32x16& p1, int dq, int dlo, const float* bl) {
    if (dlo - 63 >= 256) { const float bf = bl[319];
#pragma unroll
        for (int r = 0; r < 16; ++r) { p0[r] = fmaf(p0[r], ATT_SCALE, bf); p1[r] = fmaf(p1[r], ATT_SCALE, bf); }
    } else if (dlo + 31 <= 256) {
        const float* bq = bl + dq;
#pragma unroll
        for (int r = 0; r < 16; ++r) { const int c = (r & 3) + 8 * (r >> 2);
            p0[r] = fmaf(p0[r], ATT_SCALE, bq[63 - c]); p1[r] = fmaf(p1[r], ATT_SCALE, bq[31 - c]); }
    } else {
#pragma unroll
        for (int r = 0; r < 16; ++r) { const int c = (r & 3) + 8 * (r >> 2);
            int d0 = dq - c; d0 = d0 > 256 ? 256 : d0; int d1 = dq - c - 32; d1 = d1 > 256 ? 256 : d1;
            p0[r] = fmaf(p0[r], ATT_SCALE, bl[d0 + 63]); p1[r] = fmaf(p1[r], ATT_SCALE, bl[d1 + 63]); }
    }
}
__device__ __forceinline__ void partialSM(f32x16& p0, f32x16& p1, float& m_reg, float& mn, float& alpha) {
    float pmax = p0[0];
#pragma unroll
    for (int r = 1; r < 16; ++r) pmax = fmaxf(pmax, p0[r]);
#pragma unroll
    for (int r = 0; r < 16; ++r) pmax = fmaxf(pmax, p1[r]);
    { auto rr = __builtin_amdgcn_permlane32_swap(__float_as_uint(pmax), __float_as_uint(pmax), false, false);
      pmax = fmaxf(__uint_as_float(rr[0]), __uint_as_float(rr[1])); }
    if (__builtin_expect(__all((pmax - m_reg) <= THR), 1)) { mn = m_reg; alpha = 1.f; }
    else { mn = fmaxf(m_reg, pmax); alpha = __builtin_amdgcn_exp2f((m_reg - mn) * LOG2E); m_reg = mn; }
    const float mnL = -mn * LOG2E;
#pragma unroll
    for (int r = 0; r < 16; ++r) p0[r] = fmaf(p0[r], LOG2E, mnL);
#pragma unroll
    for (int r = 0; r < 16; ++r) p1[r] = fmaf(p1[r], LOG2E, mnL);
#pragma unroll
    for (int r = 0; r < 16; ++r) p0[r] = __builtin_amdgcn_exp2f(p0[r]);
}
__device__ __forceinline__ void finishSM(f32x16& p0, f32x16& p1, float alpha, float& l_reg, bf16x8& pa0, bf16x8& pa1, bf16x8& pa2, bf16x8& pa3) {
#pragma unroll
    for (int r = 0; r < 16; ++r) p1[r] = __builtin_amdgcn_exp2f(p1[r]);
    float ps = 0;
#pragma unroll
    for (int r = 0; r < 16; ++r) ps += p0[r];
#pragma unroll
    for (int r = 0; r < 16; ++r) ps += p1[r];
    { auto rr = __builtin_amdgcn_permlane32_swap(__float_as_uint(ps), __float_as_uint(ps), false, false);
      ps = __uint_as_float(rr[0]) + __uint_as_float(rr[1]); }
    l_reg = l_reg * alpha + ps;
#define PK4(P, B_, OUT) do { unsigned a0 = cvtpk(P[B_+0], P[B_+1]), a1 = cvtpk(P[B_+2], P[B_+3]);                          \
        unsigned b0 = cvtpk(P[B_+4], P[B_+5]), b1 = cvtpk(P[B_+6], P[B_+7]);                                             \
        auto r0 = __builtin_amdgcn_permlane32_swap(a0, b0, false, false); auto r1 = __builtin_amdgcn_permlane32_swap(a1, b1, false, false); \
        v4u w = {r0[0], r1[0], r0[1], r1[1]}; OUT = *reinterpret_cast<bf16x8*>(&w); } while (0)
    PK4(p0, 0, pa0); PK4(p0, 8, pa1); PK4(p1, 0, pa2); PK4(p1, 8, pa3);
#undef PK4
}
template <int KB>
__device__ __forceinline__ void qkt(f32x16& p0, f32x16& p1, const char* K_lds, int r32, int hi, const bf16x8* qr, bool act) {
    if (!act) { const float NEG = -__builtin_inff();
#pragma unroll
        for (int r = 0; r < 16; ++r) { p0[r] = NEG; p1[r] = NEG; } return; }
    p0 = f32x16{}; p1 = f32x16{};
    const char* kb[4];
#pragma unroll
    for (int dd = 0; dd < 4; ++dd) kb[dd] = K_lds + KB * SHM_K + KSWZ(r32, (dd * 16 + hi * 8) * 2);
#pragma unroll
    for (int d0 = 0; d0 < 8; ++d0) { const char* a = kb[d0 & 3] + (d0 >> 2) * 128;
        bf16x8 b0 = *reinterpret_cast<const bf16x8*>(a);
        bf16x8 b1 = *reinterpret_cast<const bf16x8*>(a + 32 * 256);
        p0 = __builtin_amdgcn_mfma_f32_32x32x16_bf16(b0, qr[d0], p0, 0, 0, 0);
        p1 = __builtin_amdgcn_mfma_f32_32x32x16_bf16(b1, qr[d0], p1, 0, 0, 0); }
}
template <int VB>
__device__ __forceinline__ void pv_tile(f32x16* o, int vb0, bf16x8 pa0, bf16x8 pa1, bf16x8 pa2, bf16x8 pa3, bool act) {
    if (!act) return;
#define TRRD(dst, off) asm volatile("ds_read_b64_tr_b16 %0, %1 offset:%2" : "=&v"(dst) : "v"(vb0), "i"(off) : "memory")
#define PV_D0(d0) do { s16x4 l0, l1, l2, l3, h0, h1, h2, h3; constexpr int b_ = VB * SHM_V + v_rd_off(d0, 0, 0); \
        TRRD(l0, b_); TRRD(h0, b_ + 2048); TRRD(l1, b_ + 4096); TRRD(h1, b_ + 6144); TRRD(l2, b_ + 8192); TRRD(h2, b_ + 10240); TRRD(l3, b_ + 12288); TRRD(h3, b_ + 14336); \
        asm volatile("s_waitcnt lgkmcnt(0)" ::: "memory"); SBAR();   \
        o[d0] = __builtin_amdgcn_mfma_f32_32x32x16_bf16(pa0, (bf16x8){l0[0], l0[1], l0[2], l0[3], h0[0], h0[1], h0[2], h0[3]}, o[d0], 0, 0, 0);   \
        o[d0] = __builtin_amdgcn_mfma_f32_32x32x16_bf16(pa1, (bf16x8){l1[0], l1[1], l1[2], l1[3], h1[0], h1[1], h1[2], h1[3]}, o[d0], 0, 0, 0);   \
        o[d0] = __builtin_amdgcn_mfma_f32_32x32x16_bf16(pa2, (bf16x8){l2[0], l2[1], l2[2], l2[3], h2[0], h2[1], h2[2], h2[3]}, o[d0], 0, 0, 0);   \
        o[d0] = __builtin_amdgcn_mfma_f32_32x32x16_bf16(pa3, (bf16x8){l3[0], l3[1], l3[2], l3[3], h3[0], h3[1], h3[2], h3[3]}, o[d0], 0, 0, 0); } while (0)
    PV_D0(0); PV_D0(1); PV_D0(2); PV_D0(3);
#undef PV_D0
#undef TRRD
}
struct BlockRef { const bf16_t* Q; const bf16_t* K; const bf16_t* V; bf16_t* O; int qb; int h; };
struct Seam { bf16x8 qr[8]; bf16x8 st_v0, st_v1, st_k0, st_k1; };
#define ROW(p, k0, rr) ((p) + (size_t)((k0) + (rr)) * LDQ + sc)
#define VMW() asm volatile("s_waitcnt vmcnt(0)" ::: "memory")
#define VMWN(n) asm volatile("s_waitcnt vmcnt(%0)" :: "i"(n) : "memory")
#define SLOAD_H(Kp, Vp, k0) do { S.st_v0 = load8(ROW(Vp, k0, sr)); S.st_v1 = load8(ROW(Vp, k0, 32 + sr));              \
                         S.st_k0 = load8(ROW(Kp, k0, sr)); S.st_k1 = load8(ROW(Kp, k0, 32 + sr)); } while (0)
#define SWRITE_HK(bf) do { *(bf16x8*)(K_lds + (bf) * SHM_K + kws) = S.st_k0; *(bf16x8*)(K_lds + (bf) * SHM_K + kws + 32 * 256) = S.st_k1; } while (0)
#define SWRITE_HV(bf) do { *(bf16x8*)(V_lds + (bf) * SHM_V + vst0) = S.st_v0; *(bf16x8*)(V_lds + (bf) * SHM_V + vst1) = S.st_v1; } while (0)
#define SWRITE_H(bf) do { SWRITE_HV(bf); SWRITE_HK(bf); } while (0)
__device__ __forceinline__ void att_prime(const BlockRef& cur, char* lds, Seam& S) {
    const int tid = threadIdx.x, wid = __builtin_amdgcn_readfirstlane(tid >> 6), lane = tid & 63, r32 = lane & 31, hi = lane >> 5;
    const int sr = tid >> 4, sc = (tid & 15) * 8, kws = KSWZ(sr, sc * 2); char* K_lds = lds + 2 * SHM_V;
    const int kb0 = jlo(cur.qb) * KVBLK;
#pragma unroll
    for (int d0 = 0; d0 < 8; ++d0) S.qr[d0] = load8(cur.Q + (size_t)(wid * QBLK + r32) * LDQ + d0 * 16 + hi * 8);
    SLOAD_H(cur.K, cur.V, kb0); VMW(); SWRITE_HK(0);
    __syncthreads();
}
__device__ __forceinline__ void att_block(const BlockRef& cur, const BlockRef& nxt, char* lds, Seam& S) {
    const int tid = threadIdx.x, wid = __builtin_amdgcn_readfirstlane(tid >> 6), lane = tid & 63, r32 = lane & 31, hi = lane >> 5;
    const int j_lo = jlo(cur.qb), j_hi = 4 * cur.qb + 4;
    const int NT = j_hi - j_lo;
    const int kbn = jlo(nxt.qb) * KVBLK;
    const int cq = 4 * cur.qb + (wid >> 1);
    const int qlo = cur.qb * QB + wid * QBLK, qpos = qlo + r32;
    const float* bl = (const float*)(lds + BIAS_OFF) + cur.h * 320;
    char* V_lds = lds; char* K_lds = lds + 2 * SHM_V;
    float* ws = (float*)(lds + 2 * SHM_V + 2 * SHM_K) + wid * 64; float* li_l = ws, * al_l = ws + 32;
    float m_reg = -1e30f, l_reg = 0; f32x16 o[4] = {};
    const int sr = tid >> 4, sc = (tid & 15) * 8, vst0 = v_st(sr, sc), vst1 = v_st(32 + sr, sc), kws = KSWZ(sr, sc * 2);
    const int vb0 = (int)(uintptr_t)V_lds + v_rd_base(lane);
    const bf16_t* Kh = cur.K; const bf16_t* Vh = cur.V;
#define RESC(a) do { if (__any((a) < 1.f)) { if (hi == 0) al_l[r32] = (a); asm volatile("s_waitcnt lgkmcnt(0)" ::: "memory");              \
                     for (int d_ = 0; d_ < 4; ++d_) for (int r = 0; r < 16; ++r) o[d_][r] *= al_l[crow(r, hi)]; } } while (0)
#define KBASE(t) ((j_lo + (t)) * KVBLK)
#define ACT(t) ((j_lo + (t)) <= cq && (j_lo + (t)) + 8 >= cq)
#define BIAST(P0_, P1_, t) do { if (ACT(t)) bias_tile(P0_, P1_, qpos - KBASE(t) - 4 * hi, qlo - KBASE(t), bl); } while (0)
    constexpr int NQL = 8;
#define SEAM_K0() do { VMWN(NQL); SWRITE_HK(0); SBAR(); } while (0)
    f32x16 pA0, pA1, pB0, pB1; float mnA, mnB, alA, alB; bf16x8 pa0, pa1, pa2, pa3;
    SWRITE_HV(0); SBAR();
    if (NT > 1) { SLOAD_H(Kh, Vh, KBASE(1)); }
    SBAR(); qkt<0>(pA0, pA1, K_lds, r32, hi, S.qr, ACT(0));
    BIAST(pA0, pA1, 0); partialSM(pA0, pA1, m_reg, mnA, alA);
    if (NT > 1) { VMW(); SWRITE_H(1); }
    __syncthreads();
#define HALF_STEP(PX0, PX1, mnX, alX, PY0, PY1, alY, t, KB, VB, SB) do {                                                      \
        SBAR(); qkt<KB>(PX0, PX1, K_lds, r32, hi, S.qr, ACT(t));                                             \
        finishSM(PY0, PY1, alY, l_reg, pa0, pa1, pa2, pa3); SBAR();                                                           \
        if ((t) + 1 < NT) { SLOAD_H(Kh, Vh, KBASE((t) + 1)); SBAR(); }                                               \
        pv_tile<VB>(o, vb0, pa0, pa1, pa2, pa3, ACT((t) - 1)); BIAST(PX0, PX1, (t)); partialSM(PX0, PX1, m_reg, mnX, alX);                                        \
        __syncthreads();                                                                                                      \
        if ((t) + 1 < NT) { VMW(); SWRITE_H(SB); }                                                                          \
        RESC(alX); __syncthreads(); } while (0)
    for (int t = 1; t + 1 < NT; t += 2) {
        HALF_STEP(pB0, pB1, mnB, alB, pA0, pA1, alA, t, 1, 0, 0);
        HALF_STEP(pA0, pA1, mnA, alA, pB0, pB1, alB, t + 1, 0, 1, 1);
    }
    const bool even = (NT & 1) == 0;
    if (even) { SBAR(); qkt<1>(pB0, pB1, K_lds, r32, hi, S.qr, ACT(NT - 1)); SBAR(); }
    SLOAD_H(nxt.K, nxt.V, kbn); SBAR();
#pragma unroll
    for (int d0 = 0; d0 < 8; ++d0) S.qr[d0] = load8(nxt.Q + (size_t)(wid * QBLK + r32) * LDQ + d0 * 16 + hi * 8);
    SBAR();
    finishSM(pA0, pA1, alA, l_reg, pa0, pa1, pa2, pa3); SBAR();
    pv_tile<0>(o, vb0, pa0, pa1, pa2, pa3, ACT(even ? NT - 2 : NT - 1));
    if (even) { BIAST(pB0, pB1, NT - 1); partialSM(pB0, pB1, m_reg, mnB, alB); __syncthreads(); RESC(alB);
        finishSM(pB0, pB1, alB, l_reg, pa0, pa1, pa2, pa3); SBAR(); pv_tile<1>(o, vb0, pa0, pa1, pa2, pa3, ACT(NT - 1)); }
    SBAR(); SEAM_K0();
    if (hi == 0) li_l[r32] = l_reg; asm volatile("s_waitcnt lgkmcnt(0)" ::: "memory");
    float rli[16];
#pragma unroll
    for (int r = 0; r < 16; ++r) rli[r] = __builtin_amdgcn_rcpf(li_l[crow(r, hi)]);
    bf16_t* Ow = cur.O + (size_t)(wid * QBLK) * LDO;
#pragma unroll
    for (int r = 0; r < 16; ++r) { const int orow = crow(r, hi);
#pragma unroll
        for (int d0 = 0; d0 < 4; ++d0) { const float v = o[d0][r] * rli[r];
            const float vn = __shfl_xor(v, 1);
            if ((r32 & 1) == 0) *(unsigned*)(Ow + (size_t)orow * LDO + d0 * 32 + r32) = cvtpk(v, vn); } }
    __syncthreads();
#undef RESC
#undef KBASE
#undef ACT
#undef BIAST
#undef SEAM_K0
#undef HALF_STEP
}
#undef ROW
#undef VMW
#undef VMWN
#undef SLOAD_H
#undef SWRITE_HK
#undef SWRITE_HV
#undef SWRITE_H
#undef SBAR
#undef KSWZ
}

#define XB_TMO      128
#define XB_XCNT(j)  (256  + 64 * (j))
#define XB_XSUB(j)  (1280 + 64 * (j))
#define XB_XGEN(j)  (2304 + 64 * (j))
#define XB_TOP      3328
#define XB_TOPGEN   3392
#define XCD_BAR_WORDS 3456
#define XB_SPIN_CAP (1u << 18)
__device__ __forceinline__ unsigned xb_ld(unsigned* p)              { return __hip_atomic_load(p, __ATOMIC_RELAXED, __HIP_MEMORY_SCOPE_AGENT); }
__device__ __forceinline__ unsigned xb_add(unsigned* p, unsigned v) { return __hip_atomic_fetch_add(p, v, __ATOMIC_RELAXED, __HIP_MEMORY_SCOPE_AGENT); }
__device__ __forceinline__ unsigned xb_xcc_id() { return (unsigned)__builtin_amdgcn_s_getreg((3 << 11) | 20) & 0xFu; }
#define XB_SPIN(cond, bar) do { unsigned _sp = 0; while (cond) { __builtin_amdgcn_s_sleep(1); \
    if ((++_sp & 255u) == 0u) { if (xb_ld(&(bar)[XB_TMO])) break; if (_sp > XB_SPIN_CAP) { atomicAdd(&(bar)[XB_TMO], 1u); break; } } } } while (0)
struct XcdBarrier { unsigned* bar; unsigned x; volatile LAS unsigned* st; };
__device__ __forceinline__ XcdBarrier xcd_barrier_post(unsigned* bar, volatile LAS unsigned* st) {
    XcdBarrier b; b.bar = bar; b.x = xb_xcc_id(); b.st = st;
    if (threadIdx.x == 0) (void)xb_add(&bar[XB_XCNT(b.x)], 1u);
    return b;
}
__device__ __forceinline__ void xcd_barrier_complete(unsigned* bar, unsigned x, unsigned& nloc, unsigned& nx) {
    const unsigned G = gridDim.x * gridDim.y * gridDim.z;
    unsigned sum, cnt, mine, sp = 0u;
    for (;;) {
        sum = 0u; cnt = 0u; mine = 0u;
#pragma unroll
        for (unsigned j = 0; j < 16; ++j) { const unsigned c = xb_ld(&bar[XB_XCNT(j)]); sum += c; cnt += (c > 0u) ? 1u : 0u; mine = (j == x) ? c : mine; }
        if (sum == G) break;
        __builtin_amdgcn_s_sleep(1);
        if ((++sp & 255u) == 0u) { if (xb_ld(&bar[XB_TMO])) break; if (sp > XB_SPIN_CAP) { atomicAdd(&bar[XB_TMO], 1u); break; } }
    }
    nloc = mine > 0u ? mine : 1u; nx = cnt > 0u ? cnt : 1u;
}
__device__ __forceinline__ void xcd_barrier(const XcdBarrier& b) {
    asm volatile("s_waitcnt vmcnt(0)" ::: "memory");
    __syncthreads();
    if (threadIdx.x == 0) {
        unsigned* bar = b.bar;
        __builtin_amdgcn_s_waitcnt(0);
        unsigned nloc = b.st[0], nx = b.st[1];
        if (nloc == 0u) { xcd_barrier_complete(bar, b.x, nloc, nx); b.st[0] = nloc; b.st[1] = nx; }
        const unsigned old = xb_add(&bar[XB_XSUB(b.x)], 1u);
        const unsigned gen = old / nloc;
        if (old + 1u == (gen + 1u) * nloc) {
            __builtin_amdgcn_fence(__ATOMIC_RELEASE, "agent");
            asm volatile("s_waitcnt vmcnt(0)" ::: "memory");
            const unsigned og = xb_add(&bar[XB_TOP], 1u);
            const unsigned tg = og / nx;
            if (og + 1u == (tg + 1u) * nx) xb_add(&bar[XB_TOPGEN], 1u);
            else XB_SPIN(xb_ld(&bar[XB_TOPGEN]) == tg, bar);
            __builtin_amdgcn_fence(__ATOMIC_ACQUIRE, "agent");
            xb_add(&bar[XB_XGEN(b.x)], 1u);
            asm volatile("s_waitcnt vmcnt(0)" ::: "memory");
        } else {
            XB_SPIN(xb_ld(&bar[XB_XGEN(b.x)]) == gen, bar);
            __builtin_amdgcn_fence(__ATOMIC_ACQUIRE, "agent");
            asm volatile("s_waitcnt vmcnt(0)" ::: "memory");
        }
    }
    __syncthreads();
}

struct Args { const float* in[26]; float* out; unsigned char* ws; int ph_lo, ph_hi; };
__device__ __forceinline__ const float* arg_ptr(int k) { int o = k * 8; asm volatile("" : "+s"(o)); return *(const float* const*)((const char*)__builtin_amdgcn_kernarg_segment_ptr() + o); }
struct Frame {
    LAS unsigned char* lds;
    int tid, lane, wave, vcu, G;
    float* out; unsigned char* ws;
    __device__ __forceinline__ const float* x_prompt() const { return arg_ptr(0); }
    __device__ __forceinline__ const float* x_sample() const { return arg_ptr(1); }
    __device__ __forceinline__ const float* c_prompt() const { return arg_ptr(2); }
    __device__ __forceinline__ const float* c_sample() const { return arg_ptr(3); }
    __device__ __forceinline__ const float* cache_k() const { return arg_ptr(4); }
    __device__ __forceinline__ const float* cache_v() const { return arg_ptr(5); }
    __device__ __forceinline__ const float* st_h() const { return arg_ptr(6); }
    __device__ __forceinline__ const float* st_conv() const { return arg_ptr(7); }
    __device__ __forceinline__ const float* w_mod() const { return arg_ptr(8); }
    __device__ __forceinline__ const float* b_mod() const { return arg_ptr(9); }
    __device__ __forceinline__ const float* w_in() const { return arg_ptr(10); }
    __device__ __forceinline__ const float* rel_bias() const { return arg_ptr(11); }
    __device__ __forceinline__ const float* conv_w() const { return arg_ptr(12); }
    __device__ __forceinline__ const float* conv_b() const { return arg_ptr(13); }
    __device__ __forceinline__ const float* w_rg_a() const { return arg_ptr(14); }
    __device__ __forceinline__ const float* b_rg_a() const { return arg_ptr(15); }
    __device__ __forceinline__ const float* w_rg_x() const { return arg_ptr(16); }
    __device__ __forceinline__ const float* b_rg_x() const { return arg_ptr(17); }
    __device__ __forceinline__ const float* rg_lambda() const { return arg_ptr(18); }
    __device__ __forceinline__ const float* w_pa() const { return arg_ptr(19); }
    __device__ __forceinline__ const float* w_pr() const { return arg_ptr(20); }
    __device__ __forceinline__ const float* w_out() const { return arg_ptr(21); }
    __device__ __forceinline__ const float* w_gate() const { return arg_ptr(22); }
    __device__ __forceinline__ const float* w_up() const { return arg_ptr(23); }
    __device__ __forceinline__ const float* w_down() const { return arg_ptr(24); }
    __device__ __forceinline__ const float* fng() const { return arg_ptr(25); }
    __device__ __forceinline__ float* mod() const { return (float*)(ws + WS_MOD); }
    __device__ __forceinline__ float* x1() const { return (float*)(ws + WS_OY); }
    __device__ __forceinline__ float* slab4() const { return (float*)(ws + WS_SLAB4); }
    __device__ __forceinline__ float* slab6() const { return (float*)(ws + WS_SLAB6); }
    __device__ __forceinline__ float* slab9() const { return (float*)(ws + WS_SLAB9); }
    __device__ __forceinline__ bf16_t* Win_t() const { return (bf16_t*)(ws + WS_WIN); }
    __device__ __forceinline__ bf16_t* Wproj_t() const { return (bf16_t*)(ws + WS_WPROJ); }
    __device__ __forceinline__ bf16_t* Wout_t() const { return (bf16_t*)(ws + WS_WOUT); }
    __device__ __forceinline__ bf16_t* Wgu_t() const { return (bf16_t*)(ws + WS_WGU); }
    __device__ __forceinline__ bf16_t* Wdn_t() const { return (bf16_t*)(ws + WS_WDN); }
    __device__ __forceinline__ bf16_t* Wrg_t() const { return (bf16_t*)(ws + WS_WRG); }
    __device__ __forceinline__ bf16_t* H1() const { return (bf16_t*)(ws + WS_H1); }
    __device__ __forceinline__ bf16_t* Qb() const { return (bf16_t*)(ws + WS_Q); }
    __device__ __forceinline__ bf16_t* Kb() const { return (bf16_t*)(ws + WS_K); }
    __device__ __forceinline__ bf16_t* Vb() const { return (bf16_t*)(ws + WS_V); }
    __device__ __forceinline__ bf16_t* Ub() const { return (bf16_t*)(ws + WS_U); }
    __device__ __forceinline__ bf16_t* Gb() const { return (bf16_t*)(ws + WS_G); }
    __device__ __forceinline__ bf16_t* SAb() const { return (bf16_t*)(ws + WS_SA); }
    __device__ __forceinline__ bf16_t* SRb() const { return (bf16_t*)(ws + WS_SR); }
    __device__ __forceinline__ bf16_t* OY() const { return (bf16_t*)(ws + WS_OY); }
    __device__ __forceinline__ bf16_t* MG() const { return (bf16_t*)(ws + WS_MERGED); }
    __device__ __forceinline__ bf16_t* ACT() const { return (bf16_t*)(ws + WS_ACT); }
    __device__ __forceinline__ gu64* gran() const { return (gu64*)(ws + WS_GRAN); }
    __device__ __forceinline__ void refresh() { int t = threadIdx.x; asm volatile("" : "+v"(t)); tid = t; lane = t & 63; wave = __builtin_amdgcn_readfirstlane(t >> 6); }
};

__device__ __forceinline__ void xpose_item(const float* W, int N, bf16_t* WT, size_t ldo, int k0, int n0, int drow0, int dcol0, LAS float* scr, int lane) {
#pragma unroll 8
    for (int i = 0; i < 32; ++i) { const int kk = 2 * i + (lane >> 5); scr[kk * 33 + (lane & 31)] = W[(size_t)(k0 + kk) * N + n0 + (lane & 31)]; }
    LDS_WAIT(); asm volatile("" ::: "memory");
    const int c = lane & 7;
#pragma unroll
    for (int j = 0; j < 4; ++j) { const int n = (lane >> 3) + 8 * j; const LAS float* s = scr + (8 * c) * 33 + n;
        v4u o; o.x = pk2(s[0 * 33], s[1 * 33]); o.y = pk2(s[2 * 33], s[3 * 33]); o.z = pk2(s[4 * 33], s[5 * 33]); o.w = pk2(s[6 * 33], s[7 * 33]);
        *(GAS v4u*)(WT + (size_t)(drow0 + n) * ldo + dcol0 + 8 * c) = o; }
    LDS_WAIT(); asm volatile("" ::: "memory");
}
__device__ __forceinline__ void norm_regs_bf16(const f32x4 (&v)[8], const float* shift, const float* scale, bf16_t* orow, int lane) {
    f32x4 sc[8], sh[8];
#pragma unroll
    for (int j = 0; j < 8; ++j) { sc[j] = *((const GAS f32x4*)scale + lane + 64 * j); sh[j] = *((const GAS f32x4*)shift + lane + 64 * j); }
    float s = 0.f;
#pragma unroll
    for (int j = 0; j < 8; ++j) s += (v[j].x * v[j].x + v[j].y * v[j].y) + (v[j].z * v[j].z + v[j].w * v[j].w);
    const float rinv = rsqrtf(wave_sum(s) * (1.f / DM) + EPS);
    GAS v2u* o8 = (GAS v2u*)orow + lane;
#pragma unroll
    for (int j = 0; j < 8; ++j) { const f32x4 y = v[j] * rinv * (sc[j] + 1.f) + sh[j]; v2u w; w.x = pk2(y.x, y.y); w.y = pk2(y.z, y.w); o8[64 * j] = w; }
}
__device__ __forceinline__ void load_row(f32x4 (&v)[8], const float* row, int lane) {
    const GAS f32x4* xr = (const GAS f32x4*)row + lane;
#pragma unroll
    for (int j = 0; j < 8; ++j) v[j] = xr[64 * j];
}
__device__ __forceinline__ void phase0(Frame& F, bool dry = false) {
    const float* p_cp = F.c_prompt(); const float* p_cs = F.c_sample(); const float* p_wm = F.w_mod(); const float* p_bm = F.b_mod(); float* p_mod = F.mod(); const float* p_win = F.w_in(); bf16_t* p_wint = F.Win_t();
    { gu64* g = F.gran(); for (size_t i = (size_t)F.vcu * 512 + F.tid; i < 3 * 131072; i += (size_t)F.G * 512) g[i] = 0ull; }
    LAS float* sc = (LAS float*)(F.lds);
    LAS float* red = (LAS float*)(F.lds + 8192);
    for (int it = F.vcu; it < 768; it += F.G) {
        const int nc = it % 48, ks = it / 48;
        for (int i = F.tid; i < 1280; i += 512) { const int b = i >> 7, k = ks * 128 + (i & 127);
            const float cv = b < 2 ? p_cp[b * DM + k] : p_cs[(b - 2) * DM + k];
            sc[i] = cv * sigm(cv); }
        __syncthreads();
        f32x4 acc[10];
#pragma unroll
        for (int b = 0; b < 10; ++b) acc[b] = (f32x4){0.f, 0.f, 0.f, 0.f};
        const float* wp = p_wm + (size_t)(ks * 128 + F.wave * 16) * NMOD + nc * 256 + 4 * F.lane;
#pragma unroll 4
        for (int kk = 0; kk < 16; ++kk) { const f32x4 w = *(const GAS f32x4*)(wp + (size_t)kk * NMOD);
#pragma unroll
            for (int b = 0; b < 10; ++b) { const float s = sc[b * 128 + F.wave * 16 + kk]; acc[b] += w * s; } }
#pragma unroll
        for (int b = 0; b < 10; ++b) *(LAS f32x4*)(red + (F.wave * 10 + b) * 256 + 4 * F.lane) = acc[b];
        __syncthreads();
        for (int o = F.tid; o < 2560; o += 512) { const int b = o >> 8, col = o & 255; float s = 0.f;
#pragma unroll
            for (int w = 0; w < 8; ++w) s += red[(w * 10 + b) * 256 + col];
            if (ks == 0) s += p_bm[nc * 256 + col];
            if (!dry) atomicAdd(p_mod + (size_t)b * NMOD + nc * 256 + col, s); }
        __syncthreads();
    }
    LAS float* scr = (LAS float*)(F.lds + F.wave * 16384);
    const int gw = F.vcu * NWAVES + F.wave, NGW = F.G * NWAVES;
    for (int it = gw; it < 32 * 448; it += NGW) { const int kb = it / 448, nb = it % 448;
        xpose_item(p_win, NIN, p_wint, DM, kb * 64, nb * 32, nb * 32, kb * 64, scr, F.lane); }
}
constexpr int I_P = 32 * 64, I_G = 32 * 176, I_D = 88 * 64, I_R = 256;
constexpr int NITEMS_A = 3 * I_P + I_R, NITEMS_B = 2 * I_G + I_D;
__device__ __forceinline__ void conv_item_a(Frame& F, int r, LAS float* scr) {
    if (r < I_P) { const int kb = r / 64, nb = r % 64; xpose_item(F.w_pa(), DM, F.Wproj_t(), 4096, kb * 64, nb * 32, nb * 32, kb * 64, scr, F.lane); return; } r -= I_P;
    if (r < I_P) { const int kb = r / 64, nb = r % 64; xpose_item(F.w_pr(), DM, F.Wproj_t(), 4096, kb * 64, nb * 32, nb * 32, 2048 + kb * 64, scr, F.lane); return; } r -= I_P;
    if (r < I_P) { const int kb = r / 64, nb = r % 64; xpose_item(F.w_out(), DM, F.Wout_t(), DM, kb * 64, nb * 32, nb * 32, kb * 64, scr, F.lane); return; } r -= I_P;
    { const int mat = r >> 3, sub = r & 7, kb = sub >> 2, nb = sub & 3;
      const float* src = (mat < 16 ? F.w_rg_a() : F.w_rg_x()) + (size_t)(mat & 15) * 16384;
      xpose_item(src, 128, F.Wrg_t() + (size_t)mat * 16384, 128, kb * 64, nb * 32, nb * 32, kb * 64, scr, F.lane); }
}
__device__ __forceinline__ void conv_item_b(Frame& F, int r, LAS float* scr) {
    if (r < I_G) { const int kb = r / 176, nb = r % 176, n0 = nb * 32; xpose_item(F.w_gate(), DFF, F.Wgu_t(), DM, kb * 64, n0, (n0 >> 7) * 256 + (n0 & 127), kb * 64, scr, F.lane); return; } r -= I_G;
    if (r < I_G) { const int kb = r / 176, nb = r % 176, n0 = nb * 32; xpose_item(F.w_up(), DFF, F.Wgu_t(), DM, kb * 64, n0, (n0 >> 7) * 256 + 128 + (n0 & 127), kb * 64, scr, F.lane); return; } r -= I_G;
    { const int kb = r / 64, nb = r % 64; xpose_item(F.w_down(), DM, F.Wdn_t(), DFF, kb * 64, nb * 32, nb * 32, kb * 64, scr, F.lane); }
}
__device__ __forceinline__ void phase1(Frame& F) {
    const float* p_xp = F.x_prompt(); const float* p_xs = F.x_sample(); const float* p_mod = F.mod(); bf16_t* p_H1 = F.H1(); const float* p_sl6 = F.slab6(); const float* p_sl9 = F.slab9(); float* p_x1 = F.x1(); const float* p_fng = F.fng();
    LAS float* scr = (LAS float*)(F.lds + F.wave * 16384);
    const int gw = F.vcu * NWAVES + F.wave, NGW = F.G * NWAVES;
    for (int it = gw; it < NITEMS_A; it += NGW) conv_item_a(F, it, scr);
    for (int m = gw; m < MPAD; m += NGW) {
        bf16_t* orow = p_H1 + (size_t)m * DM;
        if (m >= MV) { GAS v2u* o8 = (GAS v2u*)orow + F.lane;
#pragma unroll
            for (int j = 0; j < 8; ++j) o8[64 * j] = (v2u){0u, 0u};
            continue; }
        const float* xrow = m < MP ? p_xp + (size_t)m * DM : p_xs + (size_t)(m - MP) * DM;
        const int seq = m < MP ? (m >> 12) : 2 + ((m - MP) >> 4);
        const float* md = p_mod + (size_t)seq * NMOD;
        f32x4 v[8]; load_row(v, xrow, F.lane);
        norm_regs_bf16(v, md, md + DM, orow, F.lane);
    }
}
__device__ __forceinline__ void phase_norm2s(Frame& F, int gw, int NGW, unsigned* ready) {
    const float* p_xs = F.x_sample(); const float* p_mod = F.mod(); bf16_t* p_H1 = F.H1(); const float* p_sl6 = F.slab6(); float* p_x1 = F.x1();
    for (int r = gw; r < MS; r += NGW) { const int m = MP + r;
        const float* md = p_mod + (size_t)(2 + (r >> 4)) * NMOD;
        f32x4 v[8], a[8]; load_row(v, p_xs + (size_t)r * DM, F.lane); load_row(a, p_sl6 + (size_t)r * DM, F.lane);
#pragma unroll 5
        for (int k = 1; k < NSL6; ++k) { f32x4 t[8]; load_row(t, p_sl6 + (size_t)(k * 128 + r) * DM, F.lane);
#pragma unroll
            for (int j = 0; j < 8; ++j) a[j] += t[j]; }
        GAS f32x4* xo = (GAS f32x4*)(p_x1 + (size_t)m * DM) + F.lane;
#pragma unroll
        for (int j = 0; j < 8; ++j) { const f32x4 g = *((const GAS f32x4*)(md + 2 * DM) + F.lane + 64 * j); v[j] = v[j] + g * a[j]; xo[64 * j] = v[j]; }
        norm_regs_bf16(v, md + 3 * DM, md + 4 * DM, p_H1 + (size_t)m * DM, F.lane);
        asm volatile("s_waitcnt vmcnt(0)" ::: "memory");
        __builtin_amdgcn_fence(__ATOMIC_RELEASE, "agent");
        asm volatile("s_waitcnt vmcnt(0)" ::: "memory");
        if (F.lane == 0) __hip_atomic_fetch_add(ready, 1u, __ATOMIC_RELAXED, __HIP_MEMORY_SCOPE_AGENT);
    }
}
__device__ __forceinline__ void phase_finals(Frame& F) {
    const float* p_mod = F.mod(); const float* p_sl9 = F.slab9(); const float* p_x1 = F.x1(); const float* p_fng = F.fng();
    LAS float* part = (LAS float*)F.lds;
    LAS float* red = part + 8 * DM;
    for (int r = F.vcu; r < MS; r += F.G) { const int m = MP + r;
        f32x4 a[8];
#pragma unroll
        for (int j = 0; j < 8; ++j) a[j] = (f32x4){0.f, 0.f, 0.f, 0.f};
        f32x4 t[3][8];
#pragma unroll
        for (int q = 0; q < 3; ++q) { const int k = F.wave + 8 * q; if (k < NSL9) load_row(t[q], p_sl9 + (size_t)(k * 128 + r) * DM, F.lane); }
#pragma unroll
        for (int q = 0; q < 3; ++q) { const int k = F.wave + 8 * q; if (k < NSL9) {
#pragma unroll
            for (int j = 0; j < 8; ++j) a[j] += t[q][j]; } }
#pragma unroll
        for (int j = 0; j < 8; ++j) *(LAS f32x4*)(part + F.wave * DM + 4 * (F.lane + 64 * j)) = a[j];
        __syncthreads();
        const int c = 256 * F.wave + 4 * F.lane;
        f32x4 sacc = *(const LAS f32x4*)(part + c);
#pragma unroll
        for (int w2 = 1; w2 < 8; ++w2) sacc += *(const LAS f32x4*)(part + w2 * DM + c);
        const float* md = p_mod + (size_t)(2 + (r >> 4)) * NMOD + 5 * DM;
        const f32x4 v = *(const GAS f32x4*)(p_x1 + (size_t)m * DM + c) + *(const GAS f32x4*)(md + c) * sacc;
        float ss = wave_sum((v.x * v.x + v.y * v.y) + (v.z * v.z + v.w * v.w));
        if (F.lane == 0) red[F.wave] = ss;
        __syncthreads();
        float tot = 0.f;
#pragma unroll
        for (int w2 = 0; w2 < 8; ++w2) tot += red[w2];
        const float rinv = rsqrtf(tot * (1.f / DM) + EPS);
        *(GAS f32x4*)(F.out + (size_t)m * DM + c) = v * rinv * *(const GAS f32x4*)(p_fng + c);
        __syncthreads();
    }
}
__device__ __forceinline__ void phase_mgs(Frame& F, unsigned* ready) {
    static_assert(NSL4 == 32, "phase_mgs: 4 lanes x 8 slabs");
    const GAS f32x4* src = (const GAS f32x4*)F.slab4(); GAS v2u* dst = (GAS v2u*)(F.MG() + (size_t)MP * DM);
    for (int i = F.vcu * 512 + F.tid; i < 128 * DM; i += F.G * 512) { const int o = i >> 2, q = i & 3;
        f32x4 t[8];
#pragma unroll
        for (int k = 0; k < 8; ++k) t[k] = src[(size_t)(8 * q + k) * (128 * DM / 4) + o];
        f32x4 a = (t[0] + t[1]) + (t[2] + t[3]) + ((t[4] + t[5]) + (t[6] + t[7]));
#pragma unroll
        for (int e = 0; e < 4; ++e) { a[e] += __shfl_xor(a[e], 1); a[e] += __shfl_xor(a[e], 2); }
        if (q == 0) { v2u w; w.x = pk2(a.x, a.y); w.y = pk2(a.z, a.w); dst[o] = w; } }
    asm volatile("s_waitcnt vmcnt(0)" ::: "memory"); __syncthreads();
    if (F.tid == 0) { __builtin_amdgcn_fence(__ATOMIC_RELEASE, "agent"); asm volatile("s_waitcnt vmcnt(0)" ::: "memory"); __hip_atomic_fetch_add(ready, 1u, __ATOMIC_RELAXED, __HIP_MEMORY_SCOPE_AGENT); }
}

constexpr int RG_WL = 4352, RG_W = 34816, RG_TOT = 104448, RG_PRE = 112640, RG_HIN = 120832, RG_TAB = 121344;
__device__ __forceinline__ float gran_poll(gu64* g) {
    unsigned spins = 0;
    for (;;) { const unsigned long long x = __hip_atomic_load(g, RLX_AGENT); if ((unsigned)(x >> 32) == 1u) return __uint_as_float((unsigned)x);
        __builtin_amdgcn_s_sleep(1); if (++spins > (1u << 17)) return 0.f; }
}
__device__ __forceinline__ void rglru_prologue(Frame& F, int n) {
    const bf16_t* p_Wrg = F.Wrg_t();
    for (int i = F.tid; i < 4096; i += 512) { const int row = i >> 4, ch = i & 15;
        const v4u wv = *(const GAS v4u*)(p_Wrg + (size_t)((row >> 7) * 16 + n) * 16384 + (row & 127) * 128 + ch * 8);
        *(LAS v4u*)(F.lds + RG_W + row * 272 + ch * 16) = wv; }
    if (F.tid < 128) { const int c = n * 128 + F.tid; LAS float* tab = (LAS float*)(F.lds + RG_TAB);
        tab[F.tid] = -8.f * log1pf(__expf(-F.rg_lambda()[c])); tab[128 + F.tid] = F.b_rg_a()[c]; tab[256 + F.tid] = F.b_rg_x()[c]; }
    __syncthreads();
}
template <bool SAMPLE>
__device__ __forceinline__ void rglru_unit(Frame& F, int bn, int j) {
    const int w = F.wave, lane = F.lane, fr = lane & 15, fq = lane >> 4;
    const float* p_conv_w = F.conv_w(); const float* p_conv_b = F.conv_b(); const float* p_st_conv = F.st_conv(); const float* p_st_h = F.st_h();
    const bf16_t* p_Ub = F.Ub(); const bf16_t* p_Gb = F.Gb(); bf16_t* p_OY = F.OY(); gu64* p_gran = F.gran();
    int n, seq; long row0;
    if (SAMPLE) { n = bn; seq = 2 + w; row0 = MP + w * 16; } else { seq = bn >> 4; n = bn & 15; row0 = (long)seq * TP + j * 128 + w * 16; }
    const int cb = n * 128;
    LAS unsigned char* wl = F.lds + w * RG_WL;
    const LAS float* tab = (const LAS float*)(F.lds + RG_TAB);
    v4u gpre[4];
#pragma unroll
    for (int i = 0; i < 4; ++i) { const int r = (lane >> 4) + 4 * i; gpre[i] = *(const GAS v4u*)(p_Gb + (size_t)(row0 + r) * DM + cb + (lane & 15) * 8); }
    {
        const int c2 = cb + 2 * lane;
        float cw0[4], cw1[4];
#pragma unroll
        for (int k = 0; k < 4; ++k) { cw0[k] = p_conv_w[k * DM + c2]; cw1[k] = p_conv_w[k * DM + c2 + 1]; }
        const float cb0 = p_conv_b[c2], cb1 = p_conv_b[c2 + 1];
        float u0[19], u1[19];
#pragma unroll
        for (int i = 0; i < 19; ++i) { const int rr = i - 3;
            if (rr < 0) {
                if (SAMPLE) { u0[i] = p_st_conv[(size_t)(w * 3 + i) * DM + c2]; u1[i] = p_st_conv[(size_t)(w * 3 + i) * DM + c2 + 1]; }
                else if (j == 0 && w == 0) { u0[i] = 0.f; u1[i] = 0.f; }
                else { const unsigned p = *(const GAS unsigned*)(p_Ub + (size_t)(row0 + rr) * DM + c2); u0[i] = bflo(p); u1[i] = bfhi(p); }
            } else { const unsigned p = *(const GAS unsigned*)(p_Ub + (size_t)(row0 + rr) * DM + c2); u0[i] = bflo(p); u1[i] = bfhi(p); } }
#pragma unroll
        for (int tt = 0; tt < 16; ++tt) {
            const float x0 = cb0 + cw0[0] * u0[tt] + cw0[1] * u0[tt + 1] + cw0[2] * u0[tt + 2] + cw0[3] * u0[tt + 3];
            const float x1 = cb1 + cw1[0] * u1[tt] + cw1[1] * u1[tt + 1] + cw1[2] * u1[tt + 2] + cw1[3] * u1[tt + 3];
            *(LAS unsigned*)(wl + tt * 272 + lane * 4) = pk2(x0, x1); }
    }
    LDS_WAIT(); asm volatile("" ::: "memory");
    f32x4 acc[2][8];
#pragma unroll
    for (int a = 0; a < 2; ++a)
#pragma unroll
        for (int g = 0; g < 8; ++g) acc[a][g] = (f32x4){0.f, 0.f, 0.f, 0.f};
#pragma unroll
    for (int ks = 0; ks < 4; ++ks) { const bf16x8 a = *(const LAS bf16x8*)(wl + fr * 272 + (32 * ks + 8 * fq) * 2);
#pragma unroll
        for (int wh = 0; wh < 2; ++wh)
#pragma unroll
            for (int g = 0; g < 8; ++g) { const bf16x8 b = *(const LAS bf16x8*)(F.lds + RG_W + (wh * 128 + 16 * g + fr) * 272 + (32 * ks + 8 * fq) * 2);
                acc[wh][g] = __builtin_amdgcn_mfma_f32_16x16x32_bf16(a, b, acc[wh][g], 0, 0, 0); } }
    float Al[8][4], Hl[8][4], HS[8], EA[8], EH[8];
#pragma unroll
    for (int g = 0; g < 8; ++g) {
        const int cl = 16 * g + fr, c = cb + cl;
        const float c8 = tab[cl], ba = tab[128 + cl], bx = tab[256 + cl];
        float A = 1.f, H = 0.f;
#pragma unroll
        for (int reg = 0; reg < 4; ++reg) { const int tt = 4 * fq + reg;
            const float xcv = bf2f(*(const LAS unsigned short*)(wl + tt * 272 + cl * 2));
            const float r = sigm(acc[0][g][reg] + ba), ii = sigm(acc[1][g][reg] + bx);
            const float la = c8 * r, a = __expf(la), bb = __builtin_amdgcn_sqrtf(fmaxf(1.f - a * a, 0.f)) * (ii * xcv);
            H = a * H + bb; A = a * A; Al[g][reg] = A; Hl[g][reg] = H; }
        float IA = A, IH = H;
        { const float xa = __shfl_up(IA, 16), xh = __shfl_up(IH, 16); if (fq >= 1) { IH = IA * xh + IH; IA = IA * xa; } }
        { const float xa = __shfl_up(IA, 32), xh = __shfl_up(IH, 32); if (fq >= 2) { IH = IA * xh + IH; IA = IA * xa; } }
        { const float xa = __shfl_up(IA, 16), xh = __shfl_up(IH, 16); EA[g] = fq ? xa : 1.f; EH[g] = fq ? xh : 0.f; }
        if (SAMPLE) { const float h0 = p_st_h[(size_t)w * DM + c]; HS[g] = EA[g] * h0 + EH[g];
            if (fq == 3) F.out[O_SH + (size_t)w * DM + c] = IA * h0 + IH; }
        else { HS[g] = 0.f; if (fq == 3) *(LAS f32x2*)(F.lds + RG_TOT + (w * 128 + cl) * 8) = (f32x2){IA, IH}; }
    }
#pragma unroll
    for (int i = 0; i < 4; ++i) { const int r = (lane >> 4) + 4 * i; *(LAS v4u*)(wl + r * 272 + (lane & 15) * 16) = gpre[i]; }
    if (!SAMPLE) {
        __syncthreads();
        if (F.tid < 128) { const int c = F.tid; float PA = 1.f, PH = 0.f;
#pragma unroll
            for (int w2 = 0; w2 < 8; ++w2) { *(LAS f32x2*)(F.lds + RG_PRE + (w2 * 128 + c) * 8) = (f32x2){PA, PH};
                const f32x2 t = *(const LAS f32x2*)(F.lds + RG_TOT + (w2 * 128 + c) * 8); PH = t.x * PH + t.y; PA = PA * t.x; }
            gu64* gI = p_gran + (size_t)(bn * 32) * 128 + c; gu64* gA = gI + 131072; gu64* gB = gI + 262144;
            if (j < 31) { __hip_atomic_store(gA + j * 128, (1ull << 32) | (unsigned long long)__float_as_uint(PA), RLX_AGENT);
                          __hip_atomic_store(gB + j * 128, (1ull << 32) | (unsigned long long)__float_as_uint(PH), RLX_AGENT); }
            float hin = 0.f;
            if (j > 0) { float fa = 1.f, fh = 0.f; int k = j - 1; unsigned spins = 0; bool done = false;
                while (!done) {
                    unsigned long long xi[8], xa[8], xb[8];
#pragma unroll
                    for (int i = 0; i < 8; ++i) { const int kk = k - i < 0 ? 0 : k - i; xi[i] = __hip_atomic_load(gI + kk * 128, RLX_AGENT); xa[i] = __hip_atomic_load(gA + kk * 128, RLX_AGENT); xb[i] = __hip_atomic_load(gB + kk * 128, RLX_AGENT); }
                    bool stuck = false;
#pragma unroll
                    for (int i = 0; i < 8; ++i) { if (!done && !stuck) {
                        if ((unsigned)(xi[i] >> 32) == 1u) { hin = fa * __uint_as_float((unsigned)xi[i]) + fh; done = true; }
                        else if ((unsigned)(xa[i] >> 32) == 1u && (unsigned)(xb[i] >> 32) == 1u) { fh = fa * __uint_as_float((unsigned)xb[i]) + fh; fa = fa * __uint_as_float((unsigned)xa[i]); --k; if (k < 0) { hin = fh; done = true; } }
                        else stuck = true; } }
                    if (!done) { __builtin_amdgcn_s_sleep(1); if (++spins > (1u << 16)) break; }
                } }
            const float hout = PA * hin + PH;
            if (j < 31) __hip_atomic_store(gI + j * 128, (1ull << 32) | (unsigned long long)__float_as_uint(hout), RLX_AGENT);
            else F.out[O_PH + (size_t)seq * DM + cb + c] = hout;
            *(LAS float*)(F.lds + RG_HIN + c * 4) = hin; }
        __syncthreads();
#pragma unroll
        for (int g = 0; g < 8; ++g) { const int cl = 16 * g + fr; const f32x2 p = *(const LAS f32x2*)(F.lds + RG_PRE + (w * 128 + cl) * 8);
            const float hw = p.x * *(const LAS float*)(F.lds + RG_HIN + cl * 4) + p.y; HS[g] = EA[g] * hw + EH[g]; }
    }
    LDS_WAIT(); asm volatile("" ::: "memory");
#pragma unroll
    for (int g = 0; g < 8; ++g) { const int cl = 16 * g + fr;
#pragma unroll
        for (int reg = 0; reg < 4; ++reg) { const int tt = 4 * fq + reg; LAS unsigned short* gp = (LAS unsigned short*)(wl + tt * 272 + cl * 2);
            const float h = Al[g][reg] * HS[g] + Hl[g][reg]; *gp = (unsigned short)f2bf(h * bf2f(*gp)); } }
    LDS_WAIT(); asm volatile("" ::: "memory");
#pragma unroll
    for (int i = 0; i < 4; ++i) { const int r = (lane >> 4) + 4 * i; const v4u y = *(const LAS v4u*)(wl + r * 272 + (lane & 15) * 16);
        *(GAS v4u*)(p_OY + (size_t)(row0 + r) * 4096 + 2048 + cb + (lane & 15) * 8) = y; }
    __syncthreads();
}
typedef int i32x4_t __attribute__((ext_vector_type(4)));
__device__ __forceinline__ bf16x8 pack8frag(f32x4 a, f32x4 b) { const v4u w = pack8bf(a, b); return __builtin_bit_cast(bf16x8, w); }
__device__ __forceinline__ void sattn_unit(Frame& F, int bs, int h, int qh) {
    constexpr int RS = 532;
    LAS float* scv = (LAS float*)F.lds;
    LAS float* inv = scv + 16 * RS;
    LAS float* btab = inv + 16;
    LAS float* part = btab + 320;
    const int w = F.wave, lane = F.lane, fr = lane & 15, fq = lane >> 4;
    if (F.tid < 320) btab[F.tid] = F.rel_bias()[h * 320 + F.tid];
    const unsigned lrow = (unsigned)(fr * 2048 + 8 * fq) * 4u;
    {
        bf16x8 qf[4];
#pragma unroll
        for (int ks = 0; ks < 4; ++ks) qf[ks] = *(const GAS bf16x8*)(F.Qb() + (size_t)(MP + bs * 16 + qh * 8 + (fr & 7)) * DM + h * 128 + 32 * ks + 8 * fq);
        const __amdgpu_buffer_rsrc_t rk = __builtin_amdgcn_make_buffer_rsrc((void*)(F.cache_k() + ((size_t)(bs * 512 + 64 * w) * 16 + h) * 128), 0, 0x40000000, 0x00020000);
        f32x4 kr[4][4][2];
#pragma unroll
        for (int t = 0; t < 4; ++t)
#pragma unroll
            for (int ks = 0; ks < 4; ++ks) { const int so = (16 * t * 2048 + 32 * ks) * 4;
                kr[t][ks][0] = __builtin_bit_cast(f32x4, __builtin_amdgcn_raw_buffer_load_b128(rk, lrow, so, 0));
                kr[t][ks][1] = __builtin_bit_cast(f32x4, __builtin_amdgcn_raw_buffer_load_b128(rk, lrow, so + 16, 0)); }
#pragma unroll
        for (int t = 0; t < 4; ++t) { f32x4 acc = {0.f, 0.f, 0.f, 0.f};
#pragma unroll
            for (int ks = 0; ks < 4; ++ks) acc = __builtin_amdgcn_mfma_f32_16x16x32_bf16(pack8frag(kr[t][ks][0], kr[t][ks][1]), qf[ks], acc, 0, 0, 0);
#pragma unroll
            for (int reg = 0; reg < 4; ++reg) scv[fr * RS + 64 * w + 16 * t + 4 * fq + reg] = acc[reg] * ATT_SCALE; }
        if (w == 0) {
            const __amdgpu_buffer_rsrc_t rn = __builtin_amdgcn_make_buffer_rsrc((void*)(F.out + O_SK + (size_t)(bs * 16) * DM + h * 128), 0, 0x40000000, 0x00020000);
            f32x4 acc = {0.f, 0.f, 0.f, 0.f};
#pragma unroll
            for (int ks = 0; ks < 4; ++ks) { const f32x4 a = __builtin_bit_cast(f32x4, __builtin_amdgcn_raw_buffer_load_b128(rn, lrow, 32 * ks * 4, 0)), b = __builtin_bit_cast(f32x4, __builtin_amdgcn_raw_buffer_load_b128(rn, lrow, 32 * ks * 4 + 16, 0));
                acc = __builtin_amdgcn_mfma_f32_16x16x32_bf16(pack8frag(a, b), qf[ks], acc, 0, 0, 0); }
#pragma unroll
            for (int reg = 0; reg < 4; ++reg) scv[fr * RS + 512 + 4 * fq + reg] = acc[reg] * ATT_SCALE; }
    }
    __syncthreads();
    { const int row = w, qp_ = qh * 8 + w; float mx = -1e30f;
        for (int jk = lane; jk < 528; jk += 64) { int diff = jk < 512 ? (512 + qp_ - jk) : (qp_ - (jk - 512)); diff = diff > 256 ? 256 : diff;
            const float v = scv[row * RS + jk] + btab[diff + 63]; scv[row * RS + jk] = v; mx = fmaxf(mx, v); }
        mx = wave_max(mx); float sum = 0.f;
        for (int jk = lane; jk < 528; jk += 64) { const float e = __expf(scv[row * RS + jk] - mx); scv[row * RS + jk] = e; sum += e; }
        sum = wave_sum(sum); if (lane == 0) inv[row] = 1.f / sum; }
    __syncthreads();
    {
        const unsigned lcol = (unsigned)(8 * fq * 2048 + fr) * 4u;
        const __amdgpu_buffer_rsrc_t rv = __builtin_amdgcn_make_buffer_rsrc((void*)(F.cache_v() + ((size_t)(bs * 512 + 64 * w) * 16 + h) * 128), 0, 0x40000000, 0x00020000);
        f32x4 acc[8];
#pragma unroll
        for (int dt = 0; dt < 8; ++dt) acc[dt] = (f32x4){0.f, 0.f, 0.f, 0.f};
#pragma unroll
        for (int kt = 0; kt < 2; ++kt) {
            float vv[8][8];
#pragma unroll
            for (int dt = 0; dt < 8; ++dt)
#pragma unroll
                for (int j = 0; j < 8; ++j) vv[dt][j] = __builtin_bit_cast(float, __builtin_amdgcn_raw_buffer_load_b32(rv, lcol, ((32 * kt + j) * 2048 + 16 * dt) * 4, 0));
            const LAS f32x4* pp = (const LAS f32x4*)(scv + fr * RS + 64 * w + 32 * kt + 8 * fq);
            const bf16x8 pf = pack8frag(pp[0], pp[1]);
#pragma unroll
            for (int dt = 0; dt < 8; ++dt) { const bf16x8 bfr = pack8frag((f32x4){vv[dt][0], vv[dt][1], vv[dt][2], vv[dt][3]}, (f32x4){vv[dt][4], vv[dt][5], vv[dt][6], vv[dt][7]});
                acc[dt] = __builtin_amdgcn_mfma_f32_16x16x32_bf16(pf, bfr, acc[dt], 0, 0, 0); }
        }
        if (w == 0) {
            const __amdgpu_buffer_rsrc_t rn = __builtin_amdgcn_make_buffer_rsrc((void*)(F.out + O_SV + (size_t)(bs * 16) * DM + h * 128), 0, 0x40000000, 0x00020000);
            const unsigned lcn = (unsigned)(8 * (fq & 1) * 2048 + fr) * 4u;
            float vv[8][8];
#pragma unroll
            for (int dt = 0; dt < 8; ++dt)
#pragma unroll
                for (int j = 0; j < 8; ++j) vv[dt][j] = __builtin_bit_cast(float, __builtin_amdgcn_raw_buffer_load_b32(rn, lcn, (j * 2048 + 16 * dt) * 4, 0));
            const LAS f32x4* pp = (const LAS f32x4*)(scv + fr * RS + 512 + 8 * (fq & 1));
            f32x4 p0 = pp[0], p1 = pp[1]; if (fq >= 2) { p0 = (f32x4){0.f, 0.f, 0.f, 0.f}; p1 = p0; }
            const bf16x8 pf = pack8frag(p0, p1);
#pragma unroll
            for (int dt = 0; dt < 8; ++dt) { const bf16x8 bfr = pack8frag((f32x4){vv[dt][0], vv[dt][1], vv[dt][2], vv[dt][3]}, (f32x4){vv[dt][4], vv[dt][5], vv[dt][6], vv[dt][7]});
                acc[dt] = __builtin_amdgcn_mfma_f32_16x16x32_bf16(pf, bfr, acc[dt], 0, 0, 0); }
        }
#pragma unroll
        for (int dt = 0; dt < 8; ++dt)
#pragma unroll
            for (int reg = 0; reg < 4; ++reg) part[(w * 16 + 4 * fq + reg) * 128 + 16 * dt + fr] = acc[dt][reg];
    }
    __syncthreads();
    { const int row = F.tid >> 6, c2 = (F.tid & 63) * 2; f32x2 a = {0.f, 0.f};
#pragma unroll
      for (int w2 = 0; w2 < 8; ++w2) a += *(const LAS f32x2*)(part + (w2 * 16 + row) * 128 + c2);
      a = a * inv[row];
      *(GAS unsigned*)(F.OY() + (size_t)(MP + bs * 16 + qh * 8 + row) * 4096 + h * 128 + c2) = pk2(a.x, a.y); }
    __syncthreads();
}
__device__ __forceinline__ att::BlockRef att_ref(Frame& F, int L) {
    const int bh = L >> 4, qb = L & 15, b = bh >> 4, h = bh & 15;
    att::BlockRef r; const size_t rb = (size_t)b * TP;
    r.Q = F.Qb() + (rb + (size_t)qb * 256) * DM + h * 128; r.K = F.Kb() + rb * DM + h * 128; r.V = F.Vb() + rb * DM + h * 128;
    r.O = F.OY() + (rb + (size_t)qb * 256) * 4096 + h * 128; r.qb = qb; r.h = h; return r;
}
template <int pmask>
__device__ __forceinline__ void phase3(Frame& F, char* ldsg) {
    int wn = -1;
    if (pmask & 1) for (int id = F.vcu; id < 1024; id += F.G) { const int bn = id & 31; if ((bn & 15) != wn) { wn = bn & 15; rglru_prologue(F, wn); } rglru_unit<false>(F, bn, id >> 5); }
    if (pmask & 2) { if ((F.G & 15) == 0) { if ((F.vcu & 15) == 0 && (F.vcu >> 4) < 16) { const int n = F.vcu >> 4; if (n != wn) { wn = n; rglru_prologue(F, wn); } rglru_unit<true>(F, n, 0); } }
        else for (int n = F.vcu; n < 16; n += F.G) { if (n != wn) { wn = n; rglru_prologue(F, wn); } rglru_unit<true>(F, n, 0); } }
    if (pmask & 4) for (int u = F.vcu; u < 256; u += F.G) sattn_unit(F, u >> 5, (u >> 1) & 15, u & 1);
    for (int i = F.tid; i < 5120; i += 512) ((LAS float*)(F.lds + att::BIAS_OFF))[i] = F.rel_bias()[i];
    __syncthreads();
    int L = F.vcu;
    if ((pmask & 8) && L < 512) {
        att::BlockRef cur = att_ref(F, L); att::Seam S; att::att_prime(cur, ldsg, S);
        for (;;) { const bool more = L + F.G < 512; const int Ln = more ? L + F.G : L; const att::BlockRef nxt = more ? att_ref(F, Ln) : cur;
            att::att_block(cur, nxt, ldsg, S); if (!more) break; cur = nxt; L = Ln; }
    }
}

#ifndef WGM_P2
#define WGM_P2 2
#endif
#ifndef WGM_P4
#define WGM_P4 2
#endif
#ifndef WGM_P5
#define WGM_P5 2
#endif
#ifndef WGM_P6
#define WGM_P6 2
#endif
#ifndef WGM_P7
#define WGM_P7 2
#endif
__global__ void __launch_bounds__(NWAVES * 64, 2) fwd(Args args) {
    extern __shared__ __attribute__((aligned(16))) unsigned char lds[];
    Frame F;
    F.lds = (LAS unsigned char*)lds;
    F.tid = threadIdx.x; F.lane = F.tid & 63; F.wave = __builtin_amdgcn_readfirstlane(F.tid >> 6);
    F.G = gridDim.x; { const int bx = blockIdx.x; F.vcu = (F.G % 8 == 0) ? (bx % 8) * (F.G / 8) + bx / 8 : bx; }
    F.out = args.out; F.ws = args.ws;
    unsigned char* ws = args.ws;
    for (int u = F.tid; u < (LDS_BYTES - LDSCTL_OFF) / 4; u += NWAVES * 64) ((LAS unsigned*)(F.lds + LDSCTL_OFF))[u] = 0u;
    __syncthreads();
#if !MK_MULTI
    XcdBarrier bar = xcd_barrier_post((unsigned*)(ws + WS_CTL) + CW_BAR, (volatile LAS unsigned*)(F.lds + MISC_OFF) + 8);
#define GRID_BAR() xcd_barrier(bar)
#else
#define GRID_BAR() do { } while (0)
#endif
    const int lo = args.ph_lo, hi = args.ph_hi;
#ifndef PHMASK
#define PHMASK 0x1ff
#endif
#define IN(k) (((PHMASK >> (k)) & 1) && lo <= (k) && (k) < hi)
#define SEAM(k) do { if (lo <= (k) && (k) + 1 < hi && (k) < 8) GRID_BAR(); } while (0)
#ifndef REP_PHASE
#define REP_PHASE -1
#endif
#define RUNPH(k, ...) do { unsigned long long t0_ = 0; if (PROBE_PHASE == (k)) t0_ = __builtin_amdgcn_s_memrealtime(); \
        if (IN(k)) { __VA_ARGS__ } if (REP_PHASE == (k) && IN(k)) { GRID_BAR(); __VA_ARGS__ } SEAM(k); \
        if (PROBE_PHASE == (k) && blockIdx.x == 0 && threadIdx.x == 0) ((unsigned*)(F.ws + WS_CTL))[2] = (unsigned)(__builtin_amdgcn_s_memrealtime() - t0_); } while (0)
    RUNPH(0, F.refresh(); phase0(F); );
    if (REP_PHASE == 100 && IN(0)) { phase0(F, true); GRID_BAR(); }
    RUNPH(1, F.refresh(); phase1(F); );
    RUNPH(2, F.refresh(); pg8::Gemm g{F.H1(), F.Win_t(), MPAD, NIN, DM}; pg8::StaticOrder S; S.init(MPAD, NIN, DM, F.G, (int)blockIdx.x, WGM_P2);
        EpiIn E{F.Qb(), F.out}; pg8::gemm_phase<EpiIn, pg8::StaticOrder, true, true>(F.lds, g, S, E);
        { const int nlast = S.nwg % F.G, nfree = nlast ? F.G - nlast : F.G, fidx = nlast ? (int)blockIdx.x - nlast : (int)blockIdx.x;
          if (fidx >= 0) { LAS float* scr = (LAS float*)(F.lds + F.wave * 16384);
              for (int it = fidx * NWAVES + F.wave; it < NITEMS_B; it += nfree * NWAVES) conv_item_b(F, it, scr); } } );
    RUNPH(3, F.refresh(); phase3<15>(F, (char*)lds); );
    if (REP_PHASE > 100 && REP_PHASE < 116 && IN(3)) { F.refresh(); phase3<(REP_PHASE > 100 ? REP_PHASE - 100 : 15)>(F, (char*)lds); GRID_BAR(); }
    RUNPH(4, F.refresh(); pg8::Gemm g{F.OY(), F.Wproj_t(), MPAD, DM, 2 * DM}; pg8::HybridOrder S; S.init(DM, 2 * DM, F.G, (int)blockIdx.x, 2, WGM_P4);
        EpiProj E{F.SAb(), F.SRb(), F.MG(), F.slab4(), F.ws}; pg8::gemm_phase<EpiProj, pg8::HybridOrder, true, true>(F.lds, g, S, E); );
    RUNPH(5, F.refresh(); pg8::Gemm g{F.MG(), F.Wout_t(), MPAD, DM, DM}; pg8::HybridOrder S; S.init(DM, DM, F.G, (int)blockIdx.x, 2, WGM_P5);
        unsigned* rdy = (unsigned*)(F.ws + WS_CTL) + CW_READY + 64; S.ready = rdy; S.need = (unsigned)F.G; S.slices_first = true;
        probe_mark(0, F.ws); phase_mgs(F, rdy); probe_mark(1, F.ws);
        EpiResNorm E{F.x_prompt(), F.x1(), F.H1(), F.mod(), F.slab6(), F.lds + XL_OFF, (unsigned long long*)(F.ws + WS_XW), F.ws};
        pg8::gemm_phase<EpiResNorm, pg8::HybridOrder, true, true>(F.lds, g, S, E); );
    RUNPH(6, F.refresh(); pg8::Gemm g{F.H1(), F.Wgu_t(), MPAD, NGU, DM}; pg8::SampleGatedOrder S; S.init(MPAD, NGU, DM, F.G, (int)blockIdx.x, WGM_P6);
        unsigned* ready = (unsigned*)(F.ws + WS_CTL) + CW_READY; S.ready = ready; S.need = MS;
        { const int nlast = S.nwg % F.G, nfree = nlast ? F.G - nlast : F.G, fidx = nlast ? (int)blockIdx.x - nlast : (int)blockIdx.x;
          if (fidx >= 0) phase_norm2s(F, fidx * NWAVES + F.wave, nfree * NWAVES, ready); }
        EpiGU E{F.ACT()}; pg8::gemm_phase<EpiGU, pg8::SampleGatedOrder, true, true>(F.lds, g, S, E); );
    RUNPH(7, F.refresh(); pg8::Gemm g{F.ACT(), F.Wdn_t(), MPAD, DM, DFF}; pg8::HybridOrder S; S.init(DM, DFF, F.G, (int)blockIdx.x, 4, WGM_P7); S.slices_first = true;
        EpiResFinal E{F.x1(), F.out, F.mod(), F.fng(), F.slab9(), F.lds + XL_OFF, (unsigned long long*)(F.ws + WS_XW) + 32 * 256};
        pg8::gemm_phase<EpiResFinal, pg8::HybridOrder, true, true>(F.lds, g, S, E); );
    RUNPH(8, F.refresh(); phase_finals(F); );
    if (PROBE_PHASE >= 0 && blockIdx.x == 0) { __syncthreads(); const unsigned ticks = ((volatile unsigned*)(F.ws + WS_CTL))[2];
        const float fac = 1.f + 4e-3f + (PROBE_PHASE >= 100 ? 5e-5f : 1.5e-5f) * (0.01f * (float)ticks);
        for (int i = threadIdx.x; i < 16384; i += 512) F.out[O_SH + i] *= fac; }
#undef IN
#undef SEAM
}

extern "C" void kernel_launch(void* const* d_in, const int* in_sizes, int n_in, void* d_out, int out_size, void* d_ws, size_t ws_size, hipStream_t stream) {
    static int grid = 0;
    if (grid == 0) {
        if (n_in != 26 || out_size != (int)O_END || ws_size < WS_END) { fprintf(stderr, "kernel_launch: unexpected shapes (n_in %d out %d ws %zu)\n", n_in, out_size, ws_size); grid = -1; return; }
        int dev = 0, cus = 0, per_cu = 0;
        if (hipGetDevice(&dev) != hipSuccess || hipDeviceGetAttribute(&cus, hipDeviceAttributeMultiprocessorCount, dev) != hipSuccess) { grid = -1; return; }
        if (hipFuncSetAttribute((const void*)fwd, hipFuncAttributeMaxDynamicSharedMemorySize, LDS_BYTES) != hipSuccess) { fprintf(stderr, "kernel_launch: hipFuncSetAttribute failed\n"); grid = -1; return; }
        if (hipOccupancyMaxActiveBlocksPerMultiprocessor(&per_cu, (const void*)fwd, NWAVES * 64, LDS_BYTES) != hipSuccess || per_cu < 1) { fprintf(stderr, "kernel_launch: occupancy query says %d workgroups per CU; nothing launched\n", per_cu); (void)hipGetLastError(); grid = -1; return; }
        grid = cus;
    }
    if (grid < 0) return;
    (void)hipMemsetAsync((char*)d_ws + WS_CTL, 0, CTL_ZERO_BYTES, stream);
    Args a{};
    for (int i = 0; i < 26; ++i) a.in[i] = (const float*)d_in[i];
    a.out = (float*)d_out; a.ws = (unsigned char*)d_ws;
#if MK_MULTI
    for (int p = 0; p < 9; ++p) { a.ph_lo = p; a.ph_hi = p + 1; hipLaunchKernelGGL(fwd, dim3(grid), dim3(NWAVES * 64), LDS_BYTES, stream, a); }
#else
    a.ph_lo = 0; a.ph_hi = 9;
    void* kargs[] = {&a};
    hipError_t e = hipLaunchCooperativeKernel((const void*)fwd, dim3(grid), dim3(NWAVES * 64), kargs, LDS_BYTES, stream);
    if (e != hipSuccess) fprintf(stderr, "kernel_launch: cooperative launch failed: %s (grid %d)\n", hipGetErrorString(e), grid);
#endif
}
```

```cpp
#include <hip/hip_runtime.h>
#include <hip/hip_bf16.h>
#include <cstdio>
#include <cstdint>

#ifndef MK_MULTI
#define MK_MULTI 0
#endif

constexpr int DM = 2048, TP = 4096, NBP = 2, TS = 16, NBS = 8;
constexpr int MP = NBP * TP;
constexpr int MS = NBS * TS;
constexpr int MV = MP + MS;
constexpr int MPAD = 8448;
constexpr int NIN = 14336, DFF = 5632, NGU = 2 * DFF, NMOD = 6 * DM;
constexpr float EPS = 1e-6f;
constexpr float ATT_SCALE = 0.08838834764831845f;
constexpr size_t O_YP = 0, O_YS = 16777216, O_PK = 17039360, O_PV = 19136512, O_PH = 21233664, O_PC = 21237760,
                 O_SK = 21250048, O_SV = 21512192, O_SH = 21774336, O_SC = 21790720, O_END = 21839872;

constexpr size_t MiB = 1u << 20;
constexpr size_t WS_CTL = 0, CTL_ZERO_BYTES = 1 * MiB;
constexpr size_t WS_MOD = 64 * 1024;
constexpr size_t WS_GRAN = 1 * MiB;
constexpr size_t WS_SLAB4 = 218 * MiB, WS_SLAB6 = 251 * MiB, WS_SLAB9 = 350 * MiB;
#ifndef SNT5
#define SNT5 2
#endif
#ifndef SNT7
#define SNT7 4
#endif
constexpr int NSL4 = 32, NSL6 = 32 / SNT5, NSL9 = 88 / SNT7;
constexpr size_t WS_WIN = 4 * MiB, WS_WPROJ = 60 * MiB, WS_WOUT = 76 * MiB, WS_WGU = 84 * MiB, WS_WDN = 128 * MiB, WS_WRG = 150 * MiB;
constexpr size_t WS_H1 = 152 * MiB;
constexpr size_t WS_Q = 185 * MiB, WS_K = 218 * MiB, WS_V = 251 * MiB, WS_U = 284 * MiB, WS_G = 317 * MiB, WS_SA = 350 * MiB, WS_SR = 383 * MiB;
constexpr size_t WS_MERGED = WS_Q;
constexpr size_t WS_ACT = WS_K;
constexpr size_t WS_OY = 416 * MiB;
constexpr size_t WS_END = 482 * MiB;
static_assert(WS_ACT + (size_t)MPAD * DFF * 2 <= WS_G, "ACT overlay");
constexpr int CW_TMO = 0, CW_READY = 2048, CW_BAR = 4096;
constexpr size_t WS_XW = 640 * 1024;

constexpr int RING_BYTES = 131072, LDSCTL_OFF = RING_BYTES, MISC_OFF = LDSCTL_OFF + 320, LDS_BYTES = 147456;
constexpr int NWAVES = 8;

#define GAS __attribute__((address_space(1)))
#define LAS __attribute__((address_space(3)))
typedef unsigned short bf16_t;
typedef unsigned v4u __attribute__((ext_vector_type(4)));
typedef unsigned v2u __attribute__((ext_vector_type(2)));
typedef float f32x4 __attribute__((ext_vector_type(4)));
typedef float f32x2 __attribute__((ext_vector_type(2)));
typedef float f32x16 __attribute__((ext_vector_type(16)));
typedef short bf16x8 __attribute__((ext_vector_type(8)));
typedef short s16x4 __attribute__((ext_vector_type(4)));
typedef GAS unsigned gu32;
typedef GAS unsigned long long gu64;
#define RLX_AGENT __ATOMIC_RELAXED, __HIP_MEMORY_SCOPE_AGENT
#define LDS_WAIT() asm volatile("s_waitcnt lgkmcnt(0)" ::: "memory")
#define VM_WAIT() asm volatile("s_waitcnt vmcnt(0)" ::: "memory")

__device__ __forceinline__ unsigned f2bf(float f) { unsigned u = __builtin_bit_cast(unsigned, f); return (u + 0x7fffu + ((u >> 16) & 1u)) >> 16; }
__device__ __forceinline__ unsigned pk2(float lo, float hi) { return f2bf(lo) | (f2bf(hi) << 16); }
__device__ __forceinline__ float bf2f(unsigned short h) { return __builtin_bit_cast(float, (unsigned)h << 16); }
__device__ __forceinline__ float bflo(unsigned w) { return __builtin_bit_cast(float, w << 16); }
__device__ __forceinline__ float bfhi(unsigned w) { return __builtin_bit_cast(float, w & 0xffff0000u); }
typedef __bf16 bf16x2_t __attribute__((ext_vector_type(2)));
__device__ __forceinline__ unsigned cvt_pk_bf16(float lo, float hi) { f32x2 v = {lo, hi}; bf16x2_t b = __builtin_convertvector(v, bf16x2_t); return __builtin_bit_cast(unsigned, b); }
__device__ __forceinline__ float sigm(float x) { return __builtin_amdgcn_rcpf(1.f + __expf(-x)); }
__device__ __forceinline__ float gelu_tanh(float x) { return x * sigm(1.5957691216057308f * (x + 0.044715f * x * x * x)); }
__device__ __forceinline__ float wave_sum(float v) {
#pragma unroll
    for (int o = 1; o < 64; o <<= 1) v += __shfl_xor(v, o);
    return v;
}
__device__ __forceinline__ float wave_max(float v) {
#pragma unroll
    for (int o = 1; o < 64; o <<= 1) v = fmaxf(v, __shfl_xor(v, o));
    return v;
}

namespace pg8 {
#define PG8_LAS __attribute__((address_space(3)))
constexpr int BM = 256, BK = 64, HALF = 128, HTB = HALF * BK * 2, STAGE_BYTES = 8 * HTB, NXCD = 8, WGM = 2;
__host__ __device__ __forceinline__ int lds_byte(int r, int c) { const int st = (r >> 4) * 2 + (c >> 5), rr = r & 15, cc = c & 31, ob = rr * 64 + cc * 2; return st * 1024 + (ob ^ (((ob >> 9) & 1) << 5)); }
__host__ __device__ __forceinline__ void stage_rc(int b, int& R, int& C) { const int st = b / 1024, sb = b % 1024, swz = sb ^ (((sb >> 9) & 1) << 5); R = (st >> 1) * 16 + swz / 64; C = (st & 1) * 32 + (swz % 64) / 2; }
__host__ __device__ __forceinline__ int perm32(int rho) { const int n = rho >> 4, i = rho & 15; return 8 * (i >> 2) + 4 * n + (i & 3); }
struct Unit { int pm, pn, k0, nt; };
struct Gemm { const bf16_t* A; const bf16_t* Bt; int M, N, K; };
struct StaticOrder {
    int nM, nN, nwg, G, c, ntf, wgm;
    __host__ __device__ void init(int M, int N, int K, int G_, int c_, int wgm_ = WGM) { nM = M / BM; nN = N / BM; nwg = nM * nN; G = G_; c = c_; ntf = K / BK; wgm = wgm_; }
    __host__ __device__ __forceinline__ bool next(int i, Unit& u) const { return at((long)i * G + c, u); }
    __host__ __device__ __forceinline__ bool at(long L, Unit& u) const {
        u.pm = 0; u.pn = 0; u.k0 = 0; u.nt = ntf;
        if (L >= nwg) return false;
#ifndef XCDREMAP
#define XCDREMAP 1
#endif
        int wgid = (int)L; if (XCDREMAP) { const int q = nwg / NXCD, r = nwg % NXCD, xcd = wgid % NXCD, off = wgid / NXCD; wgid = (xcd < r ? xcd * (q + 1) : r * (q + 1) + (xcd - r) * q) + off; }
        const int nig = wgm * nN, gid = wgid / nig, fm = gid * wgm, gsz = (nM - fm) < wgm ? (nM - fm) : wgm;
        u.pm = fm + ((wgid % nig) % gsz); u.pn = (wgid % nig) / gsz; return true;
    }
    __device__ __forceinline__ void a_ready(const Unit&) const {}
    __device__ __forceinline__ void done(const Unit&) const {}
};
struct SampleGatedOrder : StaticOrder {
    const unsigned* ready; unsigned need;
    __device__ __forceinline__ void a_ready(const Unit& u) const {
        if (u.pm != 32) return;
        if (threadIdx.x < 64) { unsigned polls = 0;
            while ((unsigned)__builtin_amdgcn_readfirstlane(__hip_atomic_load(ready, __ATOMIC_RELAXED, __HIP_MEMORY_SCOPE_AGENT)) < need) { __builtin_amdgcn_s_sleep(2); if (++polls > (1u << 20)) break; }
            __builtin_amdgcn_fence(__ATOMIC_ACQUIRE, "agent");
            asm volatile("s_waitcnt vmcnt(0)" ::: "memory"); }
        asm volatile("" ::: "memory"); __builtin_amdgcn_s_barrier(); asm volatile("" ::: "memory");
    }
};
struct HybridOrder {
    StaticOrder base; int snt, npn, nsl; const unsigned* ready = nullptr; unsigned need = 0;
    bool slices_first = false;
    __host__ __device__ void init(int N, int K, int G_, int c_, int snt_, int wgm_ = WGM) { base.init(8192, N, K, G_, c_, wgm_); snt = snt_; npn = N / BM; nsl = (K / BK) / snt_; }
    __host__ __device__ __forceinline__ bool next(int i, Unit& u) const {
        const long L = (long)i * base.G + base.c;
        if (slices_first) { const long ns = (long)npn * nsl;
            if (L >= ns) return base.at(L - ns, u);
            u.pm = 32; u.pn = (int)(L % npn); u.k0 = (int)(L / npn) * snt; u.nt = snt; return true; }
        if (L < base.nwg) return base.at(L, u);
        const int sidx = (int)(L - base.nwg);
        u.pm = 32; u.pn = sidx % npn; u.k0 = (sidx / npn) * snt; u.nt = snt; return sidx < npn * nsl;
    }
    __device__ __forceinline__ void a_ready(const Unit& u) const {
        if (u.pm != 32 || ready == nullptr) return;
        if (threadIdx.x < 64) { unsigned polls = 0;
            while ((unsigned)__builtin_amdgcn_readfirstlane(__hip_atomic_load(ready, __ATOMIC_RELAXED, __HIP_MEMORY_SCOPE_AGENT)) < need) { __builtin_amdgcn_s_sleep(2); if (++polls > (1u << 20)) break; }
            __builtin_amdgcn_fence(__ATOMIC_ACQUIRE, "agent");
            asm volatile("s_waitcnt vmcnt(0)" ::: "memory"); }
        asm volatile("" ::: "memory"); __builtin_amdgcn_s_barrier(); asm volatile("" ::: "memory");
    }
    __device__ __forceinline__ void done(const Unit&) const {}
};
template <class Epi, class Sched, bool ALIGN_EPI = false, bool SP2 = false>
__device__ __forceinline__ void gemm_phase(PG8_LAS unsigned char* lds, const Gemm g, const Sched& S, const Epi& E) {
    const int tid = threadIdx.x, wid = __builtin_amdgcn_readfirstlane(tid >> 6), lane = tid & 63, wr = wid >> 2, wc = wid & 3, fr = lane & 15, fq = lane >> 4;
    const int K = g.K, nt = K / BK;
    unsigned voffA[2], voffB[2];
#pragma unroll
    for (int i = 0; i < 2; ++i) { int R, C; stage_rc(tid * 16 + i * 8192, R, C); const int Rb = Epi::PERM ? ((R & ~31) + perm32(R & 31)) : R;
        voffA[i] = (unsigned)(R * K + C) * 2u; voffB[i] = (unsigned)(Rb * K + C) * 2u; }
    const size_t kstep = (size_t)(BK * 2);
    const size_t hstep = (size_t)HALF * K * 2;
    const size_t tstep = 2 * hstep;
    const unsigned ldsw = (unsigned)wid * 1024u;
    const int aoff = lds_byte(wr * 64 + fr, fq * 8), boff = lds_byte(wc * 32 + fr, fq * 8);
#define PG8_SA(b, h) (((b) * 2 + (h)) * HTB)
#define PG8_SB(b, h) ((4 + (b) * 2 + (h)) * HTB)
#define PG8_STAGE(bufoff, gbase, voff) do { _Pragma("unroll") for (int _i = 0; _i < 2; ++_i) \
        __builtin_amdgcn_global_load_lds((const unsigned*)((const char*)(gbase) + (voff)[_i]), (PG8_LAS unsigned*)(lds + (bufoff) + ldsw + _i * 8192), 16, 0, 0); } while (0)
#define PG8_LDA(dst, b, h) do { _Pragma("unroll") for (int m = 0; m < 4; ++m) _Pragma("unroll") for (int k = 0; k < 2; ++k) dst[m][k] = *(const PG8_LAS bf16x8*)(lds + PG8_SA(b, h) + aoff + m * 2048 + k * 1024); } while (0)
#define PG8_LDB(dst, b, h) do { _Pragma("unroll") for (int n = 0; n < 2; ++n) _Pragma("unroll") for (int k = 0; k < 2; ++k) dst[n][k] = *(const PG8_LAS bf16x8*)(lds + PG8_SB(b, h) + boff + n * 2048 + k * 1024); } while (0)
#define PG8_MMA(ai, bj, At, Bt) do { __builtin_amdgcn_s_setprio(1); _Pragma("unroll") for (int m = 0; m < 4; ++m) _Pragma("unroll") for (int n = 0; n < 2; ++n) _Pragma("unroll") for (int k = 0; k < 2; ++k) \
        acc[ai][bj][m][n] = __builtin_amdgcn_mfma_f32_16x16x32_bf16(Bt[n][k], At[m][k], acc[ai][bj][m][n], 0, 0, 0); __builtin_amdgcn_s_setprio(0); } while (0)
#define PG8_WAIT_V(n) asm volatile("s_waitcnt vmcnt(" #n ")" ::: "memory")
#define PG8_WAIT_L(n) asm volatile("s_waitcnt lgkmcnt(" #n ")" ::: "memory")
#define PG8_BAR __builtin_amdgcn_s_barrier()
#define PG8_SCHED __builtin_amdgcn_sched_barrier(0)
    Unit cur, nxt; int ui = 0;
    if (!S.next(0, cur)) return;
    f32x4 acc[2][2][4][2];
#pragma unroll
    for (int a = 0; a < 2; ++a)
#pragma unroll
        for (int b = 0; b < 2; ++b)
#pragma unroll
            for (int m = 0; m < 4; ++m)
#pragma unroll
                for (int n = 0; n < 2; ++n) acc[a][b][m][n] = (f32x4){0.f, 0.f, 0.f, 0.f};
    bf16x8 At[4][2], B0[2][2], B1[2][2];
    const char* cA = (const char*)g.A + (size_t)cur.pm * tstep + (size_t)cur.k0 * kstep; const char* cB = (const char*)g.Bt + (size_t)cur.pn * tstep + (size_t)cur.k0 * kstep;
    S.a_ready(cur);
    if constexpr (SP2) {
        PG8_STAGE(PG8_SB(0, 0), cB, voffB); PG8_STAGE(PG8_SB(0, 1), cB + hstep, voffB); PG8_STAGE(PG8_SA(0, 0), cA, voffA); PG8_STAGE(PG8_SA(0, 1), cA + hstep, voffA);
        if (wr == 1) PG8_BAR;
        PG8_WAIT_V(2); PG8_BAR;
        PG8_STAGE(PG8_SB(1, 0), cB + kstep, voffB); PG8_STAGE(PG8_SA(1, 0), cA + kstep, voffA); PG8_STAGE(PG8_SB(1, 1), cB + hstep + kstep, voffB);
        PG8_WAIT_V(6); PG8_BAR;
    } else {
        PG8_STAGE(PG8_SB(0, 0), cB, voffB); PG8_STAGE(PG8_SA(0, 0), cA, voffA); PG8_STAGE(PG8_SB(0, 1), cB + hstep, voffB); PG8_STAGE(PG8_SA(0, 1), cA + hstep, voffA);
        if (wr == 1) PG8_BAR;
        PG8_WAIT_V(4); PG8_BAR;
        PG8_STAGE(PG8_SB(1, 0), cB + kstep, voffB); PG8_STAGE(PG8_SA(1, 0), cA + kstep, voffA); PG8_STAGE(PG8_SB(1, 1), cB + hstep + kstep, voffB);
        PG8_WAIT_V(6); PG8_BAR;
    }
    for (;;) {
        const bool has_next = S.next(ui + 1, nxt);
        const char* nA = has_next ? (const char*)g.A + (size_t)nxt.pm * tstep + (size_t)nxt.k0 * kstep : cA; const char* nB = has_next ? (const char*)g.Bt + (size_t)nxt.pn * tstep + (size_t)nxt.k0 * kstep : cB;
        const int cnt = cur.nt;
        for (int t = 0; t < cnt; t += 2) {
            if constexpr (Epi::MIDK) { if (cnt == nt && t == (nt >> 1)) E.mid(acc, cur, wr, wc, fr, fq); }
            const bool last = (t == cnt - 2);
            const char* a1 = cA + (size_t)(t + 1) * kstep;
            const char* a2 = last ? nA : cA + (size_t)(t + 2) * kstep; const char* b2 = last ? nB : cB + (size_t)(t + 2) * kstep;
            const char* a3 = a2 + kstep; const char* b3 = b2 + kstep;
            if (last && has_next) S.a_ready(nxt);
            if constexpr (SP2) {
            PG8_LDB(B0, 0, 0); PG8_LDB(B1, 0, 1); PG8_SCHED; PG8_LDA(At, 0, 0); PG8_STAGE(PG8_SA(1, 1), a1 + hstep, voffA);
            PG8_WAIT_V(8); PG8_WAIT_L(0); PG8_BAR; PG8_MMA(0, 0, At, B0); PG8_MMA(0, 1, At, B1); PG8_BAR; PG8_SCHED;
            PG8_LDA(At, 0, 1); PG8_STAGE(PG8_SB(0, 0), b2, voffB); PG8_STAGE(PG8_SB(0, 1), b2 + hstep, voffB); PG8_STAGE(PG8_SA(0, 0), a2, voffA);
            PG8_WAIT_V(8); PG8_WAIT_L(0); PG8_BAR; PG8_MMA(1, 0, At, B0); PG8_MMA(1, 1, At, B1); PG8_BAR; PG8_SCHED;
            PG8_LDB(B0, 1, 0); PG8_LDB(B1, 1, 1); PG8_SCHED; PG8_LDA(At, 1, 0); PG8_STAGE(PG8_SA(0, 1), a2 + hstep, voffA);
            PG8_WAIT_V(8); PG8_WAIT_L(0); PG8_BAR; PG8_MMA(0, 0, At, B0); PG8_MMA(0, 1, At, B1); PG8_BAR; PG8_SCHED;
            PG8_LDA(At, 1, 1); PG8_STAGE(PG8_SB(1, 0), b3, voffB); PG8_STAGE(PG8_SB(1, 1), b3 + hstep, voffB); PG8_STAGE(PG8_SA(1, 0), a3, voffA);
            PG8_WAIT_V(8); PG8_WAIT_L(0); PG8_BAR; PG8_MMA(1, 0, At, B0); PG8_MMA(1, 1, At, B1); PG8_BAR; PG8_SCHED;
            } else {
            PG8_LDB(B0, 0, 0); PG8_SCHED; PG8_LDA(At, 0, 0); PG8_STAGE(PG8_SA(1, 1), a1 + hstep, voffA);
            PG8_WAIT_L(8); PG8_BAR; PG8_WAIT_L(0); PG8_MMA(0, 0, At, B0); PG8_BAR; PG8_SCHED;
            PG8_LDB(B1, 0, 1); PG8_STAGE(PG8_SB(0, 0), b2, voffB);
            PG8_BAR; PG8_WAIT_L(0); PG8_MMA(0, 1, At, B1); PG8_BAR;
            PG8_LDA(At, 0, 1); PG8_STAGE(PG8_SA(0, 0), a2, voffA);
            PG8_BAR; PG8_WAIT_L(0); PG8_MMA(1, 0, At, B0); PG8_BAR; PG8_SCHED;
            PG8_STAGE(PG8_SB(0, 1), b2 + hstep, voffB);
            PG8_WAIT_V(6); PG8_BAR; PG8_MMA(1, 1, At, B1); PG8_BAR;
            PG8_LDB(B0, 1, 0); PG8_SCHED; PG8_LDA(At, 1, 0); PG8_STAGE(PG8_SA(0, 1), a2 + hstep, voffA);
            PG8_WAIT_L(8); PG8_BAR; PG8_WAIT_L(0); PG8_MMA(0, 0, At, B0); PG8_BAR; PG8_SCHED;
            PG8_LDB(B1, 1, 1); PG8_STAGE(PG8_SB(1, 0), b3, voffB);
            PG8_BAR; PG8_WAIT_L(0); PG8_MMA(0, 1, At, B1); PG8_BAR;
            PG8_LDA(At, 1, 1); PG8_STAGE(PG8_SA(1, 0), a3, voffA);
            PG8_BAR; PG8_WAIT_L(0); PG8_MMA(1, 0, At, B0); PG8_BAR; PG8_SCHED;
            PG8_STAGE(PG8_SB(1, 1), b3 + hstep, voffB);
            PG8_WAIT_V(6); PG8_BAR; PG8_MMA(1, 1, At, B1); PG8_BAR;
            }
        }
        if constexpr (ALIGN_EPI) { if (wr == 0) PG8_BAR; }
        if constexpr (Epi::AFTER_DRAIN) { if (has_next) E(acc, cur, wr, wc, fr, fq); } else { E(acc, cur, wr, wc, fr, fq); }
        S.done(cur);
        if (!has_next) break;
#pragma unroll
        for (int a = 0; a < 2; ++a)
#pragma unroll
            for (int b = 0; b < 2; ++b)
#pragma unroll
                for (int m = 0; m < 4; ++m)
#pragma unroll
                    for (int n = 0; n < 2; ++n) acc[a][b][m][n] = (f32x4){0.f, 0.f, 0.f, 0.f};
        cur = nxt; cA = nA; cB = nB; ++ui;
        if constexpr (ALIGN_EPI) { if (wr == 1) PG8_BAR; }
    }
    PG8_WAIT_V(0);
    if constexpr (!ALIGN_EPI) { if (wr == 0) PG8_BAR; }
    PG8_BAR;
    if constexpr (Epi::AFTER_DRAIN) E.fused(acc, cur, wr, wc, fr, fq, lds);
#undef PG8_SA
#undef PG8_SB
#undef PG8_STAGE
#undef PG8_LDA
#undef PG8_LDB
#undef PG8_MMA
#undef PG8_WAIT_V
#undef PG8_WAIT_L
#undef PG8_BAR
#undef PG8_SCHED
}
}

#ifndef PROBE_PHASE
#define PROBE_PHASE -1
#endif
__device__ __forceinline__ void probe_mark(int id, unsigned char* ws) {
    if (PROBE_PHASE >= 100 && blockIdx.x == 0 && threadIdx.x == 0) { const int a = (PROBE_PHASE - 100) / 10, b = (PROBE_PHASE - 100) % 10;
        unsigned* w = (unsigned*)ws; const unsigned now = (unsigned)__builtin_amdgcn_s_memrealtime();
        if (id == a) w[3] = now; if (id == b) w[2] = now - w[3]; }
}
__device__ __forceinline__ v4u pack8bf(f32x4 a, f32x4 b) { v4u w; w.x = cvt_pk_bf16(a[0], a[1]); w.y = cvt_pk_bf16(a[2], a[3]); w.z = cvt_pk_bf16(b[0], b[1]); w.w = cvt_pk_bf16(b[2], b[3]); return w; }
__device__ __forceinline__ void unpack8bf(v4u w, f32x4& a, f32x4& b) { a = (f32x4){bflo(w.x), bfhi(w.x), bflo(w.y), bfhi(w.y)}; b = (f32x4){bflo(w.z), bfhi(w.z), bflo(w.w), bfhi(w.w)}; }

struct EpiIn {
    static constexpr bool PERM = true, MIDK = false, AFTER_DRAIN = false;
    bf16_t* base;
    float* out;
    __device__ __forceinline__ void mid(f32x4 (&)[2][2][4][2], const pg8::Unit&, int, int, int, int) const {}
    template <int MODE>
    __device__ __forceinline__ void store_bf(const f32x4 (&acc)[2][2][4][2], const pg8::Unit& u, int wr, int wc, int fr, int fq, bf16_t* dst) const {
        const int colr = (u.pn & 7) * 256 + wc * 32 + 8 * fq;
#pragma unroll
        for (int ai = 0; ai < 2; ++ai)
#pragma unroll
            for (int m = 0; m < 4; ++m) {
                const size_t row = (size_t)u.pm * 256 + ai * 128 + wr * 64 + m * 16 + fr;
#pragma unroll
                for (int bj = 0; bj < 2; ++bj) {
                    f32x4 v0 = acc[ai][bj][m][0], v1 = acc[ai][bj][m][1];
                    if (MODE == 1) {
#pragma unroll
                        for (int e = 0; e < 4; ++e) { v0[e] = gelu_tanh(v0[e]); v1[e] = gelu_tanh(v1[e]); }
                    } else if (MODE == 2) {
#pragma unroll
                        for (int e = 0; e < 4; ++e) { v0[e] = sigm(v0[e]); v1[e] = sigm(v1[e]); }
                    }
                    *(v4u*)(dst + row * DM + colr + bj * 128) = pack8bf(v0, v1);
                }
                asm volatile("" ::: "memory");
            }
    }
    __device__ __forceinline__ void store_f32(const f32x4 (&acc)[2][2][4][2], const pg8::Unit& u, int wr, int wc, int fr, int fq, float* orow0, int rl0, int rl1) const {
        const int colr = (u.pn & 7) * 256 + wc * 32 + 8 * fq;
#pragma unroll
        for (int ai = 0; ai < 2; ++ai)
#pragma unroll
            for (int m = 0; m < 4; ++m) {
                const int rl = ai * 128 + wr * 64 + m * 16 + fr;
                if (rl >= rl0 && rl < rl1) {
                    float* o = orow0 + (size_t)(rl - rl0) * DM + colr;
#pragma unroll
                    for (int bj = 0; bj < 2; ++bj) { *(f32x4*)(o + bj * 128) = acc[ai][bj][m][0]; *(f32x4*)(o + bj * 128 + 4) = acc[ai][bj][m][1]; }
                }
                asm volatile("" ::: "memory");
            }
    }
    __device__ __forceinline__ void store_f32_sconv(const f32x4 (&acc)[2][2][4][2], const pg8::Unit& u, int wr, int wc, int fr, int fq) const {
        const int colr = (u.pn & 7) * 256 + wc * 32 + 8 * fq;
        if (fr >= 13) {
#pragma unroll
            for (int m = 0; m < 4; ++m) {
                const int rl = wr * 64 + m * 16 + fr;
                float* o = out + O_SC + ((size_t)((rl >> 4) * 3 + fr - 13)) * DM + colr;
#pragma unroll
                for (int bj = 0; bj < 2; ++bj) { *(f32x4*)(o + bj * 128) = acc[0][bj][m][0]; *(f32x4*)(o + bj * 128 + 4) = acc[0][bj][m][1]; }
                asm volatile("" ::: "memory");
            }
        }
    }
    __device__ __forceinline__ void operator()(const f32x4 (&acc)[2][2][4][2], const pg8::Unit& u, int wr, int wc, int fr, int fq) const {
        const int region = u.pn >> 3, pm = u.pm;
        bf16_t* dst = base + (size_t)region * (33 * MiB / 2);
        const bool sample = (pm == 32);
        if (region == 4) store_bf<1>(acc, u, wr, wc, fr, fq, dst);
        else if (region >= 5) store_bf<2>(acc, u, wr, wc, fr, fq, dst);
        else store_bf<0>(acc, u, wr, wc, fr, fq, dst);
        if (region == 1 || region == 2) {
            if (sample) store_f32(acc, u, wr, wc, fr, fq, out + (region == 1 ? O_SK : O_SV), 0, 128);
            else if ((pm & 15) >= 14) store_f32(acc, u, wr, wc, fr, fq, out + (region == 1 ? O_PK : O_PV) + ((size_t)((pm >> 4) * 512 + ((pm & 15) - 14) * 256)) * DM, 0, 256);
        } else if (region == 3) {
            if (sample) store_f32_sconv(acc, u, wr, wc, fr, fq);
            else if ((pm & 15) == 15) store_f32(acc, u, wr, wc, fr, fq, out + O_PC + (size_t)((pm >> 4) * 3) * DM, 253, 256);
        }
    }
};
template <bool GATED>
__device__ __forceinline__ void slice_store(const f32x4 (&acc)[2][2][4][2], const pg8::Unit& u, int wr, int wc, int fr, int fq, float* slabs, const bf16_t* gate) {
    int opq = 0; asm volatile("" : "+v"(opq));
    const int col0 = u.pn * 256 + wc * 32 + 8 * fq;
    float* slab = slabs + (size_t)(u.k0 / u.nt) * (128 * DM);
#pragma unroll
    for (int m = 0; m < 4; ++m) {
        const int rl = wr * 64 + m * 16 + fr + opq;
#pragma unroll
        for (int bj = 0; bj < 2; ++bj) {
            const int c = col0 + bj * 128;
            f32x4 v0 = acc[0][bj][m][0], v1 = acc[0][bj][m][1];
            if (GATED) { f32x4 g0, g1; unpack8bf(*(const v4u*)(gate + (size_t)(MP + rl) * DM + c), g0, g1); v0 = v0 * g0; v1 = v1 * g1; }
            float* p = slab + (size_t)rl * DM + c;
            *(f32x4*)p = v0; *(f32x4*)(p + 4) = v1;
        }
        if (m & 1) asm volatile("" ::: "memory");
    }
}
struct EpiProj {
    static constexpr bool PERM = true, MIDK = true, AFTER_DRAIN = false;
    const bf16_t* SA; const bf16_t* SR; bf16_t* O; float* sacc; unsigned char* pws;
    __device__ __forceinline__ void mid(f32x4 (&acc)[2][2][4][2], const pg8::Unit& u, int wr, int wc, int fr, int fq) const {
        probe_mark(6, pws);
        int opq = 0; asm volatile("" : "+v"(opq));
        const int col0 = u.pn * 256 + wc * 32 + 8 * fq;
        const int rowb = u.pm * 256 + wr * 64 + fr + opq;
#pragma unroll
        for (int ai = 0; ai < 2; ++ai)
#pragma unroll
            for (int m = 0; m < 4; ++m) {
                const size_t row = (size_t)(rowb + ai * 128 + m * 16);
#pragma unroll
                for (int bj = 0; bj < 2; ++bj) {
                    const size_t off = row * DM + col0 + bj * 128;
                    f32x4 a0, a1, r0, r1; unpack8bf(*(const v4u*)(SA + off), a0, a1); unpack8bf(*(const v4u*)(SR + off), r0, r1);
#pragma unroll
                    for (int e = 0; e < 4; ++e) { acc[ai][bj][m][0][e] *= a0[e] * __builtin_amdgcn_rcpf(r0[e]); acc[ai][bj][m][1][e] *= a1[e] * __builtin_amdgcn_rcpf(r1[e]); }
                }
                if (m & 1) asm volatile("" : "+v"(acc[ai][0][m][0]), "+v"(acc[ai][0][m][1]), "+v"(acc[ai][1][m][0]), "+v"(acc[ai][1][m][1]) :: "memory");
            }
        probe_mark(7, pws);
    }
    __device__ __forceinline__ void operator()(const f32x4 (&acc)[2][2][4][2], const pg8::Unit& u, int wr, int wc, int fr, int fq) const {
        probe_mark(8, pws);
        if (u.pm == 32) { slice_store<true>(acc, u, wr, wc, fr, fq, sacc, u.k0 < 32 ? SA : SR); return; }
        const int col0 = u.pn * 256 + wc * 32 + 8 * fq;
#pragma unroll
        for (int ai = 0; ai < 2; ++ai)
#pragma unroll
            for (int m = 0; m < 4; ++m) {
                const size_t row = (size_t)u.pm * 256 + ai * 128 + wr * 64 + m * 16 + fr;
#pragma unroll
                for (int bj = 0; bj < 2; ++bj) {
                    const size_t off = row * DM + col0 + bj * 128;
                    f32x4 r0, r1; unpack8bf(*(const v4u*)(SR + off), r0, r1);
                    *(v4u*)(O + off) = pack8bf(acc[ai][bj][m][0] * r0, acc[ai][bj][m][1] * r1);
                }
                if (m & 1) asm volatile("" ::: "memory");
            }
    }
};
constexpr int XL_OFF = LDSCTL_OFF + 1024;
__device__ __forceinline__ void panel_rinv(const f32x4 (&v)[2][2][4][2], const pg8::Unit& u, int wr, int wc, int fr, int fq, LAS unsigned char* xl, unsigned long long* xw) {
    const int lane = threadIdx.x & 63, wid = wr * 4 + wc;
    LAS float* P = (LAS float*)xl;
    LAS float* S = P + 1024;
#pragma unroll
    for (int ai = 0; ai < 2; ++ai)
#pragma unroll
        for (int m = 0; m < 4; ++m) { float q = 0.f;
#pragma unroll
            for (int bj = 0; bj < 2; ++bj)
#pragma unroll
                for (int n = 0; n < 2; ++n) { const f32x4 x = v[ai][bj][m][n]; q += (x[0] * x[0] + x[1] * x[1]) + (x[2] * x[2] + x[3] * x[3]); }
            q += __shfl_xor(q, 16); q += __shfl_xor(q, 32);
            if (fq == 0) P[(ai * 128 + wr * 64 + m * 16 + fr) * 4 + wc] = q; }
    asm volatile("s_waitcnt lgkmcnt(0)" ::: "memory"); __builtin_amdgcn_s_barrier(); asm volatile("" ::: "memory");
    int opq = 0; asm volatile("" : "+v"(opq));
    if (lane < 32) { const int row = wid * 32 + lane + opq; const f32x4 a = *(const LAS f32x4*)(P + row * 4);
        const float q = (a[0] + a[1]) + (a[2] + a[3]);
        unsigned long long* w = xw + (size_t)u.pm * 256 + row;
        const unsigned long long inc = (1ull << 56) + (unsigned long long)(q * 1048576.f);
        unsigned long long cur = __hip_atomic_fetch_add(w, inc, __ATOMIC_RELAXED, __HIP_MEMORY_SCOPE_AGENT) + inc;
        unsigned spins = 0;
        while ((cur >> 56) < 8ull) { __builtin_amdgcn_s_sleep(1); cur = __hip_atomic_load(w, __ATOMIC_RELAXED, __HIP_MEMORY_SCOPE_AGENT); if (++spins > (1u << 18)) break; }
        S[row] = rsqrtf((float)(cur & ((1ull << 56) - 1)) * (1.f / (1048576.f * DM)) + EPS); }
    asm volatile("s_waitcnt vmcnt(0) lgkmcnt(0)" ::: "memory"); __builtin_amdgcn_s_barrier(); asm volatile("" ::: "memory");
}
__device__ __forceinline__ void residual_dma(f32x4 (&acc)[2][2][4][2], const float* res, size_t row_base  , int col0, const float* gate, int wr, int wc, int fr, int fq, LAS unsigned char* lds) {
    const int wid = __builtin_amdgcn_readfirstlane(wr * 4 + wc), lane = threadIdx.x & 63;
    LAS unsigned char* wreg = lds + wid * 16384;
    f32x4 gg[2][2];
#pragma unroll
    for (int bj = 0; bj < 2; ++bj) { gg[bj][0] = *(const f32x4*)(gate + col0 + bj * 128); gg[bj][1] = *(const f32x4*)(gate + col0 + bj * 128 + 4); }
#pragma unroll
    for (int ai = 0; ai < 2; ++ai) {
        const float* rb = res + (row_base + ai * 128 + wr * 64 + fr) * DM + col0;
#pragma unroll
        for (int m = 0; m < 4; ++m)
#pragma unroll
            for (int bj = 0; bj < 2; ++bj)
#pragma unroll
                for (int hf = 0; hf < 2; ++hf)
                    __builtin_amdgcn_global_load_lds((const unsigned*)(rb + (size_t)(16 * m) * DM + bj * 128 + 4 * hf), (LAS unsigned*)(wreg + ((m * 2 + bj) * 2 + hf) * 1024), 16, 0, 0);
        asm volatile("s_waitcnt vmcnt(0)" ::: "memory");
#pragma unroll
        for (int m = 0; m < 4; ++m)
#pragma unroll
            for (int bj = 0; bj < 2; ++bj) {
                const f32x4 x0 = *(const LAS f32x4*)(wreg + ((m * 2 + bj) * 2 + 0) * 1024 + lane * 16), x1 = *(const LAS f32x4*)(wreg + ((m * 2 + bj) * 2 + 1) * 1024 + lane * 16);
                acc[ai][bj][m][0] = x0 + gg[bj][0] * acc[ai][bj][m][0]; acc[ai][bj][m][1] = x1 + gg[bj][1] * acc[ai][bj][m][1];
                asm volatile("" : "+v"(acc[ai][bj][m][0]), "+v"(acc[ai][bj][m][1]) :: "memory"); }
        asm volatile("s_waitcnt lgkmcnt(0)" ::: "memory");
    }
}
struct EpiResNorm {
    static constexpr bool PERM = true, MIDK = false, AFTER_DRAIN = true;
    const float* xin; float* x1o; bf16_t* h2o; const float* mod; float* slabs; LAS unsigned char* xl; unsigned long long* xw; unsigned char* pws;
    __device__ __forceinline__ void mid(f32x4 (&)[2][2][4][2], const pg8::Unit&, int, int, int, int) const {}
    __device__ __forceinline__ void finish(f32x4 (&acc)[2][2][4][2], const pg8::Unit& u, int wr, int wc, int fr, int fq) const {
        const int col0 = u.pn * 256 + wc * 32 + 8 * fq;
        const float* md = mod + (size_t)(u.pm >> 4) * NMOD;
        panel_rinv(acc, u, wr, wc, fr, fq, xl, xw);
        probe_mark(4, pws);
        const LAS float* S = (const LAS float*)xl + 1024;
        int opq = 0; asm volatile("" : "+v"(opq));
        const int rl0 = wr * 64 + fr + opq;
#pragma unroll
        for (int bj = 0; bj < 2; ++bj)
#pragma unroll
            for (int n = 0; n < 2; ++n) {
                const int c = col0 + bj * 128 + 4 * n;
                const f32x4 s0 = *(const f32x4*)(md + 4 * DM + c) + 1.f, h0 = *(const f32x4*)(md + 3 * DM + c);
#pragma unroll
                for (int ai = 0; ai < 2; ++ai)
#pragma unroll
                    for (int m = 0; m < 4; ++m) {
                        const int rl = rl0 + ai * 128 + m * 16; const float rv = S[rl];
                        const size_t ro = (size_t)(u.pm * 256 + rl) * DM + c;
                        *(f32x4*)(x1o + ro) = acc[ai][bj][m][n];
                        const f32x4 y = acc[ai][bj][m][n] * rv * s0 + h0; v2u w; w.x = cvt_pk_bf16(y[0], y[1]); w.y = cvt_pk_bf16(y[2], y[3]);
                        *(v2u*)(h2o + ro) = w;
                    }
                asm volatile("" ::: "memory");
            }
    }
    __device__ __forceinline__ void operator()(f32x4 (&acc)[2][2][4][2], const pg8::Unit& u, int wr, int wc, int fr, int fq) const {
        if (u.pm == 32) { slice_store<false>(acc, u, wr, wc, fr, fq, slabs, nullptr); return; }
        const int col0 = u.pn * 256 + wc * 32 + 8 * fq;
        const float* md = mod + (size_t)(u.pm >> 4) * NMOD;
#pragma unroll
        for (int ai = 0; ai < 2; ++ai)
#pragma unroll
            for (int m = 0; m < 4; ++m) {
                const size_t ro = (size_t)(u.pm * 256 + ai * 128 + wr * 64 + m * 16 + fr) * DM;
#pragma unroll
                for (int bj = 0; bj < 2; ++bj) {
                    const int c = col0 + bj * 128;
                    const f32x4 g0 = *(const f32x4*)(md + 2 * DM + c), g1 = *(const f32x4*)(md + 2 * DM + c + 4);
                    const f32x4 x0 = *(const f32x4*)(xin + ro + c), x1 = *(const f32x4*)(xin + ro + c + 4);
                    acc[ai][bj][m][0] = x0 + g0 * acc[ai][bj][m][0]; acc[ai][bj][m][1] = x1 + g1 * acc[ai][bj][m][1];
                }
                asm volatile("" : "+v"(acc[ai][0][m][0]), "+v"(acc[ai][0][m][1]), "+v"(acc[ai][1][m][0]), "+v"(acc[ai][1][m][1]) :: "memory");
            }
        finish(acc, u, wr, wc, fr, fq);
    }
    __device__ __forceinline__ void fused(f32x4 (&acc)[2][2][4][2], const pg8::Unit& u, int wr, int wc, int fr, int fq, LAS unsigned char* lds) const {
        if (u.pm == 32) { slice_store<false>(acc, u, wr, wc, fr, fq, slabs, nullptr); return; }
        probe_mark(2, pws);
        residual_dma(acc, xin, (size_t)u.pm * 256, u.pn * 256 + wc * 32 + 8 * fq, mod + (size_t)(u.pm >> 4) * NMOD + 2 * DM, wr, wc, fr, fq, lds);
        probe_mark(3, pws);
        finish(acc, u, wr, wc, fr, fq);
        probe_mark(5, pws);
    }
};
struct EpiResFinal {
    static constexpr bool PERM = true, MIDK = false, AFTER_DRAIN = true;
    const float* x1i; float* yo; const float* mod; const float* fng; float* slabs; LAS unsigned char* xl; unsigned long long* xw;
    __device__ __forceinline__ void mid(f32x4 (&)[2][2][4][2], const pg8::Unit&, int, int, int, int) const {}
    __device__ __forceinline__ void finish(f32x4 (&acc)[2][2][4][2], const pg8::Unit& u, int wr, int wc, int fr, int fq) const {
        const int col0 = u.pn * 256 + wc * 32 + 8 * fq;
        panel_rinv(acc, u, wr, wc, fr, fq, xl, xw);
        const LAS float* S = (const LAS float*)xl + 1024;
        int opq = 0; asm volatile("" : "+v"(opq));
        const int rl0 = wr * 64 + fr + opq;
#pragma unroll
        for (int bj = 0; bj < 2; ++bj) {
            const int c = col0 + bj * 128;
            const f32x4 f0 = *(const f32x4*)(fng + c), f1 = *(const f32x4*)(fng + c + 4);
#pragma unroll
            for (int ai = 0; ai < 2; ++ai)
#pragma unroll
                for (int m = 0; m < 4; ++m) {
                    const int rl = rl0 + ai * 128 + m * 16; const float rv = S[rl];
                    float* o = yo + (size_t)(u.pm * 256 + rl) * DM + c;
                    *(f32x4*)o = acc[ai][bj][m][0] * rv * f0; *(f32x4*)(o + 4) = acc[ai][bj][m][1] * rv * f1;
                }
            asm volatile("" ::: "memory");
        }
    }
    __device__ __forceinline__ void operator()(f32x4 (&acc)[2][2][4][2], const pg8::Unit& u, int wr, int wc, int fr, int fq) const {
        if (u.pm == 32) { slice_store<false>(acc, u, wr, wc, fr, fq, slabs, nullptr); return; }
        const int col0 = u.pn * 256 + wc * 32 + 8 * fq;
        const float* gp = mod + (size_t)(u.pm >> 4) * NMOD + 5 * DM;
#pragma unroll
        for (int ai = 0; ai < 2; ++ai)
#pragma unroll
            for (int m = 0; m < 4; ++m) {
                const size_t ro = (size_t)(u.pm * 256 + ai * 128 + wr * 64 + m * 16 + fr) * DM;
#pragma unroll
                for (int bj = 0; bj < 2; ++bj) {
                    const int c = col0 + bj * 128;
                    const f32x4 g0 = *(const f32x4*)(gp + c), g1 = *(const f32x4*)(gp + c + 4);
                    const f32x4 x0 = *(const f32x4*)(x1i + ro + c), x1 = *(const f32x4*)(x1i + ro + c + 4);
                    acc[ai][bj][m][0] = x0 + g0 * acc[ai][bj][m][0]; acc[ai][bj][m][1] = x1 + g1 * acc[ai][bj][m][1];
                }
                asm volatile("" : "+v"(acc[ai][0][m][0]), "+v"(acc[ai][0][m][1]), "+v"(acc[ai][1][m][0]), "+v"(acc[ai][1][m][1]) :: "memory");
            }
        finish(acc, u, wr, wc, fr, fq);
    }
    __device__ __forceinline__ void fused(f32x4 (&acc)[2][2][4][2], const pg8::Unit& u, int wr, int wc, int fr, int fq, LAS unsigned char* lds) const {
        if (u.pm == 32) { slice_store<false>(acc, u, wr, wc, fr, fq, slabs, nullptr); return; }
        residual_dma(acc, x1i, (size_t)u.pm * 256, u.pn * 256 + wc * 32 + 8 * fq, mod + (size_t)(u.pm >> 4) * NMOD + 5 * DM, wr, wc, fr, fq, lds);
        finish(acc, u, wr, wc, fr, fq);
    }
};
struct EpiGU {
    static constexpr bool PERM = true, MIDK = false, AFTER_DRAIN = false;
    bf16_t* O;
    __device__ __forceinline__ void mid(f32x4 (&)[2][2][4][2], const pg8::Unit&, int, int, int, int) const {}
    __device__ __forceinline__ void operator()(const f32x4 (&acc)[2][2][4][2], const pg8::Unit& u, int wr, int wc, int fr, int fq) const {
        const int col0 = u.pn * 128 + wc * 32 + 8 * fq;
#pragma unroll
        for (int ai = 0; ai < 2; ++ai)
#pragma unroll
            for (int m = 0; m < 4; ++m) {
                const size_t row = (size_t)u.pm * 256 + ai * 128 + wr * 64 + m * 16 + fr;
                f32x4 o0, o1;
#pragma unroll
                for (int e = 0; e < 4; ++e) { const float g0 = acc[ai][0][m][0][e], g1 = acc[ai][0][m][1][e];
                    o0[e] = g0 * sigm(g0) * acc[ai][1][m][0][e]; o1[e] = g1 * sigm(g1) * acc[ai][1][m][1][e]; }
                *(v4u*)(O + row * DFF + col0) = pack8bf(o0, o1);
            }
    }
};

namespace att {
constexpr int NW = 8, QBLK = 32, KVBLK = 64, QB = NW * QBLK, D = 128, LDQ = 2048, LDO = 4096;
constexpr int SHM_V = KVBLK * D * 2, SHM_K = KVBLK * D * 2;
constexpr int LDS_BYTES = 2 * SHM_V + 2 * SHM_K + NW * 64 * 4;
constexpr int BIAS_OFF = LDS_BYTES;
constexpr float THR = 8.f;
constexpr float LOG2E = 1.4426950408889634f;
#define KSWZ(row, colB) ((row) * 256 + ((colB) ^ (((row) & 7) << 4)))
#define SBAR() __builtin_amdgcn_sched_barrier(0)
__device__ __forceinline__ int v_st(int k, int c) { const int kk = (k & ~0xC) | ((k & 4) << 1) | ((k & 8) >> 1); return ((kk >> 3) * 4 + (c >> 5)) * 512 + ((kk & 7) * 32 + (c & 31)) * 2; }
__device__ __forceinline__ int v_rd_base(int lane) { return ((lane & 3) << 3) | (((lane >> 2) & 3) << 6) | (((lane >> 4) & 1) << 5) | (((lane >> 5) & 1) << 8); }
constexpr int v_rd_off(int d0, int ks, int half) { return d0 * 512 + ks * 4096 + half * 2048; }
__device__ __forceinline__ int crow(int r, int hi) { return (r & 3) + 8 * (r >> 2) + 4 * hi; }
__device__ __forceinline__ unsigned cvtpk(float lo, float hi) { return cvt_pk_bf16(lo, hi); }
__device__ __forceinline__ bf16x8 load8(const bf16_t* p) { return *reinterpret_cast<const bf16x8*>(p); }
__device__ __forceinline__ int jlo(int qb) { const int j = 4 * qb - 8; return j > 0 ? j : 0; }
__device__ __forceinline__ void bias_tile(f32x16& p0, f32x16& p1, int dq, int dlo, const float* bl) {
    if (dlo - 63 >= 256) { const float bf = bl[319];
#pragma unroll
        for (int r = 0; r < 16; ++r) { p0[r] = fmaf(p0[r], ATT_SCALE, bf); p1[r] = fmaf(p1[r], ATT_SCALE, bf); }
    } else if (dlo + 31 <= 256) {
        const float* bq = bl + dq;
#pragma unroll
        for (int r = 0; r < 16; ++r) { const int c = (r & 3) + 8 * (r >> 2);
            p0[r] = fmaf(p0[r], ATT_SCALE, bq[63 - c]); p1[r] = fmaf(p1[r], ATT_SCALE, bq[31 - c]); }
    } else {
#pragma unroll
        for (int r = 0; r < 16; ++r) { const int c = (r & 3) + 8 * (r >> 2);
            int d0 = dq - c; d0 = d0 > 256 ? 256 : d0; int d1 = dq - c - 32; d1 = d1 > 256 ? 256 : d1;
            p0[r] = fmaf(p0[r], ATT_SCALE, bl[d0 + 63]); p1[r] = fmaf(p1[r], ATT_SCALE, bl[d1 + 63]); }
    }
}
__device__ __forceinline__ void partialSM(f32x16& p0, f32x16& p1, float& m_reg, float& mn, float& alpha) {
    float pmax = p0[0];
#pragma unroll
    for (int r = 1; r < 16; ++r) pmax = fmaxf(pmax, p0[r]);
#pragma unroll
    for (int r = 0; r < 16; ++r) pmax = fmaxf(pmax, p1[r]);
    { auto rr = __builtin_amdgcn_permlane32_swap(__float_as_uint(pmax), __float_as_uint(pmax), false, false);
      pmax = fmaxf(__uint_as_float(rr[0]), __uint_as_float(rr[1])); }
    if (__builtin_expect(__all((pmax - m_reg) <= THR), 1)) { mn = m_reg; alpha = 1.f; }
    else { mn = fmaxf(m_reg, pmax); alpha = __builtin_amdgcn_exp2f((m_reg - mn) * LOG2E); m_reg = mn; }
    const float mnL = -mn * LOG2E;
#pragma unroll
    for (int r = 0; r < 16; ++r) p0[r] = fmaf(p0[r], LOG2E, mnL);
#pragma unroll
    for (int r = 0; r < 16; ++r) p1[r] = fmaf(p1[r], LOG2E, mnL);
#pragma unroll
    for (int r = 0; r < 16; ++r) p0[r] = __builtin_amdgcn_exp2f(p0[r]);
}
__device__ __forceinline__ void finishSM(f32x16& p0, f32x16& p1, float alpha, float& l_reg, bf16x8& pa0, bf16x8& pa1, bf16x8& pa2, bf16x8& pa3) {
#pragma unroll
    for (int r = 0; r < 16; ++r) p1[r] = __builtin_amdgcn_exp2f(p1[r]);
    float ps = 0;
#pragma unroll
    for (int r = 0; r < 16; ++r) ps += p0[r];
#pragma unroll
    for (int r = 0; r < 16; ++r) ps += p1[r];
    { auto rr = __builtin_amdgcn_permlane32_swap(__float_as_uint(ps), __float_as_uint(ps), false, false);
      ps = __uint_as_float(rr[0]) + __uint_as_float(rr[1]); }
    l_reg = l_reg * alpha + ps;
#define PK4(P, B_, OUT) do { unsigned a0 = cvtpk(P[B_+0], P[B_+1]), a1 = cvtpk(P[B_+2], P[B_+3]);                          \
        unsigned b0 = cvtpk(P[B_+4], P[B_+5]), b1 = cvtpk(P[B_+6], P[B_+7]);                                             \
        auto r0 = __builtin_amdgcn_permlane32_swap(a0, b0, false, false); auto r1 = __builtin_amdgcn_permlane32_swap(a1, b1, false, false); \
        v4u w = {r0[0], r1[0], r0[1], r1[1]}; OUT = *reinterpret_cast<bf16x8*>(&w); } while (0)
    PK4(p0, 0, pa0); PK4(p0, 8, pa1); PK4(p1, 0, pa2); PK4(p1, 8, pa3);
#undef PK4
}
template <int KB>
__device__ __forceinline__ void qkt(f32x16& p0, f32x16& p1, const char* K_lds, int r32, int hi, const bf16x8* qr, bool act) {
    if (!act) { const float NEG = -__builtin_inff();
#pragma unroll
        for (int r = 0; r < 16; ++r) { p0[r] = NEG; p1[r] = NEG; } return; }
    p0 = f32x16{}; p1 = f32x16{};
    const char* kb[4];
#pragma unroll
    for (int dd = 0; dd < 4; ++dd) kb[dd] = K_lds + KB * SHM_K + KSWZ(r32, (dd * 16 + hi * 8) * 2);
#pragma unroll
    for (int d0 = 0; d0 < 8; ++d0) { const char* a = kb[d0 & 3] + (d0 >> 2) * 128;
        bf16x8 b0 = *reinterpret_cast<const bf16x8*>(a);
        bf16x8 b1 = *reinterpret_cast<const bf16x8*>(a + 32 * 256);
        p0 = __builtin_amdgcn_mfma_f32_32x32x16_bf16(b0, qr[d0], p0, 0, 0, 0);
        p1 = __builtin_amdgcn_mfma_f32_32x32x16_bf16(b1, qr[d0], p1, 0, 0, 0); }
}
template <int VB>
__device__ __forceinline__ void pv_tile(f32x16* o, int vb0, bf16x8 pa0, bf16x8 pa1, bf16x8 pa2, bf16x8 pa3, bool act) {
    if (!act) return;
#define TRRD(dst, off) asm volatile("ds_read_b64_tr_b16 %0, %1 offset:%2" : "=&v"(dst) : "v"(vb0), "i"(off) : "memory")
#define PV_D0(d0) do { s16x4 l0, l1, l2, l3, h0, h1, h2, h3; constexpr int b_ = VB * SHM_V + v_rd_off(d0, 0, 0); \
        TRRD(l0, b_); TRRD(h0, b_ + 2048); TRRD(l1, b_ + 4096); TRRD(h1, b_ + 6144); TRRD(l2, b_ + 8192); TRRD(h2, b_ + 10240); TRRD(l3, b_ + 12288); TRRD(h3, b_ + 14336); \
        asm volatile("s_waitcnt lgkmcnt(0)" ::: "memory"); SBAR();   \
        o[d0] = __builtin_amdgcn_mfma_f32_32x32x16_bf16(pa0, (bf16x8){l0[0], l0[1], l0[2], l0[3], h0[0], h0[1], h0[2], h0[3]}, o[d0], 0, 0, 0);   \
        o[d0] = __builtin_amdgcn_mfma_f32_32x32x16_bf16(pa1, (bf16x8){l1[0], l1[1], l1[2], l1[3], h1[0], h1[1], h1[2], h1[3]}, o[d0], 0, 0, 0);   \
        o[d0] = __builtin_amdgcn_mfma_f32_32x32x16_bf16(pa2, (bf16x8){l2[0], l2[1], l2[2], l2[3], h2[0], h2[1], h2[2], h2[3]}, o[d0], 0, 0, 0);   \
        o[d0] = __builtin_amdgcn_mfma_f32_32x32x16_bf16(pa3, (bf16x8){l3[0], l3[1], l3[2], l3[3], h3[0], h3[1], h3[2], h3[3]}, o[d0], 0, 0, 0); } while (0)
    PV_D0(0); PV_D0(1); PV_D0(2); PV_D0(3);
#undef PV_D0
#undef TRRD
}
struct BlockRef { const bf16_t* Q; const bf16_t* K; const bf16_t* V; bf16_t* O; int qb; int h; };
struct Seam { bf16x8 qr[8]; bf16x8 st_v0, st_v1, st_k0, st_k1; };
#define ROW(p, k0, rr) ((p) + (size_t)((k0) + (rr)) * LDQ + sc)
#define VMW() asm volatile("s_waitcnt vmcnt(0)" ::: "memory")
#define VMWN(n) asm volatile("s_waitcnt vmcnt(%0)" :: "i"(n) : "memory")
#define SLOAD_H(Kp, Vp, k0) do { S.st_v0 = load8(ROW(Vp, k0, sr)); S.st_v1 = load8(ROW(Vp, k0, 32 + sr));              \
                         S.st_k0 = load8(ROW(Kp, k0, sr)); S.st_k1 = load8(ROW(Kp, k0, 32 + sr)); } while (0)
#define SWRITE_HK(bf) do { *(bf16x8*)(K_lds + (bf) * SHM_K + kws) = S.st_k0; *(bf16x8*)(K_lds + (bf) * SHM_K + kws + 32 * 256) = S.st_k1; } while (0)
#define SWRITE_HV(bf) do { *(bf16x8*)(V_lds + (bf) * SHM_V + vst0) = S.st_v0; *(bf16x8*)(V_lds + (bf) * SHM_V + vst1) = S.st_v1; } while (0)
#define SWRITE_H(bf) do { SWRITE_HV(bf); SWRITE_HK(bf); } while (0)
__device__ __forceinline__ void att_prime(const BlockRef& cur, char* lds, Seam& S) {
    const int tid = threadIdx.x, wid = __builtin_amdgcn_readfirstlane(tid >> 6), lane = tid & 63, r32 = lane & 31, hi = lane >> 5;
    const int sr = tid >> 4, sc = (tid & 15) * 8, kws = KSWZ(sr, sc * 2); char* K_lds = lds + 2 * SHM_V;
    const int kb0 = jlo(cur.qb) * KVBLK;
#pragma unroll
    for (int d0 = 0; d0 < 8; ++d0) S.qr[d0] = load8(cur.Q + (size_t)(wid * QBLK + r32) * LDQ + d0 * 16 + hi * 8);
    SLOAD_H(cur.K, cur.V, kb0); VMW(); SWRITE_HK(0);
    __syncthreads();
}
__device__ __forceinline__ void att_block(const BlockRef& cur, const BlockRef& nxt, char* lds, Seam& S) {
    const int tid = threadIdx.x, wid = __builtin_amdgcn_readfirstlane(tid >> 6), lane = tid & 63, r32 = lane & 31, hi = lane >> 5;
    const int j_lo = jlo(cur.qb), j_hi = 4 * cur.qb + 4;
    const int NT = j_hi - j_lo;
    const int kbn = jlo(nxt.qb) * KVBLK;
    const int cq = 4 * cur.qb + (wid >> 1);
    const int qlo = cur.qb * QB + wid * QBLK, qpos = qlo + r32;
    const float* bl = (const float*)(lds + BIAS_OFF) + cur.h * 320;
    char* V_lds = lds; char* K_lds = lds + 2 * SHM_V;
    float* ws = (float*)(lds + 2 * SHM_V + 2 * SHM_K) + wid * 64; float* li_l = ws, * al_l = ws + 32;
    float m_reg = -1e30f, l_reg = 0; f32x16 o[4] = {};
    const int sr = tid >> 4, sc = (tid & 15) * 8, vst0 = v_st(sr, sc), vst1 = v_st(32 + sr, sc), kws = KSWZ(sr, sc * 2);
    const int vb0 = (int)(uintptr_t)V_lds + v_rd_base(lane);
    const bf16_t* Kh = cur.K; const bf16_t* Vh = cur.V;
#define RESC(a) do { if (__any((a) < 1.f)) { if (hi == 0) al_l[r32] = (a); asm volatile("s_waitcnt lgkmcnt(0)" ::: "memory");              \
                     for (int d_ = 0; d_ < 4; ++d_) for (int r = 0; r < 16; ++r) o[d_][r] *= al_l[crow(r, hi)]; } } while (0)
#define KBASE(t) ((j_lo + (t)) * KVBLK)
#define ACT(t) ((j_lo + (t)) <= cq && (j_lo + (t)) + 8 >= cq)
#define BIAST(P0_, P1_, t) do { if (ACT(t)) bias_tile(P0_, P1_, qpos - KBASE(t) - 4 * hi, qlo - KBASE(t), bl); } while (0)
    constexpr int NQL = 8;
#define SEAM_K0() do { VMWN(NQL); SWRITE_HK(0); SBAR(); } while (0)
    f32x16 pA0, pA1, pB0, pB1; float mnA, mnB, alA, alB; bf16x8 pa0, pa1, pa2, pa3;
    SWRITE_HV(0); SBAR();
    if (NT > 1) { SLOAD_H(Kh, Vh, KBASE(1)); }
    SBAR(); qkt<0>(pA0, pA1, K_lds, r32, hi, S.qr, ACT(0));
    BIAST(pA0, pA1, 0); partialSM(pA0, pA1, m_reg, mnA, alA);
    if (NT > 1) { VMW(); SWRITE_H(1); }
    __syncthreads();
#define HALF_STEP(PX0, PX1, mnX, alX, PY0, PY1, alY, t, KB, VB, SB) do {                                                      \
        SBAR(); qkt<KB>(PX0, PX1, K_lds, r32, hi, S.qr, ACT(t));                                             \
        finishSM(PY0, PY1, alY, l_reg, pa0, pa1, pa2, pa3); SBAR();                                                           \
        if ((t) + 1 < NT) { SLOAD_H(Kh, Vh, KBASE((t) + 1)); SBAR(); }                                               \
        pv_tile<VB>(o, vb0, pa0, pa1, pa2, pa3, ACT((t) - 1)); BIAST(PX0, PX1, (t)); partialSM(PX0, PX1, m_reg, mnX, alX);                                        \
        __syncthreads();                                                                                                      \
        if ((t) + 1 < NT) { VMW(); SWRITE_H(SB); }                                                                          \
        RESC(alX); __syncthreads(); } while (0)
    for (int t = 1; t + 1 < NT; t += 2) {
        HALF_STEP(pB0, pB1, mnB, alB, pA0, pA1, alA, t, 1, 0, 0);
        HALF_STEP(pA0, pA1, mnA, alA, pB0, pB1, alB, t + 1, 0, 1, 1);
    }
    const bool even = (NT & 1) == 0;
    if (even) { SBAR(); qkt<1>(pB0, pB1, K_lds, r32, hi, S.qr, ACT(NT - 1)); SBAR(); }
    SLOAD_H(nxt.K, nxt.V, kbn); SBAR();
#pragma unroll
    for (int d0 = 0; d0 < 8; ++d0) S.qr[d0] = load8(nxt.Q + (size_t)(wid * QBLK + r32) * LDQ + d0 * 16 + hi * 8);
    SBAR();
    finishSM(pA0, pA1, alA, l_reg, pa0, pa1, pa2, pa3); SBAR();
    pv_tile<0>(o, vb0, pa0, pa1, pa2, pa3, ACT(even ? NT - 2 : NT - 1));
    if (even) { BIAST(pB0, pB1, NT - 1); partialSM(pB0, pB1, m_reg, mnB, alB); __syncthreads(); RESC(alB);
        finishSM(pB0, pB1, alB, l_reg, pa0, pa1, pa2, pa3); SBAR(); pv_tile<1>(o, vb0, pa0, pa1, pa2, pa3, ACT(NT - 1)); }
    SBAR(); SEAM_K0();
    if (hi == 0) li_l[r32] = l_reg; asm volatile("s_waitcnt lgkmcnt(0)" ::: "memory");
    float rli[16];
#pragma unroll
    for (int r = 0; r < 16; ++r) rli[r] = __builtin_amdgcn_rcpf(li_l[crow(r, hi)]);
    bf16_t* Ow = cur.O + (size_t)(wid * QBLK) * LDO;
#pragma unroll
    for (int r = 0; r < 16; ++r) { const int orow = crow(r, hi);
#pragma unroll
        for (int d0 = 0; d0 < 4; ++d0) { const float v = o[d0][r] * rli[r];
            const float vn = __shfl_xor(v, 1);
            if ((r32 & 1) == 0) *(unsigned*)(Ow + (size_t)orow * LDO + d0 * 32 + r32) = cvtpk(v, vn); } }
    __syncthreads();
#undef RESC
#undef KBASE
#undef ACT
#undef BIAST
#undef SEAM_K0
#undef HALF_STEP
}
#undef ROW
#undef VMW
#undef VMWN
#undef SLOAD_H
#undef SWRITE_HK
#undef SWRITE_HV
#undef SWRITE_H
#undef SBAR
#undef KSWZ
}

#define XB_TMO      128
#define XB_XCNT(j)  (256  + 64 * (j))
#define XB_XSUB(j)  (1280 + 64 * (j))
#define XB_XGEN(j)  (2304 + 64 * (j))
#define XB_TOP      3328
#define XB_TOPGEN   3392
#define XCD_BAR_WORDS 3456
#define XB_SPIN_CAP (1u << 18)
__device__ __forceinline__ unsigned xb_ld(unsigned* p)              { return __hip_atomic_load(p, __ATOMIC_RELAXED, __HIP_MEMORY_SCOPE_AGENT); }
__device__ __forceinline__ unsigned xb_add(unsigned* p, unsigned v) { return __hip_atomic_fetch_add(p, v, __ATOMIC_RELAXED, __HIP_MEMORY_SCOPE_AGENT); }
__device__ __forceinline__ unsigned xb_xcc_id() { return (unsigned)__builtin_amdgcn_s_getreg((3 << 11) | 20) & 0xFu; }
#define XB_SPIN(cond, bar) do { unsigned _sp = 0; while (cond) { __builtin_amdgcn_s_sleep(1); \
    if ((++_sp & 255u) == 0u) { if (xb_ld(&(bar)[XB_TMO])) break; if (_sp > XB_SPIN_CAP) { atomicAdd(&(bar)[XB_TMO], 1u); break; } } } } while (0)
struct XcdBarrier { unsigned* bar; unsigned x; volatile LAS unsigned* st; };
__device__ __forceinline__ XcdBarrier xcd_barrier_post(unsigned* bar, volatile LAS unsigned* st) {
    XcdBarrier b; b.bar = bar; b.x = xb_xcc_id(); b.st = st;
    if (threadIdx.x == 0) (void)xb_add(&bar[XB_XCNT(b.x)], 1u);
    return b;
}
__device__ __forceinline__ void xcd_barrier_complete(unsigned* bar, unsigned x, unsigned& nloc, unsigned& nx) {
    const unsigned G = gridDim.x * gridDim.y * gridDim.z;
    unsigned sum, cnt, mine, sp = 0u;
    for (;;) {
        sum = 0u; cnt = 0u; mine = 0u;
#pragma unroll
        for (unsigned j = 0; j < 16; ++j) { const unsigned c = xb_ld(&bar[XB_XCNT(j)]); sum += c; cnt += (c > 0u) ? 1u : 0u; mine = (j == x) ? c : mine; }
        if (sum == G) break;
        __builtin_amdgcn_s_sleep(1);
        if ((++sp & 255u) == 0u) { if (xb_ld(&bar[XB_TMO])) break; if (sp > XB_SPIN_CAP) { atomicAdd(&bar[XB_TMO], 1u); break; } }
    }
    nloc = mine > 0u ? mine : 1u; nx = cnt > 0u ? cnt : 1u;
}
__device__ __forceinline__ void xcd_barrier(const XcdBarrier& b) {
    asm volatile("s_waitcnt vmcnt(0)" ::: "memory");
    __syncthreads();
    if (threadIdx.x == 0) {
        unsigned* bar = b.bar;
        __builtin_amdgcn_s_waitcnt(0);
        unsigned nloc = b.st[0], nx = b.st[1];
        if (nloc == 0u) { xcd_barrier_complete(bar, b.x, nloc, nx); b.st[0] = nloc; b.st[1] = nx; }
        const unsigned old = xb_add(&bar[XB_XSUB(b.x)], 1u);
        const unsigned gen = old / nloc;
        if (old + 1u == (gen + 1u) * nloc) {
            __builtin_amdgcn_fence(__ATOMIC_RELEASE, "agent");
            asm volatile("s_waitcnt vmcnt(0)" ::: "memory");
            const unsigned og = xb_add(&bar[XB_TOP], 1u);
            const unsigned tg = og / nx;
            if (og + 1u == (tg + 1u) * nx) xb_add(&bar[XB_TOPGEN], 1u);
            else XB_SPIN(xb_ld(&bar[XB_TOPGEN]) == tg, bar);
            __builtin_amdgcn_fence(__ATOMIC_ACQUIRE, "agent");
            xb_add(&bar[XB_XGEN(b.x)], 1u);
            asm volatile("s_waitcnt vmcnt(0)" ::: "memory");
        } else {
            XB_SPIN(xb_ld(&bar[XB_XGEN(b.x)]) == gen, bar);
            __builtin_amdgcn_fence(__ATOMIC_ACQUIRE, "agent");
            asm volatile("s_waitcnt vmcnt(0)" ::: "memory");
        }
    }
    __syncthreads();
}

struct Args { const float* in[26]; float* out; unsigned char* ws; int ph_lo, ph_hi; };
__device__ __forceinline__ const float* arg_ptr(int k) { int o = k * 8; asm volatile("" : "+s"(o)); return *(const float* const*)((const char*)__builtin_amdgcn_kernarg_segment_ptr() + o); }
struct Frame {
    LAS unsigned char* lds;
    int tid, lane, wave, vcu, G;
    float* out; unsigned char* ws;
    __device__ __forceinline__ const float* x_prompt() const { return arg_ptr(0); }
    __device__ __forceinline__ const float* x_sample() const { return arg_ptr(1); }
    __device__ __forceinline__ const float* c_prompt() const { return arg_ptr(2); }
    __device__ __forceinline__ const float* c_sample() const { return arg_ptr(3); }
    __device__ __forceinline__ const float* cache_k() const { return arg_ptr(4); }
    __device__ __forceinline__ const float* cache_v() const { return arg_ptr(5); }
    __device__ __forceinline__ const float* st_h() const { return arg_ptr(6); }
    __device__ __forceinline__ const float* st_conv() const { return arg_ptr(7); }
    __device__ __forceinline__ const float* w_mod() const { return arg_ptr(8); }
    __device__ __forceinline__ const float* b_mod() const { return arg_ptr(9); }
    __device__ __forceinline__ const float* w_in() const { return arg_ptr(10); }
    __device__ __forceinline__ const float* rel_bias() const { return arg_ptr(11); }
    __device__ __forceinline__ const float* conv_w() const { return arg_ptr(12); }
    __device__ __forceinline__ const float* conv_b() const { return arg_ptr(13); }
    __device__ __forceinline__ const float* w_rg_a() const { return arg_ptr(14); }
    __device__ __forceinline__ const float* b_rg_a() const { return arg_ptr(15); }
    __device__ __forceinline__ const float* w_rg_x() const { return arg_ptr(16); }
    __device__ __forceinline__ const float* b_rg_x() const { return arg_ptr(17); }
    __device__ __forceinline__ const float* rg_lambda() const { return arg_ptr(18); }
    __device__ __forceinline__ const float* w_pa() const { return arg_ptr(19); }
    __device__ __forceinline__ const float* w_pr() const { return arg_ptr(20); }
    __device__ __forceinline__ const float* w_out() const { return arg_ptr(21); }
    __device__ __forceinline__ const float* w_gate() const { return arg_ptr(22); }
    __device__ __forceinline__ const float* w_up() const { return arg_ptr(23); }
    __device__ __forceinline__ const float* w_down() const { return arg_ptr(24); }
    __device__ __forceinline__ const float* fng() const { return arg_ptr(25); }
    __device__ __forceinline__ float* mod() const { return (float*)(ws + WS_MOD); }
    __device__ __forceinline__ float* x1() const { return (float*)(ws + WS_OY); }
    __device__ __forceinline__ float* slab4() const { return (float*)(ws + WS_SLAB4); }
    __device__ __forceinline__ float* slab6() const { return (float*)(ws + WS_SLAB6); }
    __device__ __forceinline__ float* slab9() const { return (float*)(ws + WS_SLAB9); }
    __device__ __forceinline__ bf16_t* Win_t() const { return (bf16_t*)(ws + WS_WIN); }
    __device__ __forceinline__ bf16_t* Wproj_t() const { return (bf16_t*)(ws + WS_WPROJ); }
    __device__ __forceinline__ bf16_t* Wout_t() const { return (bf16_t*)(ws + WS_WOUT); }
    __device__ __forceinline__ bf16_t* Wgu_t() const { return (bf16_t*)(ws + WS_WGU); }
    __device__ __forceinline__ bf16_t* Wdn_t() const { return (bf16_t*)(ws + WS_WDN); }
    __device__ __forceinline__ bf16_t* Wrg_t() const { return (bf16_t*)(ws + WS_WRG); }
    __device__ __forceinline__ bf16_t* H1() const { return (bf16_t*)(ws + WS_H1); }
    __device__ __forceinline__ bf16_t* Qb() const { return (bf16_t*)(ws + WS_Q); }
    __device__ __forceinline__ bf16_t* Kb() const { return (bf16_t*)(ws + WS_K); }
    __device__ __forceinline__ bf16_t* Vb() const { return (bf16_t*)(ws + WS_V); }
    __device__ __forceinline__ bf16_t* Ub() const { return (bf16_t*)(ws + WS_U); }
    __device__ __forceinline__ bf16_t* Gb() const { return (bf16_t*)(ws + WS_G); }
    __device__ __forceinline__ bf16_t* SAb() const { return (bf16_t*)(ws + WS_SA); }
    __device__ __forceinline__ bf16_t* SRb() const { return (bf16_t*)(ws + WS_SR); }
    __device__ __forceinline__ bf16_t* OY() const { return (bf16_t*)(ws + WS_OY); }
    __device__ __forceinline__ bf16_t* MG() const { return (bf16_t*)(ws + WS_MERGED); }
    __device__ __forceinline__ bf16_t* ACT() const { return (bf16_t*)(ws + WS_ACT); }
    __device__ __forceinline__ gu64* gran() const { return (gu64*)(ws + WS_GRAN); }
    __device__ __forceinline__ void refresh() { int t = threadIdx.x; asm volatile("" : "+v"(t)); tid = t; lane = t & 63; wave = __builtin_amdgcn_readfirstlane(t >> 6); }
};

__device__ __forceinline__ void xpose_item(const float* W, int N, bf16_t* WT, size_t ldo, int k0, int n0, int drow0, int dcol0, LAS float* scr, int lane) {
#pragma unroll 8
    for (int i = 0; i < 32; ++i) { const int kk = 2 * i + (lane >> 5); scr[kk * 33 + (lane & 31)] = W[(size_t)(k0 + kk) * N + n0 + (lane & 31)]; }
    LDS_WAIT(); asm volatile("" ::: "memory");
    const int c = lane & 7;
#pragma unroll
    for (int j = 0; j < 4; ++j) { const int n = (lane >> 3) + 8 * j; const LAS float* s = scr + (8 * c) * 33 + n;
        v4u o; o.x = pk2(s[0 * 33], s[1 * 33]); o.y = pk2(s[2 * 33], s[3 * 33]); o.z = pk2(s[4 * 33], s[5 * 33]); o.w = pk2(s[6 * 33], s[7 * 33]);
        *(GAS v4u*)(WT + (size_t)(drow0 + n) * ldo + dcol0 + 8 * c) = o; }
    LDS_WAIT(); asm volatile("" ::: "memory");
}
__device__ __forceinline__ void norm_regs_bf16(const f32x4 (&v)[8], const float* shift, const float* scale, bf16_t* orow, int lane) {
    f32x4 sc[8], sh[8];
#pragma unroll
    for (int j = 0; j < 8; ++j) { sc[j] = *((const GAS f32x4*)scale + lane + 64 * j); sh[j] = *((const GAS f32x4*)shift + lane + 64 * j); }
    float s = 0.f;
#pragma unroll
    for (int j = 0; j < 8; ++j) s += (v[j].x * v[j].x + v[j].y * v[j].y) + (v[j].z * v[j].z + v[j].w * v[j].w);
    const float rinv = rsqrtf(wave_sum(s) * (1.f / DM) + EPS);
    GAS v2u* o8 = (GAS v2u*)orow + lane;
#pragma unroll
    for (int j = 0; j < 8; ++j) { const f32x4 y = v[j] * rinv * (sc[j] + 1.f) + sh[j]; v2u w; w.x = pk2(y.x, y.y); w.y = pk2(y.z, y.w); o8[64 * j] = w; }
}
__device__ __forceinline__ void load_row(f32x4 (&v)[8], const float* row, int lane) {
    const GAS f32x4* xr = (const GAS f32x4*)row + lane;
#pragma unroll
    for (int j = 0; j < 8; ++j) v[j] = xr[64 * j];
}
__device__ __forceinline__ void phase0(Frame& F, bool dry = false) {
    const float* p_cp = F.c_prompt(); const float* p_cs = F.c_sample(); const float* p_wm = F.w_mod(); const float* p_bm = F.b_mod(); float* p_mod = F.mod(); const float* p_win = F.w_in(); bf16_t* p_wint = F.Win_t();
    { gu64* g = F.gran(); for (size_t i = (size_t)F.vcu * 512 + F.tid; i < 3 * 131072; i += (size_t)F.G * 512) g[i] = 0ull; }
    LAS float* sc = (LAS float*)(F.lds);
    LAS float* red = (LAS float*)(F.lds + 8192);
    for (int it = F.vcu; it < 768; it += F.G) {
        const int nc = it % 48, ks = it / 48;
        for (int i = F.tid; i < 1280; i += 512) { const int b = i >> 7, k = ks * 128 + (i & 127);
            const float cv = b < 2 ? p_cp[b * DM + k] : p_cs[(b - 2) * DM + k];
            sc[i] = cv * sigm(cv); }
        __syncthreads();
        f32x4 acc[10];
#pragma unroll
        for (int b = 0; b < 10; ++b) acc[b] = (f32x4){0.f, 0.f, 0.f, 0.f};
        const float* wp = p_wm + (size_t)(ks * 128 + F.wave * 16) * NMOD + nc * 256 + 4 * F.lane;
#pragma unroll 4
        for (int kk = 0; kk < 16; ++kk) { const f32x4 w = *(const GAS f32x4*)(wp + (size_t)kk * NMOD);
#pragma unroll
            for (int b = 0; b < 10; ++b) { const float s = sc[b * 128 + F.wave * 16 + kk]; acc[b] += w * s; } }
#pragma unroll
        for (int b = 0; b < 10; ++b) *(LAS f32x4*)(red + (F.wave * 10 + b) * 256 + 4 * F.lane) = acc[b];
        __syncthreads();
        for (int o = F.tid; o < 2560; o += 512) { const int b = o >> 8, col = o & 255; float s = 0.f;
#pragma unroll
            for (int w = 0; w < 8; ++w) s += red[(w * 10 + b) * 256 + col];
            if (ks == 0) s += p_bm[nc * 256 + col];
            if (!dry) atomicAdd(p_mod + (size_t)b * NMOD + nc * 256 + col, s); }
        __syncthreads();
    }
    LAS float* scr = (LAS float*)(F.lds + F.wave * 16384);
    const int gw = F.vcu * NWAVES + F.wave, NGW = F.G * NWAVES;
    for (int it = gw; it < 32 * 448; it += NGW) { const int kb = it / 448, nb = it % 448;
        xpose_item(p_win, NIN, p_wint, DM, kb * 64, nb * 32, nb * 32, kb * 64, scr, F.lane); }
}
constexpr int I_P = 32 * 64, I_G = 32 * 176, I_D = 88 * 64, I_R = 256;
constexpr int NITEMS_A = 3 * I_P + I_R, NITEMS_B = 2 * I_G + I_D;
__device__ __forceinline__ void conv_item_a(Frame& F, int r, LAS float* scr) {
    if (r < I_P) { const int kb = r / 64, nb = r % 64; xpose_item(F.w_pa(), DM, F.Wproj_t(), 4096, kb * 64, nb * 32, nb * 32, kb * 64, scr, F.lane); return; } r -= I_P;
    if (r < I_P) { const int kb = r / 64, nb = r % 64; xpose_item(F.w_pr(), DM, F.Wproj_t(), 4096, kb * 64, nb * 32, nb * 32, 2048 + kb * 64, scr, F.lane); return; } r -= I_P;
    if (r < I_P) { const int kb = r / 64, nb = r % 64; xpose_item(F.w_out(), DM, F.Wout_t(), DM, kb * 64, nb * 32, nb * 32, kb * 64, scr, F.lane); return; } r -= I_P;
    { const int mat = r >> 3, sub = r & 7, kb = sub >> 2, nb = sub & 3;
      const float* src = (mat < 16 ? F.w_rg_a() : F.w_rg_x()) + (size_t)(mat & 15) * 16384;
      xpose_item(src, 128, F.Wrg_t() + (size_t)mat * 16384, 128, kb * 64, nb * 32, nb * 32, kb * 64, scr, F.lane); }
}
__device__ __forceinline__ void conv_item_b(Frame& F, int r, LAS float* scr) {
    if (r < I_G) { const int kb = r / 176, nb = r % 176, n0 = nb * 32; xpose_item(F.w_gate(), DFF, F.Wgu_t(), DM, kb * 64, n0, (n0 >> 7) * 256 + (n0 & 127), kb * 64, scr, F.lane); return; } r -= I_G;
    if (r < I_G) { const int kb = r / 176, nb = r % 176, n0 = nb * 32; xpose_item(F.w_up(), DFF, F.Wgu_t(), DM, kb * 64, n0, (n0 >> 7) * 256 + 128 + (n0 & 127), kb * 64, scr, F.lane); return; } r -= I_G;
    { const int kb = r / 64, nb = r % 64; xpose_item(F.w_down(), DM, F.Wdn_t(), DFF, kb * 64, nb * 32, nb * 32, kb * 64, scr, F.lane); }
}
__device__ __forceinline__ void phase1(Frame& F) {
    const float* p_xp = F.x_prompt(); const float* p_xs = F.x_sample(); const float* p_mod = F.mod(); bf16_t* p_H1 = F.H1(); const float* p_sl6 = F.slab6(); const float* p_sl9 = F.slab9(); float* p_x1 = F.x1(); const float* p_fng = F.fng();
    LAS float* scr = (LAS float*)(F.lds + F.wave * 16384);
    const int gw = F.vcu * NWAVES + F.wave, NGW = F.G * NWAVES;
    for (int it = gw; it < NITEMS_A; it += NGW) conv_item_a(F, it, scr);
    for (int m = gw; m < MPAD; m += NGW) {
        bf16_t* orow = p_H1 + (size_t)m * DM;
        if (m >= MV) { GAS v2u* o8 = (GAS v2u*)orow + F.lane;
#pragma unroll
            for (int j = 0; j < 8; ++j) o8[64 * j] = (v2u){0u, 0u};
            continue; }
        const float* xrow = m < MP ? p_xp + (size_t)m * DM : p_xs + (size_t)(m - MP) * DM;
        const int seq = m < MP ? (m >> 12) : 2 + ((m - MP) >> 4);
        const float* md = p_mod + (size_t)seq * NMOD;
        f32x4 v[8]; load_row(v, xrow, F.lane);
        norm_regs_bf16(v, md, md + DM, orow, F.lane);
    }
}
__device__ __forceinline__ void phase_norm2s(Frame& F, int gw, int NGW, unsigned* ready) {
    const float* p_xs = F.x_sample(); const float* p_mod = F.mod(); bf16_t* p_H1 = F.H1(); const float* p_sl6 = F.slab6(); float* p_x1 = F.x1();
    for (int r = gw; r < MS; r += NGW) { const int m = MP + r;
        const float* md = p_mod + (size_t)(2 + (r >> 4)) * NMOD;
        f32x4 v[8], a[8]; load_row(v, p_xs + (size_t)r * DM, F.lane); load_row(a, p_sl6 + (size_t)r * DM, F.lane);
#pragma unroll 5
        for (int k = 1; k < NSL6; ++k) { f32x4 t[8]; load_row(t, p_sl6 + (size_t)(k * 128 + r) * DM, F.lane);
#pragma unroll
            for (int j = 0; j < 8; ++j) a[j] += t[j]; }
        GAS f32x4* xo = (GAS f32x4*)(p_x1 + (size_t)m * DM) + F.lane;
#pragma unroll
        for (int j = 0; j < 8; ++j) { const f32x4 g = *((const GAS f32x4*)(md + 2 * DM) + F.lane + 64 * j); v[j] = v[j] + g * a[j]; xo[64 * j] = v[j]; }
        norm_regs_bf16(v, md + 3 * DM, md + 4 * DM, p_H1 + (size_t)m * DM, F.lane);
        asm volatile("s_waitcnt vmcnt(0)" ::: "memory");
        __builtin_amdgcn_fence(__ATOMIC_RELEASE, "agent");
        asm volatile("s_waitcnt vmcnt(0)" ::: "memory");
        if (F.lane == 0) __hip_atomic_fetch_add(ready, 1u, __ATOMIC_RELAXED, __HIP_MEMORY_SCOPE_AGENT);
    }
}
__device__ __forceinline__ void phase_finals(Frame& F) {
    const float* p_mod = F.mod(); const float* p_sl9 = F.slab9(); const float* p_x1 = F.x1(); const float* p_fng = F.fng();
    LAS float* part = (LAS float*)F.lds;
    LAS float* red = part + 8 * DM;
    for (int r = F.vcu; r < MS; r += F.G) { const int m = MP + r;
        f32x4 a[8];
#pragma unroll
        for (int j = 0; j < 8; ++j) a[j] = (f32x4){0.f, 0.f, 0.f, 0.f};
        f32x4 t[3][8];
#pragma unroll
        for (int q = 0; q < 3; ++q) { const int k = F.wave + 8 * q; if (k < NSL9) load_row(t[q], p_sl9 + (size_t)(k * 128 + r) * DM, F.lane); }
#pragma unroll
        for (int q = 0; q < 3; ++q) { const int k = F.wave + 8 * q; if (k < NSL9) {
#pragma unroll
            for (int j = 0; j < 8; ++j) a[j] += t[q][j]; } }
#pragma unroll
        for (int j = 0; j < 8; ++j) *(LAS f32x4*)(part + F.wave * DM + 4 * (F.lane + 64 * j)) = a[j];
        __syncthreads();
        const int c = 256 * F.wave + 4 * F.lane;
        f32x4 sacc = *(const LAS f32x4*)(part + c);
#pragma unroll
        for (int w2 = 1; w2 < 8; ++w2) sacc += *(const LAS f32x4*)(part + w2 * DM + c);
        const float* md = p_mod + (size_t)(2 + (r >> 4)) * NMOD + 5 * DM;
        const f32x4 v = *(const GAS f32x4*)(p_x1 + (size_t)m * DM + c) + *(const GAS f32x4*)(md + c) * sacc;
        float ss = wave_sum((v.x * v.x + v.y * v.y) + (v.z * v.z + v.w * v.w));
        if (F.lane == 0) red[F.wave] = ss;
        __syncthreads();
        float tot = 0.f;
#pragma unroll
        for (int w2 = 0; w2 < 8; ++w2) tot += red[w2];
        const float rinv = rsqrtf(tot * (1.f / DM) + EPS);
        *(GAS f32x4*)(F.out + (size_t)m * DM + c) = v * rinv * *(const GAS f32x4*)(p_fng + c);
        __syncthreads();
    }
}
__device__ __forceinline__ void phase_mgs(Frame& F, unsigned* ready) {
    static_assert(NSL4 == 32, "phase_mgs: 4 lanes x 8 slabs");
    const GAS f32x4* src = (const GAS f32x4*)F.slab4(); GAS v2u* dst = (GAS v2u*)(F.MG() + (size_t)MP * DM);
    for (int i = F.vcu * 512 + F.tid; i < 128 * DM; i += F.G * 512) { const int o = i >> 2, q = i & 3;
        f32x4 t[8];
#pragma unroll
        for (int k = 0; k < 8; ++k) t[k] = src[(size_t)(8 * q + k) * (128 * DM / 4) + o];
        f32x4 a = (t[0] + t[1]) + (t[2] + t[3]) + ((t[4] + t[5]) + (t[6] + t[7]));
#pragma unroll
        for (int e = 0; e < 4; ++e) { a[e] += __shfl_xor(a[e], 1); a[e] += __shfl_xor(a[e], 2); }
        if (q == 0) { v2u w; w.x = pk2(a.x, a.y); w.y = pk2(a.z, a.w); dst[o] = w; } }
    asm volatile("s_waitcnt vmcnt(0)" ::: "memory"); __syncthreads();
    if (F.tid == 0) { __builtin_amdgcn_fence(__ATOMIC_RELEASE, "agent"); asm volatile("s_waitcnt vmcnt(0)" ::: "memory"); __hip_atomic_fetch_add(ready, 1u, __ATOMIC_RELAXED, __HIP_MEMORY_SCOPE_AGENT); }
}

constexpr int RG_WL = 4352, RG_W = 34816, RG_TOT = 104448, RG_PRE = 112640, RG_HIN = 120832, RG_TAB = 121344;
__device__ __forceinline__ float gran_poll(gu64* g) {
    unsigned spins = 0;
    for (;;) { const unsigned long long x = __hip_atomic_load(g, RLX_AGENT); if ((unsigned)(x >> 32) == 1u) return __uint_as_float((unsigned)x);
        __builtin_amdgcn_s_sleep(1); if (++spins > (1u << 17)) return 0.f; }
}
__device__ __forceinline__ void rglru_prologue(Frame& F, int n) {
    const bf16_t* p_Wrg = F.Wrg_t();
    for (int i = F.tid; i < 4096; i += 512) { const int row = i >> 4, ch = i & 15;
        const v4u wv = *(const GAS v4u*)(p_Wrg + (size_t)((row >> 7) * 16 + n) * 16384 + (row & 127) * 128 + ch * 8);
        *(LAS v4u*)(F.lds + RG_W + row * 272 + ch * 16) = wv; }
    if (F.tid < 128) { const int c = n * 128 + F.tid; LAS float* tab = (LAS float*)(F.lds + RG_TAB);
        tab[F.tid] = -8.f * log1pf(__expf(-F.rg_lambda()[c])); tab[128 + F.tid] = F.b_rg_a()[c]; tab[256 + F.tid] = F.b_rg_x()[c]; }
    __syncthreads();
}
template <bool SAMPLE>
__device__ __forceinline__ void rglru_unit(Frame& F, int bn, int j) {
    const int w = F.wave, lane = F.lane, fr = lane & 15, fq = lane >> 4;
    const float* p_conv_w = F.conv_w(); const float* p_conv_b = F.conv_b(); const float* p_st_conv = F.st_conv(); const float* p_st_h = F.st_h();
    const bf16_t* p_Ub = F.Ub(); const bf16_t* p_Gb = F.Gb(); bf16_t* p_OY = F.OY(); gu64* p_gran = F.gran();
    int n, seq; long row0;
    if (SAMPLE) { n = bn; seq = 2 + w; row0 = MP + w * 16; } else { seq = bn >> 4; n = bn & 15; row0 = (long)seq * TP + j * 128 + w * 16; }
    const int cb = n * 128;
    LAS unsigned char* wl = F.lds + w * RG_WL;
    const LAS float* tab = (const LAS float*)(F.lds + RG_TAB);
    v4u gpre[4];
#pragma unroll
    for (int i = 0; i < 4; ++i) { const int r = (lane >> 4) + 4 * i; gpre[i] = *(const GAS v4u*)(p_Gb + (size_t)(row0 + r) * DM + cb + (lane & 15) * 8); }
    {
        const int c2 = cb + 2 * lane;
        float cw0[4], cw1[4];
#pragma unroll
        for (int k = 0; k < 4; ++k) { cw0[k] = p_conv_w[k * DM + c2]; cw1[k] = p_conv_w[k * DM + c2 + 1]; }
        const float cb0 = p_conv_b[c2], cb1 = p_conv_b[c2 + 1];
        float u0[19], u1[19];
#pragma unroll
        for (int i = 0; i < 19; ++i) { const int rr = i - 3;
            if (rr < 0) {
                if (SAMPLE) { u0[i] = p_st_conv[(size_t)(w * 3 + i) * DM + c2]; u1[i] = p_st_conv[(size_t)(w * 3 + i) * DM + c2 + 1]; }
                else if (j == 0 && w == 0) { u0[i] = 0.f; u1[i] = 0.f; }
                else { const unsigned p = *(const GAS unsigned*)(p_Ub + (size_t)(row0 + rr) * DM + c2); u0[i] = bflo(p); u1[i] = bfhi(p); }
            } else { const unsigned p = *(const GAS unsigned*)(p_Ub + (size_t)(row0 + rr) * DM + c2); u0[i] = bflo(p); u1[i] = bfhi(p); } }
#pragma unroll
        for (int tt = 0; tt < 16; ++tt) {
            const float x0 = cb0 + cw0[0] * u0[tt] + cw0[1] * u0[tt + 1] + cw0[2] * u0[tt + 2] + cw0[3] * u0[tt + 3];
            const float x1 = cb1 + cw1[0] * u1[tt] + cw1[1] * u1[tt + 1] + cw1[2] * u1[tt + 2] + cw1[3] * u1[tt + 3];
            *(LAS unsigned*)(wl + tt * 272 + lane * 4) = pk2(x0, x1); }
    }
    LDS_WAIT(); asm volatile("" ::: "memory");
    f32x4 acc[2][8];
#pragma unroll
    for (int a = 0; a < 2; ++a)
#pragma unroll
        for (int g = 0; g < 8; ++g) acc[a][g] = (f32x4){0.f, 0.f, 0.f, 0.f};
#pragma unroll
    for (int ks = 0; ks < 4; ++ks) { const bf16x8 a = *(const LAS bf16x8*)(wl + fr * 272 + (32 * ks + 8 * fq) * 2);
#pragma unroll
        for (int wh = 0; wh < 2; ++wh)
#pragma unroll
            for (int g = 0; g < 8; ++g) { const bf16x8 b = *(const LAS bf16x8*)(F.lds + RG_W + (wh * 128 + 16 * g + fr) * 272 + (32 * ks + 8 * fq) * 2);
                acc[wh][g] = __builtin_amdgcn_mfma_f32_16x16x32_bf16(a, b, acc[wh][g], 0, 0, 0); } }
    float Al[8][4], Hl[8][4], HS[8], EA[8], EH[8];
#pragma unroll
    for (int g = 0; g < 8; ++g) {
        const int cl = 16 * g + fr, c = cb + cl;
        const float c8 = tab[cl], ba = tab[128 + cl], bx = tab[256 + cl];
        float A = 1.f, H = 0.f;
#pragma unroll
        for (int reg = 0; reg < 4; ++reg) { const int tt = 4 * fq + reg;
            const float xcv = bf2f(*(const LAS unsigned short*)(wl + tt * 272 + cl * 2));
            const float r = sigm(acc[0][g][reg] + ba), ii = sigm(acc[1][g][reg] + bx);
            const float la = c8 * r, a = __expf(la), bb = __builtin_amdgcn_sqrtf(fmaxf(1.f - a * a, 0.f)) * (ii * xcv);
            H = a * H + bb; A = a * A; Al[g][reg] = A; Hl[g][reg] = H; }
        float IA = A, IH = H;
        { const float xa = __shfl_up(IA, 16), xh = __shfl_up(IH, 16); if (fq >= 1) { IH = IA * xh + IH; IA = IA * xa; } }
        { const float xa = __shfl_up(IA, 32), xh = __shfl_up(IH, 32); if (fq >= 2) { IH = IA * xh + IH; IA = IA * xa; } }
        { const float xa = __shfl_up(IA, 16), xh = __shfl_up(IH, 16); EA[g] = fq ? xa : 1.f; EH[g] = fq ? xh : 0.f; }
        if (SAMPLE) { const float h0 = p_st_h[(size_t)w * DM + c]; HS[g] = EA[g] * h0 + EH[g];
            if (fq == 3) F.out[O_SH + (size_t)w * DM + c] = IA * h0 + IH; }
        else { HS[g] = 0.f; if (fq == 3) *(LAS f32x2*)(F.lds + RG_TOT + (w * 128 + cl) * 8) = (f32x2){IA, IH}; }
    }
#pragma unroll
    for (int i = 0; i < 4; ++i) { const int r = (lane >> 4) + 4 * i; *(LAS v4u*)(wl + r * 272 + (lane & 15) * 16) = gpre[i]; }
    if (!SAMPLE) {
        __syncthreads();
        if (F.tid < 128) { const int c = F.tid; float PA = 1.f, PH = 0.f;
#pragma unroll
            for (int w2 = 0; w2 < 8; ++w2) { *(LAS f32x2*)(F.lds + RG_PRE + (w2 * 128 + c) * 8) = (f32x2){PA, PH};
                const f32x2 t = *(const LAS f32x2*)(F.lds + RG_TOT + (w2 * 128 + c) * 8); PH = t.x * PH + t.y; PA = PA * t.x; }
            gu64* gI = p_gran + (size_t)(bn * 32) * 128 + c; gu64* gA = gI + 131072; gu64* gB = gI + 262144;
            if (j < 31) { __hip_atomic_store(gA + j * 128, (1ull << 32) | (unsigned long long)__float_as_uint(PA), RLX_AGENT);
                          __hip_atomic_store(gB + j * 128, (1ull << 32) | (unsigned long long)__float_as_uint(PH), RLX_AGENT); }
            float hin = 0.f;
            if (j > 0) { float fa = 1.f, fh = 0.f; int k = j - 1; unsigned spins = 0; bool done = false;
                while (!done) {
                    unsigned long long xi[8], xa[8], xb[8];
#pragma unroll
                    for (int i = 0; i < 8; ++i) { const int kk = k - i < 0 ? 0 : k - i; xi[i] = __hip_atomic_load(gI + kk * 128, RLX_AGENT); xa[i] = __hip_atomic_load(gA + kk * 128, RLX_AGENT); xb[i] = __hip_atomic_load(gB + kk * 128, RLX_AGENT); }
                    bool stuck = false;
#pragma unroll
                    for (int i = 0; i < 8; ++i) { if (!done && !stuck) {
                        if ((unsigned)(xi[i] >> 32) == 1u) { hin = fa * __uint_as_float((unsigned)xi[i]) + fh; done = true; }
                        else if ((unsigned)(xa[i] >> 32) == 1u && (unsigned)(xb[i] >> 32) == 1u) { fh = fa * __uint_as_float((unsigned)xb[i]) + fh; fa = fa * __uint_as_float((unsigned)xa[i]); --k; if (k < 0) { hin = fh; done = true; } }
                        else stuck = true; } }
                    if (!done) { __builtin_amdgcn_s_sleep(1); if (++spins > (1u << 16)) break; }
                } }
            const float hout = PA * hin + PH;
            if (j < 31) __hip_atomic_store(gI + j * 128, (1ull << 32) | (unsigned long long)__float_as_uint(hout), RLX_AGENT);
            else F.out[O_PH + (size_t)seq * DM + cb + c] = hout;
            *(LAS float*)(F.lds + RG_HIN + c * 4) = hin; }
        __syncthreads();
#pragma unroll
        for (int g = 0; g < 8; ++g) { const int cl = 16 * g + fr; const f32x2 p = *(const LAS f32x2*)(F.lds + RG_PRE + (w * 128 + cl) * 8);
            const float hw = p.x * *(const LAS float*)(F.lds + RG_HIN + cl * 4) + p.y; HS[g] = EA[g] * hw + EH[g]; }
    }
    LDS_WAIT(); asm volatile("" ::: "memory");
#pragma unroll
    for (int g = 0; g < 8; ++g) { const int cl = 16 * g + fr;
#pragma unroll
        for (int reg = 0; reg < 4; ++reg) { const int tt = 4 * fq + reg; LAS unsigned short* gp = (LAS unsigned short*)(wl + tt * 272 + cl * 2);
            const float h = Al[g][reg] * HS[g] + Hl[g][reg]; *gp = (unsigned short)f2bf(h * bf2f(*gp)); } }
    LDS_WAIT(); asm volatile("" ::: "memory");
#pragma unroll
    for (int i = 0; i < 4; ++i) { const int r = (lane >> 4) + 4 * i; const v4u y = *(const LAS v4u*)(wl + r * 272 + (lane & 15) * 16);
        *(GAS v4u*)(p_OY + (size_t)(row0 + r) * 4096 + 2048 + cb + (lane & 15) * 8) = y; }
    __syncthreads();
}
typedef int i32x4_t __attribute__((ext_vector_type(4)));
__device__ __forceinline__ bf16x8 pack8frag(f32x4 a, f32x4 b) { const v4u w = pack8bf(a, b); return __builtin_bit_cast(bf16x8, w); }
__device__ __forceinline__ void sattn_unit(Frame& F, int bs, int h, int qh) {
    constexpr int RS = 532;
    LAS float* scv = (LAS float*)F.lds;
    LAS float* inv = scv + 16 * RS;
    LAS float* btab = inv + 16;
    LAS float* part = btab + 320;
    const int w = F.wave, lane = F.lane, fr = lane & 15, fq = lane >> 4;
    if (F.tid < 320) btab[F.tid] = F.rel_bias()[h * 320 + F.tid];
    const unsigned lrow = (unsigned)(fr * 2048 + 8 * fq) * 4u;
    {
        bf16x8 qf[4];
#pragma unroll
        for (int ks = 0; ks < 4; ++ks) qf[ks] = *(const GAS bf16x8*)(F.Qb() + (size_t)(MP + bs * 16 + qh * 8 + (fr & 7)) * DM + h * 128 + 32 * ks + 8 * fq);
        const __amdgpu_buffer_rsrc_t rk = __builtin_amdgcn_make_buffer_rsrc((void*)(F.cache_k() + ((size_t)(bs * 512 + 64 * w) * 16 + h) * 128), 0, 0x40000000, 0x00020000);
        f32x4 kr[4][4][2];
#pragma unroll
        for (int t = 0; t < 4; ++t)
#pragma unroll
            for (int ks = 0; ks < 4; ++ks) { const int so = (16 * t * 2048 + 32 * ks) * 4;
                kr[t][ks][0] = __builtin_bit_cast(f32x4, __builtin_amdgcn_raw_buffer_load_b128(rk, lrow, so, 0));
                kr[t][ks][1] = __builtin_bit_cast(f32x4, __builtin_amdgcn_raw_buffer_load_b128(rk, lrow, so + 16, 0)); }
#pragma unroll
        for (int t = 0; t < 4; ++t) { f32x4 acc = {0.f, 0.f, 0.f, 0.f};
#pragma unroll
            for (int ks = 0; ks < 4; ++ks) acc = __builtin_amdgcn_mfma_f32_16x16x32_bf16(pack8frag(kr[t][ks][0], kr[t][ks][1]), qf[ks], acc, 0, 0, 0);
#pragma unroll
            for (int reg = 0; reg < 4; ++reg) scv[fr * RS + 64 * w + 16 * t + 4 * fq + reg] = acc[reg] * ATT_SCALE; }
        if (w == 0) {
            const __amdgpu_buffer_rsrc_t rn = __builtin_amdgcn_make_buffer_rsrc((void*)(F.out + O_SK + (size_t)(bs * 16) * DM + h * 128), 0, 0x40000000, 0x00020000);
            f32x4 acc = {0.f, 0.f, 0.f, 0.f};
#pragma unroll
            for (int ks = 0; ks < 4; ++ks) { const f32x4 a = __builtin_bit_cast(f32x4, __builtin_amdgcn_raw_buffer_load_b128(rn, lrow, 32 * ks * 4, 0)), b = __builtin_bit_cast(f32x4, __builtin_amdgcn_raw_buffer_load_b128(rn, lrow, 32 * ks * 4 + 16, 0));
                acc = __builtin_amdgcn_mfma_f32_16x16x32_bf16(pack8frag(a, b), qf[ks], acc, 0, 0, 0); }
#pragma unroll
            for (int reg = 0; reg < 4; ++reg) scv[fr * RS + 512 + 4 * fq + reg] = acc[reg] * ATT_SCALE; }
    }
    __syncthreads();
    { const int row = w, qp_ = qh * 8 + w; float mx = -1e30f;
        for (int jk = lane; jk < 528; jk += 64) { int diff = jk < 512 ? (512 + qp_ - jk) : (qp_ - (jk - 512)); diff = diff > 256 ? 256 : diff;
            const float v = scv[row * RS + jk] + btab[diff + 63]; scv[row * RS + jk] = v; mx = fmaxf(mx, v); }
        mx = wave_max(mx); float sum = 0.f;
        for (int jk = lane; jk < 528; jk += 64) { const float e = __expf(scv[row * RS + jk] - mx); scv[row * RS + jk] = e; sum += e; }
        sum = wave_sum(sum); if (lane == 0) inv[row] = 1.f / sum; }
    __syncthreads();
    {
        const unsigned lcol = (unsigned)(8 * fq * 2048 + fr) * 4u;
        const __amdgpu_buffer_rsrc_t rv = __builtin_amdgcn_make_buffer_rsrc((void*)(F.cache_v() + ((size_t)(bs * 512 + 64 * w) * 16 + h) * 128), 0, 0x40000000, 0x00020000);
        f32x4 acc[8];
#pragma unroll
        for (int dt = 0; dt < 8; ++dt) acc[dt] = (f32x4){0.f, 0.f, 0.f, 0.f};
#pragma unroll
        for (int kt = 0; kt < 2; ++kt) {
            float vv[8][8];
#pragma unroll
            for (int dt = 0; dt < 8; ++dt)
#pragma unroll
                for (int j = 0; j < 8; ++j) vv[dt][j] = __builtin_bit_cast(float, __builtin_amdgcn_raw_buffer_load_b32(rv, lcol, ((32 * kt + j) * 2048 + 16 * dt) * 4, 0));
            const LAS f32x4* pp = (const LAS f32x4*)(scv + fr * RS + 64 * w + 32 * kt + 8 * fq);
            const bf16x8 pf = pack8frag(pp[0], pp[1]);
#pragma unroll
            for (int dt = 0; dt < 8; ++dt) { const bf16x8 bfr = pack8frag((f32x4){vv[dt][0], vv[dt][1], vv[dt][2], vv[dt][3]}, (f32x4){vv[dt][4], vv[dt][5], vv[dt][6], vv[dt][7]});
                acc[dt] = __builtin_amdgcn_mfma_f32_16x16x32_bf16(pf, bfr, acc[dt], 0, 0, 0); }
        }
        if (w == 0) {
            const __amdgpu_buffer_rsrc_t rn = __builtin_amdgcn_make_buffer_rsrc((void*)(F.out + O_SV + (size_t)(bs * 16) * DM + h * 128), 0, 0x40000000, 0x00020000);
            const unsigned lcn = (unsigned)(8 * (fq & 1) * 2048 + fr) * 4u;
            float vv[8][8];
#pragma unroll
            for (int dt = 0; dt < 8; ++dt)
#pragma unroll
                for (int j = 0; j < 8; ++j) vv[dt][j] = __builtin_bit_cast(float, __builtin_amdgcn_raw_buffer_load_b32(rn, lcn, (j * 2048 + 16 * dt) * 4, 0));
            const LAS f32x4* pp = (const LAS f32x4*)(scv + fr * RS + 512 + 8 * (fq & 1));
            f32x4 p0 = pp[0], p1 = pp[1]; if (fq >= 2) { p0 = (f32x4){0.f, 0.f, 0.f, 0.f}; p1 = p0; }
            const bf16x8 pf = pack8frag(p0, p1);
#pragma unroll
            for (int dt = 0; dt < 8; ++dt) { const bf16x8 bfr = pack8frag((f32x4){vv[dt][0], vv[dt][1], vv[dt][2], vv[dt][3]}, (f32x4){vv[dt][4], vv[dt][5], vv[dt][6], vv[dt][7]});
                acc[dt] = __builtin_amdgcn_mfma_f32_16x16x32_bf16(pf, bfr, acc[dt], 0, 0, 0); }
        }
#pragma unroll
        for (int dt = 0; dt < 8; ++dt)
#pragma unroll
            for (int reg = 0; reg < 4; ++reg) part[(w * 16 + 4 * fq + reg) * 128 + 16 * dt + fr] = acc[dt][reg];
    }
    __syncthreads();
    { const int row = F.tid >> 6, c2 = (F.tid & 63) * 2; f32x2 a = {0.f, 0.f};
#pragma unroll
      for (int w2 = 0; w2 < 8; ++w2) a += *(const LAS f32x2*)(part + (w2 * 16 + row) * 128 + c2);
      a = a * inv[row];
      *(GAS unsigned*)(F.OY() + (size_t)(MP + bs * 16 + qh * 8 + row) * 4096 + h * 128 + c2) = pk2(a.x, a.y); }
    __syncthreads();
}
__device__ __forceinline__ att::BlockRef att_ref(Frame& F, int L) {
    const int bh = L >> 4, qb = L & 15, b = bh >> 4, h = bh & 15;
    att::BlockRef r; const size_t rb = (size_t)b * TP;
    r.Q = F.Qb() + (rb + (size_t)qb * 256) * DM + h * 128; r.K = F.Kb() + rb * DM + h * 128; r.V = F.Vb() + rb * DM + h * 128;
    r.O = F.OY() + (rb + (size_t)qb * 256) * 4096 + h * 128; r.qb = qb; r.h = h; return r;
}
template <int pmask>
__device__ __forceinline__ void phase3(Frame& F, char* ldsg) {
    int wn = -1;
    if (pmask & 1) for (int id = F.vcu; id < 1024; id += F.G) { const int bn = id & 31; if ((bn & 15) != wn) { wn = bn & 15; rglru_prologue(F, wn); } rglru_unit<false>(F, bn, id >> 5); }
    if (pmask & 2) { if ((F.G & 15) == 0) { if ((F.vcu & 15) == 0 && (F.vcu >> 4) < 16) { const int n = F.vcu >> 4; if (n != wn) { wn = n; rglru_prologue(F, wn); } rglru_unit<true>(F, n, 0); } }
        else for (int n = F.vcu; n < 16; n += F.G) { if (n != wn) { wn = n; rglru_prologue(F, wn); } rglru_unit<true>(F, n, 0); } }
    if (pmask & 4) for (int u = F.vcu; u < 256; u += F.G) sattn_unit(F, u >> 5, (u >> 1) & 15, u & 1);
    for (int i = F.tid; i < 5120; i += 512) ((LAS float*)(F.lds + att::BIAS_OFF))[i] = F.rel_bias()[i];
    __syncthreads();
    int L = F.vcu;
    if ((pmask & 8) && L < 512) {
        att::BlockRef cur = att_ref(F, L); att::Seam S; att::att_prime(cur, ldsg, S);
        for (;;) { const bool more = L + F.G < 512; const int Ln = more ? L + F.G : L; const att::BlockRef nxt = more ? att_ref(F, Ln) : cur;
            att::att_block(cur, nxt, ldsg, S); if (!more) break; cur = nxt; L = Ln; }
    }
}

#ifndef WGM_P2
#define WGM_P2 2
#endif
#ifndef WGM_P4
#define WGM_P4 2
#endif
#ifndef WGM_P5
#define WGM_P5 2
#endif
#ifndef WGM_P6
#define WGM_P6 2
#endif
#ifndef WGM_P7
#define WGM_P7 2
#endif
__global__ void __launch_bounds__(NWAVES * 64, 2) fwd(Args args) {
    extern __shared__ __attribute__((aligned(16))) unsigned char lds[];
    Frame F;
    F.lds = (LAS unsigned char*)lds;
    F.tid = threadIdx.x; F.lane = F.tid & 63; F.wave = __builtin_amdgcn_readfirstlane(F.tid >> 6);
    F.G = gridDim.x; { const int bx = blockIdx.x; F.vcu = (F.G % 8 == 0) ? (bx % 8) * (F.G / 8) + bx / 8 : bx; }
    F.out = args.out; F.ws = args.ws;
    unsigned char* ws = args.ws;
    for (int u = F.tid; u < (LDS_BYTES - LDSCTL_OFF) / 4; u += NWAVES * 64) ((LAS unsigned*)(F.lds + LDSCTL_OFF))[u] = 0u;
    __syncthreads();
#if !MK_MULTI
    XcdBarrier bar = xcd_barrier_post((unsigned*)(ws + WS_CTL) + CW_BAR, (volatile LAS unsigned*)(F.lds + MISC_OFF) + 8);
#define GRID_BAR() xcd_barrier(bar)
#else
#define GRID_BAR() do { } while (0)
#endif
    const int lo = args.ph_lo, hi = args.ph_hi;
#ifndef PHMASK
#define PHMASK 0x1ff
#endif
#define IN(k) (((PHMASK >> (k)) & 1) && lo <= (k) && (k) < hi)
#define SEAM(k) do { if (lo <= (k) && (k) + 1 < hi && (k) < 8) GRID_BAR(); } while (0)
#ifndef REP_PHASE
#define REP_PHASE -1
#endif
#define RUNPH(k, ...) do { unsigned long long t0_ = 0; if (PROBE_PHASE == (k)) t0_ = __builtin_amdgcn_s_memrealtime(); \
        if (IN(k)) { __VA_ARGS__ } if (REP_PHASE == (k) && IN(k)) { GRID_BAR(); __VA_ARGS__ } SEAM(k); \
        if (PROBE_PHASE == (k) && blockIdx.x == 0 && threadIdx.x == 0) ((unsigned*)(F.ws + WS_CTL))[2] = (unsigned)(__builtin_amdgcn_s_memrealtime() - t0_); } while (0)
    RUNPH(0, F.refresh(); phase0(F); );
    if (REP_PHASE == 100 && IN(0)) { phase0(F, true); GRID_BAR(); }
    RUNPH(1, F.refresh(); phase1(F); );
    RUNPH(2, F.refresh(); pg8::Gemm g{F.H1(), F.Win_t(), MPAD, NIN, DM}; pg8::StaticOrder S; S.init(MPAD, NIN, DM, F.G, (int)blockIdx.x, WGM_P2);
        EpiIn E{F.Qb(), F.out}; pg8::gemm_phase<EpiIn, pg8::StaticOrder, true, true>(F.lds, g, S, E);
        { const int nlast = S.nwg % F.G, nfree = nlast ? F.G - nlast : F.G, fidx = nlast ? (int)blockIdx.x - nlast : (int)blockIdx.x;
          if (fidx >= 0) { LAS float* scr = (LAS float*)(F.lds + F.wave * 16384);
              for (int it = fidx * NWAVES + F.wave; it < NITEMS_B; it += nfree * NWAVES) conv_item_b(F, it, scr); } } );
    RUNPH(3, F.refresh(); phase3<15>(F, (char*)lds); );
    if (REP_PHASE > 100 && REP_PHASE < 116 && IN(3)) { F.refresh(); phase3<(REP_PHASE > 100 ? REP_PHASE - 100 : 15)>(F, (char*)lds); GRID_BAR(); }
    RUNPH(4, F.refresh(); pg8::Gemm g{F.OY(), F.Wproj_t(), MPAD, DM, 2 * DM}; pg8::HybridOrder S; S.init(DM, 2 * DM, F.G, (int)blockIdx.x, 2, WGM_P4);
        EpiProj E{F.SAb(), F.SRb(), F.MG(), F.slab4(), F.ws}; pg8::gemm_phase<EpiProj, pg8::HybridOrder, true, true>(F.lds, g, S, E); );
    RUNPH(5, F.refresh(); pg8::Gemm g{F.MG(), F.Wout_t(), MPAD, DM, DM}; pg8::HybridOrder S; S.init(DM, DM, F.G, (int)blockIdx.x, SNT5, WGM_P5);
        unsigned* rdy = (unsigned*)(F.ws + WS_CTL) + CW_READY + 64; S.ready = rdy; S.need = (unsigned)F.G; S.slices_first = true;
        probe_mark(0, F.ws); phase_mgs(F, rdy); probe_mark(1, F.ws);
        EpiResNorm E{F.x_prompt(), F.x1(), F.H1(), F.mod(), F.slab6(), F.lds + XL_OFF, (unsigned long long*)(F.ws + WS_XW), F.ws};
        pg8::gemm_phase<EpiResNorm, pg8::HybridOrder, true, true>(F.lds, g, S, E); );
    RUNPH(6, F.refresh(); pg8::Gemm g{F.H1(), F.Wgu_t(), MPAD, NGU, DM}; pg8::SampleGatedOrder S; S.init(MPAD, NGU, DM, F.G, (int)blockIdx.x, WGM_P6);
        unsigned* ready = (unsigned*)(F.ws + WS_CTL) + CW_READY; S.ready = ready; S.need = MS;
        { const int nlast = S.nwg % F.G, nfree = nlast ? F.G - nlast : F.G, fidx = nlast ? (int)blockIdx.x - nlast : (int)blockIdx.x;
          if (fidx >= 0) phase_norm2s(F, fidx * NWAVES + F.wave, nfree * NWAVES, ready); }
        EpiGU E{F.ACT()}; pg8::gemm_phase<EpiGU, pg8::SampleGatedOrder, true, true>(F.lds, g, S, E); );
    RUNPH(7, F.refresh(); pg8::Gemm g{F.ACT(), F.Wdn_t(), MPAD, DM, DFF}; pg8::HybridOrder S; S.init(DM, DFF, F.G, (int)blockIdx.x, SNT7, WGM_P7); S.slices_first = true;
        EpiResFinal E{F.x1(), F.out, F.mod(), F.fng(), F.slab9(), F.lds + XL_OFF, (unsigned long long*)(F.ws + WS_XW) + 32 * 256};
        pg8::gemm_phase<EpiResFinal, pg8::HybridOrder, true, true>(F.lds, g, S, E); );
    RUNPH(8, F.refresh(); phase_finals(F); );
    if (PROBE_PHASE >= 0 && blockIdx.x == 0) { __syncthreads(); const unsigned ticks = ((volatile unsigned*)(F.ws + WS_CTL))[2];
        const float fac = 1.f + 4e-3f + (PROBE_PHASE >= 100 ? 5e-5f : 1.5e-5f) * (0.01f * (float)ticks);
        for (int i = threadIdx.x; i < 16384; i += 512) F.out[O_SH + i] *= fac; }
#undef IN
#undef SEAM
}

extern "C" void kernel_launch(void* const* d_in, const int* in_sizes, int n_in, void* d_out, int out_size, void* d_ws, size_t ws_size, hipStream_t stream) {
    static int grid = 0;
    if (grid == 0) {
        if (n_in != 26 || out_size != (int)O_END || ws_size < WS_END) { fprintf(stderr, "kernel_launch: unexpected shapes (n_in %d out %d ws %zu)\n", n_in, out_size, ws_size); grid = -1; return; }
        int dev = 0, cus = 0, per_cu = 0;
        if (hipGetDevice(&dev) != hipSuccess || hipDeviceGetAttribute(&cus, hipDeviceAttributeMultiprocessorCount, dev) != hipSuccess) { grid = -1; return; }
        if (hipFuncSetAttribute((const void*)fwd, hipFuncAttributeMaxDynamicSharedMemorySize, LDS_BYTES) != hipSuccess) { fprintf(stderr, "kernel_launch: hipFuncSetAttribute failed\n"); grid = -1; return; }
        if (hipOccupancyMaxActiveBlocksPerMultiprocessor(&per_cu, (const void*)fwd, NWAVES * 64, LDS_BYTES) != hipSuccess || per_cu < 1) { fprintf(stderr, "kernel_launch: occupancy query says %d workgroups per CU; nothing launched\n", per_cu); (void)hipGetLastError(); grid = -1; return; }
        grid = cus;
    }
    if (grid < 0) return;
    (void)hipMemsetAsync((char*)d_ws + WS_CTL, 0, CTL_ZERO_BYTES, stream);
    Args a{};
    for (int i = 0; i < 26; ++i) a.in[i] = (const float*)d_in[i];
    a.out = (float*)d_out; a.ws = (unsigned char*)d_ws;
#if MK_MULTI
    for (int p = 0; p < 9; ++p) { a.ph_lo = p; a.ph_hi = p + 1; hipLaunchKernelGGL(fwd, dim3(grid), dim3(NWAVES * 64), LDS_BYTES, stream, a); }
#else
    a.ph_lo = 0; a.ph_hi = 9;
    void* kargs[] = {&a};
    hipError_t e = hipLaunchCooperativeKernel((const void*)fwd, dim3(grid), dim3(NWAVES * 64), kargs, LDS_BYTES, stream);
    if (e != hipSuccess) fprintf(stderr, "kernel_launch: cooperative launch failed: %s (grid %d)\n", hipGetErrorString(e), grid);
#endif
}
```
